# Optimizing an MI355X kernel written in HIP

```python
import jax, jax.numpy as jnp
from jax import lax
import numpy as np

D_MODEL = 1024
BATCH = 4
SEQ = 8192
DEPTH = 4

HG_HEADS = 8
HG_DK = 128
HG_DV = D_MODEL // HG_HEADS
HG_KEY_W = HG_HEADS * HG_DK
HG_VAL_W = HG_HEADS * HG_DV
HG_CHUNK = 64
FOX_HEADS = 8
FOX_DH = D_MODEL // FOX_HEADS
FOX_W = FOX_HEADS * FOX_DH
ATTN_BLOCK = 128
N_GROUPS = 4
EXPERTS_PER_GROUP = 8
N_EXPERTS = N_GROUPS * EXPERTS_PER_GROUP
TOP_K = 2
D_EXPERT = D_MODEL // 2
MOE_BLOCK = 128
IN_SPLITS = (HG_KEY_W, HG_KEY_W, HG_VAL_W, HG_VAL_W, FOX_W, FOX_W, FOX_W, FOX_HEADS, D_MODEL, D_MODEL)
IN_COLS = sum(IN_SPLITS)
ALPHA = (2 * DEPTH) ** 0.25
BETA = (8 * DEPTH) ** -0.25
LN_EPS = 1e-5
NORM_EPS = 1e-6

kernel_name = 'hgrn2_fox_gated_hier_moe_deepnorm'


def layer_norm(x, g, b):
    xf = x.astype(jnp.float32)
    mu = jnp.mean(xf, -1, keepdims=True)
    xc = xf - mu
    var = jnp.mean(xc * xc, -1, keepdims=True)
    return (xc * lax.rsqrt(var + LN_EPS) * g + b).astype(x.dtype)


def rms_norm(x, g):
    xf = x.astype(jnp.float32)
    return xf * lax.rsqrt(jnp.mean(xf * xf, -1, keepdims=True) + NORM_EPS) * g


def to_heads(a, n_heads):
    b, s, _ = a.shape
    return a.reshape(b, s, n_heads, -1).transpose(0, 2, 1, 3)


def from_heads(a):
    b, h, s, d = a.shape
    return a.transpose(0, 2, 1, 3).reshape(b, s, h * d)


def hgrn2_chunkwise(q, k, v, log_f):
    b, h, s, dk = q.shape
    dv = v.shape[-1]
    n = s // HG_CHUNK

    def to_chunks(a):
        return a.reshape(b, h, n, HG_CHUNK, a.shape[-1]).transpose(2, 0, 1, 3, 4)

    causal = jnp.tril(jnp.ones((HG_CHUNK, HG_CHUNK), bool))

    def step(state, inp):
        q_c, k_c, v_c, g_c = inp
        cum = jnp.cumsum(g_c, axis=2)
        diff = cum[:, :, :, None, :] - cum[:, :, None, :, :]
        decay = jnp.exp(jnp.where(causal[:, :, None], diff, -jnp.inf))
        scores = jnp.einsum('bhtk,bhsk,bhtsk->bhts', q_c, k_c, decay)
        o_intra = jnp.einsum('bhts,bhsv->bhtv', scores, v_c)
        o_inter = jnp.einsum('bhtk,bhkv->bhtv', q_c * jnp.exp(cum), state)
        last = cum[:, :, -1:, :]
        k_dec = k_c * jnp.exp(last - cum)
        new_state = jnp.exp(last[:, :, 0, :])[..., None] * state + jnp.einsum('bhsk,bhsv->bhkv', k_dec, v_c)
        return new_state, o_intra + o_inter

    state0 = jnp.zeros((b, h, dk, dv), jnp.float32)
    _, o = lax.scan(step, state0, (to_chunks(q), to_chunks(k), to_chunks(v), to_chunks(log_f)))
    return o.transpose(1, 2, 0, 3, 4).reshape(b, h, s, dv)


def forgetting_attention(q, k, v, log_f):
    s = q.shape[2]
    cum = jnp.cumsum(log_f, axis=-1)
    scale = FOX_DH ** -0.5
    outs = []
    for i in range(s // ATTN_BLOCK):
        lo, hi = i * ATTN_BLOCK, (i + 1) * ATTN_BLOCK
        logits = jnp.einsum('bhtd,bhsd->bhts', q[:, :, lo:hi], k[:, :, :hi]) * scale
        logits = logits + cum[:, :, lo:hi, None] - cum[:, :, None, :hi]
        mask = jnp.arange(hi)[None, :] <= (lo + jnp.arange(ATTN_BLOCK))[:, None]
        p = jax.nn.softmax(jnp.where(mask, logits, -jnp.inf), axis=-1)
        outs.append(jnp.einsum('bhts,bhsd->bhtd', p, v[:, :, :hi]))
    return jnp.concatenate(outs, axis=2)


def hybrid_mixer(x, w_in, b_fox_f, fox_q_gain, fox_k_gain, hg_lb, hg_norm_gain, w_br_a, w_br_b, w_out):
    f32 = jnp.float32
    proj = x @ w_in
    offsets = [int(o) for o in np.cumsum(IN_SPLITS)[:-1]]
    hq, hf, hi, hg, fq, fk, fv, ff, gate_a, gate_b = jnp.split(proj, offsets, axis=-1)
    q_a = jax.nn.silu(to_heads(hq, HG_HEADS).astype(f32))
    lb = hg_lb.reshape(HG_HEADS, 1, HG_DK)
    forget = lb + (1.0 - lb) * jax.nn.sigmoid(to_heads(hf, HG_HEADS).astype(f32))
    o_a = hgrn2_chunkwise(q_a, 1.0 - forget, to_heads(hi, HG_HEADS).astype(f32), jnp.log(forget))
    o_a = from_heads(rms_norm(o_a, hg_norm_gain)) * jax.nn.silu(hg.astype(f32))
    y_a = o_a.astype(x.dtype) @ w_br_a
    q_b = rms_norm(to_heads(fq, FOX_HEADS), fox_q_gain)
    k_b = rms_norm(to_heads(fk, FOX_HEADS), fox_k_gain)
    v_b = to_heads(fv, FOX_HEADS).astype(f32)
    log_f = jax.nn.log_sigmoid((ff + b_fox_f).astype(f32)).transpose(0, 2, 1)
    o_b = from_heads(forgetting_attention(q_b, k_b, v_b, log_f))
    y_b = o_b.astype(x.dtype) @ w_br_b
    merged = jax.nn.sigmoid(gate_a) * y_a + jax.nn.sigmoid(gate_b) * y_b
    return merged @ w_out


def grouped_expert_ffn(xt, expert_idx, w_gate, w_up, w_down):
    t, d = xt.shape
    a = t * TOP_K
    flat_e = expert_idx.reshape(a)
    flat_tok = jnp.arange(a, dtype=jnp.int32) // TOP_K
    order = jnp.argsort(flat_e)
    sorted_e = flat_e[order]
    counts = jnp.bincount(flat_e, length=N_EXPERTS)
    padded = (counts + MOE_BLOCK - 1) // MOE_BLOCK * MOE_BLOCK
    pad_end = jnp.cumsum(padded)
    pad_start = pad_end - padded
    start = jnp.cumsum(counts) - counts
    dest = pad_start[sorted_e] + jnp.arange(a, dtype=jnp.int32) - start[sorted_e]
    n_blocks = -(-a // MOE_BLOCK) + N_EXPERTS
    n_slots = n_blocks * MOE_BLOCK
    slot_tok = jnp.full((n_slots,), t, jnp.int32).at[dest].set(flat_tok[order])
    block_start = jnp.arange(n_blocks, dtype=pad_end.dtype) * MOE_BLOCK
    block_expert = jnp.minimum(jnp.searchsorted(pad_end, block_start, side='right'), N_EXPERTS - 1)
    x_pad = jnp.concatenate([xt, jnp.zeros((1, d), xt.dtype)], axis=0)
    xb = x_pad[slot_tok].reshape(n_blocks, MOE_BLOCK, d)

    def expert_block(args):
        xblk, e = args
        h = jax.nn.silu(xblk @ w_gate[e]) * (xblk @ w_up[e])
        return h @ w_down[e]

    yb = lax.map(expert_block, (xb, block_expert)).reshape(n_slots, d)
    dest_by_assign = jnp.zeros((a,), dest.dtype).at[order].set(dest)
    return yb[dest_by_assign].reshape(t, TOP_K, d)


def hier_moe(x, rg_w, rg_b, re_w, re_b, w_gate, w_up, w_down):
    f32 = jnp.float32
    b, s, d = x.shape
    t = b * s
    xt = x.reshape(t, d)
    g_logits = (xt @ rg_w).astype(f32) + rg_b
    grp = jnp.argmax(g_logits, axis=-1)
    p_grp = jnp.take_along_axis(jax.nn.softmax(g_logits, -1), grp[:, None], axis=-1)
    e_logits = ((xt @ re_w).astype(f32) + re_b).reshape(t, N_GROUPS, EXPERTS_PER_GROUP)
    e_logits = jnp.take_along_axis(e_logits, grp[:, None, None], axis=1)[:, 0]
    top_vals, top_idx = lax.top_k(e_logits, TOP_K)
    gate_w = jax.nn.softmax(top_vals, axis=-1) * p_grp
    expert_idx = grp[:, None].astype(jnp.int32) * EXPERTS_PER_GROUP + top_idx.astype(jnp.int32)
    y = grouped_expert_ffn(xt, expert_idx, w_gate, w_up, w_down)
    out = jnp.einsum('tk,tkd->td', gate_w, y.astype(f32))
    return out.astype(x.dtype).reshape(b, s, d)


def setup_inputs(seed: int = 0) -> dict:
    key = jax.random.key(seed)
    ks = jax.random.split(key, 21)
    L, D = DEPTH, D_MODEL

    def nrm(k, shape, scale):
        return jax.random.normal(k, shape, jnp.float32) * scale

    return {
        'x': nrm(ks[0], (BATCH, SEQ, D), 1.0),
        'w_in': nrm(ks[1], (L, D, IN_COLS), D ** -0.5),
        'b_fox_f': jax.random.uniform(ks[2], (L, FOX_HEADS), jnp.float32, 1.0, 5.0),
        'fox_q_gain': 1.0 + nrm(ks[3], (L, FOX_DH), 0.02),
        'fox_k_gain': 1.0 + nrm(ks[4], (L, FOX_DH), 0.02),
        'hg_lb_logits': nrm(ks[5], (L, HG_KEY_W), 0.1),
        'hg_norm_gain': 1.0 + nrm(ks[6], (L, HG_DV), 0.02),
        'w_br_a': nrm(ks[7], (L, HG_VAL_W, D), BETA * HG_VAL_W ** -0.5),
        'w_br_b': nrm(ks[8], (L, FOX_W, D), BETA * FOX_W ** -0.5),
        'w_out': nrm(ks[9], (L, D, D), BETA * D ** -0.5),
        'ln1_g': 1.0 + nrm(ks[10], (L, D), 0.02),
        'ln1_b': nrm(ks[11], (L, D), 0.02),
        'router_g_w': nrm(ks[12], (L, D, N_GROUPS), D ** -0.5),
        'router_g_b': nrm(ks[13], (L, N_GROUPS), 0.01),
        'router_e_w': nrm(ks[14], (L, D, N_EXPERTS), D ** -0.5),
        'router_e_b': nrm(ks[15], (L, N_EXPERTS), 0.01),
        'w_gate': nrm(ks[16], (L, N_EXPERTS, D, D_EXPERT), D ** -0.5),
        'w_up': nrm(ks[17], (L, N_EXPERTS, D, D_EXPERT), D ** -0.5),
        'w_down': nrm(ks[18], (L, N_EXPERTS, D_EXPERT, D), BETA * D_EXPERT ** -0.5),
        'ln2_g': 1.0 + nrm(ks[19], (L, D), 0.02),
        'ln2_b': nrm(ks[20], (L, D), 0.02),
    }


def reference(x, w_in, b_fox_f, fox_q_gain, fox_k_gain, hg_lb_logits, hg_norm_gain, w_br_a, w_br_b, w_out,
              ln1_g, ln1_b, router_g_w, router_g_b, router_e_w, router_e_b, w_gate, w_up, w_down, ln2_g, ln2_b):
    lb_p = jax.nn.softmax(hg_lb_logits.astype(jnp.float32), axis=0)
    lb_all = jnp.cumsum(lb_p, axis=0) - lb_p[0]
    for l in range(DEPTH):
        h = hybrid_mixer(x, w_in[l], b_fox_f[l], fox_q_gain[l], fox_k_gain[l], lb_all[l], hg_norm_gain[l],
                         w_br_a[l], w_br_b[l], w_out[l])
        x = layer_norm(ALPHA * x + h, ln1_g[l], ln1_b[l])
        f = hier_moe(x, router_g_w[l], router_g_b[l], router_e_w[l], router_e_b[l], w_gate[l], w_up[l], w_down[l])
        x = layer_norm(ALPHA * x + f, ln2_g[l], ln2_b[l])
    return x
```

```cpp
#include <hip/hip_runtime.h>
#include <stdint.h>
#include <stdio.h>

typedef unsigned short bf16_t;
typedef float f32x4 __attribute__((ext_vector_type(4)));
typedef unsigned u32x4 __attribute__((ext_vector_type(4)));
typedef unsigned u32x2 __attribute__((ext_vector_type(2)));
#define LAS __attribute__((address_space(3)))

constexpr int DM = 1024, NB = 4, SEQ = 8192, T = NB * SEQ, DEPTH = 4;
constexpr int NH = 8, DH = 128;
constexpr int IN_COLS = 9224, INP = 9216, FF_COL = 7168;
constexpr int NG = 4, EPG = 8, NE = 32, DE = 512;
constexpr float ALPHA = 1.6817928305074292f;
constexpr float LN_EPS = 1e-5f, NORM_EPS = 1e-6f;
constexpr float SQRT_DH = 11.313708498984761f;
constexpr float ATT_SCALE = 0.08838834764831845f;
constexpr int NSLOT = 2 * T + NE * 256;

constexpr size_t MiB = 1u << 20;
constexpr size_t WS_CTL = 0, CTL_BYTES = 1 * MiB;
constexpr size_t WS_LB = 1 * MiB;
constexpr size_t WS_RWT = 1 * MiB + 65536;
constexpr size_t WS_FFL = 2 * MiB;
constexpr size_t WS_KBIAS = 3 * MiB;
constexpr size_t WS_TOPE = 4 * MiB;
constexpr size_t WS_TOPW = 4 * MiB + 262144;
constexpr size_t WS_TPOS = 4 * MiB + 524288;
constexpr size_t WS_STE = 5 * MiB;
constexpr size_t WS_WIN = 16 * MiB;
constexpr size_t WS_WA = 34 * MiB, WS_WB = 36 * MiB, WS_WO = 38 * MiB;
constexpr size_t WS_WGU = 40 * MiB;
constexpr size_t WS_WD = 104 * MiB;
constexpr size_t WS_XA = 136 * MiB;
constexpr size_t WS_XBF = 264 * MiB;
constexpr size_t WS_QA = 328 * MiB;
constexpr size_t WS_LF = 392 * MiB;
constexpr size_t WS_VA = 520 * MiB;
constexpr size_t WS_GA = 584 * MiB;
constexpr size_t WS_FQ = 648 * MiB;
constexpr size_t WS_FK = 712 * MiB;
constexpr size_t WS_FV = 776 * MiB;
constexpr size_t WS_SGA = 840 * MiB, WS_SGB = 904 * MiB;
constexpr size_t WS_HB = 520 * MiB;
constexpr size_t WS_YB = 592 * MiB;
constexpr size_t WS_END = 968 * MiB;
static_assert(WS_HB + (size_t)NSLOT * 512 * 2 <= WS_YB && WS_YB + (size_t)NSLOT * 1024 * 2 <= WS_SGA, "moe overlay");
constexpr int CW_CNT = 1024;

struct Ctx { const float* in[21]; float* out; unsigned char* ws; };
enum { I_X = 0, I_WIN, I_BFF, I_GQ, I_GK, I_LBL, I_HGN, I_WA, I_WB, I_WO, I_L1G, I_L1B, I_RGW, I_RGB, I_REW, I_REB, I_WG, I_WU, I_WD, I_L2G, I_L2B };

__device__ __forceinline__ float bf2f(bf16_t b) { return __uint_as_float(((unsigned)b) << 16); }
__device__ __forceinline__ unsigned f2bf(float f) { unsigned u = __float_as_uint(f); return (u + 0x7fffu + ((u >> 16) & 1u)) >> 16; }
__device__ __forceinline__ unsigned pk2(float lo, float hi) { return f2bf(lo) | (f2bf(hi) << 16); }
__device__ __forceinline__ float sigm(float x) { return 1.f / (1.f + __expf(-x)); }
__device__ __forceinline__ float silu(float x) { return x / (1.f + __expf(-x)); }
__device__ __forceinline__ float wave_sum(float v) {
#pragma unroll
    for (int o = 1; o < 64; o <<= 1) v += __shfl_xor(v, o);
    return v;
}
__device__ __forceinline__ float wave_max(float v) {
#pragma unroll
    for (int o = 1; o < 64; o <<= 1) v = fmaxf(v, __shfl_xor(v, o));
    return v;
}

struct InProjOut { bf16_t *QA, *VA, *GA, *FQ, *FK, *FV, *SGA, *SGB; float* LF; const float* lb; };
__device__ __forceinline__ InProjOut make_ipo(const Ctx& c) {
    InProjOut o; unsigned char* ws = c.ws;
    o.QA = (bf16_t*)(ws + WS_QA); o.VA = (bf16_t*)(ws + WS_VA); o.GA = (bf16_t*)(ws + WS_GA); o.FQ = (bf16_t*)(ws + WS_FQ); o.FK = (bf16_t*)(ws + WS_FK); o.FV = (bf16_t*)(ws + WS_FV);
    o.SGA = (bf16_t*)(ws + WS_SGA); o.SGB = (bf16_t*)(ws + WS_SGB); o.LF = (float*)(ws + WS_LF); o.lb = (const float*)(ws + WS_LB); return o;
}
__device__ __forceinline__ size_t headmajor(int m, int c) { const int b = m >> 13, s = m & (SEQ - 1), h = c >> 7, d = c & 127; return ((size_t)((b * NH + h) * SEQ + s)) * DH + d; }
__device__ __forceinline__ void inproj_store1(const InProjOut& o, int m, int n, float v) {
    const int reg = n >> 10, c = n & 1023; const size_t tm = (size_t)m * DM + c;
    switch (reg) {
        case 0: o.QA[tm] = (bf16_t)f2bf(silu(v)); break;
        case 1: { const float lb = o.lb[c]; const float f = lb + (1.f - lb) * sigm(v); o.LF[tm] = logf(f); } break;
        case 2: o.VA[tm] = (bf16_t)f2bf(v); break;
        case 3: o.GA[tm] = (bf16_t)f2bf(silu(v)); break;
        case 4: o.FQ[tm] = (bf16_t)f2bf(v); break;
        case 5: o.FK[headmajor(m, c)] = (bf16_t)f2bf(v); break;
        case 6: o.FV[headmajor(m, c)] = (bf16_t)f2bf(v); break;
        case 7: o.SGA[tm] = (bf16_t)f2bf(sigm(v)); break;
        default: o.SGB[tm] = (bf16_t)f2bf(sigm(v)); break;
    }
}

constexpr int NTHR = 512, NWAVE = 8;
struct Wv { int tid, lane, wave, gw, ngw; };
__device__ __forceinline__ Wv make_wv() { Wv w; w.tid = threadIdx.x; w.lane = w.tid & 63; w.wave = __builtin_amdgcn_readfirstlane(w.tid >> 6); w.gw = blockIdx.x * NWAVE + w.wave; w.ngw = gridDim.x * NWAVE; return w; }

__device__ __forceinline__ void transpose_item(const float* src, int ld, int k0, int c0, bf16_t* dst_row0, int K, LAS float* scr, int lane) {
#pragma unroll 8
    for (int i = 0; i < 32; ++i) { const int kk = 2 * i + (lane >> 5); scr[kk * 33 + (lane & 31)] = src[(size_t)(k0 + kk) * ld + c0 + (lane & 31)]; }
    asm volatile("s_waitcnt lgkmcnt(0)" ::: "memory");
    const int c = lane & 7;
#pragma unroll
    for (int j = 0; j < 4; ++j) { const int n = (lane >> 3) + 8 * j; const LAS float* s = scr + (8 * c) * 33 + n;
        u32x4 o; o.x = pk2(s[0 * 33], s[1 * 33]); o.y = pk2(s[2 * 33], s[3 * 33]); o.z = pk2(s[4 * 33], s[5 * 33]); o.w = pk2(s[6 * 33], s[7 * 33]);
        *(u32x4*)(dst_row0 + (size_t)n * K + k0 + 8 * c) = o; }
    asm volatile("s_waitcnt lgkmcnt(0)" ::: "memory");
}
__device__ __forceinline__ void ph_convert(const Ctx& c, int layer, LAS unsigned char* lds) {
    const Wv w = make_wv(); LAS float* scr = (LAS float*)(lds + w.wave * 8448);
    unsigned char* ws = c.ws;
    constexpr int I_IN = 16 * 288, I_SQ = 16 * 32, I_GU = 16 * 16, I_DN = 8 * 32;
    constexpr int NIT = I_IN + 3 * I_SQ + NE * 2 * I_GU + NE * I_DN;
    for (int it = w.gw; it < NIT; it += w.ngw) {
        int r = it;
        if (r < I_IN) { const int kb = r / 288, nb = r % 288, n0 = nb * 32; const int c0 = n0 + (n0 >= FF_COL ? 8 : 0);
            transpose_item(c.in[I_WIN] + (size_t)layer * DM * IN_COLS, IN_COLS, kb * 64, c0, (bf16_t*)(ws + WS_WIN) + (size_t)n0 * DM, DM, scr, w.lane); continue; }
        r -= I_IN;
        if (r < 3 * I_SQ) { const int which = r / I_SQ, q = r % I_SQ, kb = q / 32, nb = q % 32;
            const float* src = c.in[which == 0 ? I_WA : (which == 1 ? I_WB : I_WO)] + (size_t)layer * DM * DM;
            bf16_t* dst = (bf16_t*)(ws + (which == 0 ? WS_WA : (which == 1 ? WS_WB : WS_WO)));
            transpose_item(src, DM, kb * 64, nb * 32, dst + (size_t)(nb * 32) * DM, DM, scr, w.lane); continue; }
        r -= 3 * I_SQ;
        if (r < NE * 2 * I_GU) { const int e = r / (2 * I_GU), q = r % (2 * I_GU), up = q / I_GU, q2 = q % I_GU, kb = q2 / 16, nb = q2 % 16, j0 = nb * 32;
            const float* src = c.in[up ? I_WU : I_WG] + ((size_t)layer * NE + e) * DM * DE;
            const int drow = (j0 >> 7) * 256 + (j0 & 127) + up * 128;
            transpose_item(src, DE, kb * 64, j0, (bf16_t*)(ws + WS_WGU) + ((size_t)e * 1024 + drow) * DM, DM, scr, w.lane); continue; }
        r -= NE * 2 * I_GU;
        { const int e = r / I_DN, q = r % I_DN, kb = q / 32, nb = q % 32;
            const float* src = c.in[I_WD] + ((size_t)layer * NE + e) * DE * DM;
            transpose_item(src, DM, kb * 64, nb * 32, (bf16_t*)(ws + WS_WD) + ((size_t)e * 1024 + nb * 32) * DE, DE, scr, w.lane); }
    }
    const int gt = blockIdx.x * NTHR + w.tid, ngt = gridDim.x * NTHR;
    float* rwt = (float*)(ws + WS_RWT);
    for (int i = gt; i < 36 * DM; i += ngt) { const int j = i / DM, k = i % DM;
        rwt[i] = j < 4 ? c.in[I_RGW][((size_t)layer * DM + k) * NG + j] : c.in[I_REW][((size_t)layer * DM + k) * NE + (j - 4)]; }
    float* lb = (float*)(ws + WS_LB);
    for (int i = gt; i < DM; i += ngt) { float l[DEPTH], mx = -1e30f;
#pragma unroll
        for (int q = 0; q < DEPTH; ++q) { l[q] = c.in[I_LBL][q * DM + i]; mx = fmaxf(mx, l[q]); }
        float s = 0.f, p[DEPTH];
#pragma unroll
        for (int q = 0; q < DEPTH; ++q) { p[q] = expf(l[q] - mx); s += p[q]; }
        float acc = 0.f;
#pragma unroll
        for (int q = 1; q < DEPTH; ++q) if (q <= layer) acc += p[q] / s;
        lb[i] = acc; }
}

__device__ __forceinline__ void emit_xb_ffl(const Ctx& c, int nl, int row, const f32x4 (&v)[4], int lane) {
    bf16_t* xb = (bf16_t*)(c.ws + WS_XBF) + (size_t)row * DM;
#pragma unroll
    for (int j = 0; j < 4; ++j) { u32x2 o; o.x = pk2(v[j][0], v[j][1]); o.y = pk2(v[j][2], v[j][3]); *(u32x2*)(xb + 256 * j + 4 * lane) = o; }
    const float* wbase = c.in[I_WIN] + (size_t)nl * DM * IN_COLS + FF_COL;
    float z[8] = {0.f, 0.f, 0.f, 0.f, 0.f, 0.f, 0.f, 0.f};
#pragma unroll
    for (int j = 0; j < 4; ++j)
#pragma unroll
        for (int i = 0; i < 4; ++i) { const int k = 256 * j + 4 * lane + i; const float* wr = wbase + (size_t)k * IN_COLS;
            const f32x4 w0 = *(const f32x4*)wr, w1 = *(const f32x4*)(wr + 4); const float x = v[j][i];
            z[0] += x * w0[0]; z[1] += x * w0[1]; z[2] += x * w0[2]; z[3] += x * w0[3]; z[4] += x * w1[0]; z[5] += x * w1[1]; z[6] += x * w1[2]; z[7] += x * w1[3]; }
    float zz = 0.f;
#pragma unroll
    for (int h = 0; h < 8; ++h) { const float s = wave_sum(z[h]); zz = (lane == h) ? s : zz; }
    if (lane < 8) { zz += c.in[I_BFF][nl * NH + lane]; ((float*)(c.ws + WS_FFL))[(size_t)row * 8 + lane] = fminf(zz, 0.f) - log1pf(expf(-fabsf(zz))); }
}
__device__ __forceinline__ void ph_xprep(const Ctx& c) {
    const Wv w = make_wv();
    for (int m = w.gw; m < T; m += w.ngw) { const f32x4* xr = (const f32x4*)(c.in[I_X] + (size_t)m * DM) + w.lane; f32x4 v[4];
#pragma unroll
        for (int j = 0; j < 4; ++j) v[j] = xr[64 * j];
        emit_xb_ffl(c, 0, m, v, w.lane); }
}

__device__ __forceinline__ void ph_foxprep(const Ctx& c, int layer, LAS unsigned char* lds) {
    const Wv w = make_wv(); unsigned char* ws = c.ws;
    const int sub = w.lane & 15, grp = w.lane >> 4;
    const int NIT = 2 * T * NH;
    for (int it0 = w.gw * 4; it0 < NIT; it0 += w.ngw * 4) { const int it = it0 + grp; const int tensor = it / (T * NH), r = it % (T * NH);
        bf16_t* p = (bf16_t*)(ws + (tensor ? WS_FK : WS_FQ)) + (size_t)r * DH + sub * 8;
        const float* g = c.in[tensor ? I_GK : I_GQ] + layer * DH + sub * 8;
        const u32x4 raw = *(const u32x4*)p; float x[8];
        x[0] = __uint_as_float(raw.x << 16); x[1] = __uint_as_float(raw.x & 0xffff0000u); x[2] = __uint_as_float(raw.y << 16); x[3] = __uint_as_float(raw.y & 0xffff0000u);
        x[4] = __uint_as_float(raw.z << 16); x[5] = __uint_as_float(raw.z & 0xffff0000u); x[6] = __uint_as_float(raw.w << 16); x[7] = __uint_as_float(raw.w & 0xffff0000u);
        float ss = 0.f;
#pragma unroll
        for (int i = 0; i < 8; ++i) ss += x[i] * x[i];
        ss += __shfl_xor(ss, 1); ss += __shfl_xor(ss, 2); ss += __shfl_xor(ss, 4); ss += __shfl_xor(ss, 8);
        const float sc = rsqrtf(ss * (1.f / DH) + NORM_EPS);
        u32x4 o; o.x = pk2(x[0] * sc * g[0], x[1] * sc * g[1]); o.y = pk2(x[2] * sc * g[2], x[3] * sc * g[3]); o.z = pk2(x[4] * sc * g[4], x[5] * sc * g[5]); o.w = pk2(x[6] * sc * g[6], x[7] * sc * g[7]);
        *(u32x4*)p = o; }
    LAS float* wtot = (LAS float*)lds;
    const float* ffl = (const float*)(ws + WS_FFL); float* kb = (float*)(ws + WS_KBIAS);
    for (int seq = blockIdx.x; seq < NB * NH; seq += gridDim.x) { const int b = seq >> 3, h = seq & 7;
        float loc[16], run = 0.f;
#pragma unroll
        for (int i = 0; i < 16; ++i) { run += ffl[((size_t)(b * SEQ + w.tid * 16 + i)) * 8 + h]; loc[i] = run; }
        float incl = run;
#pragma unroll
        for (int o = 1; o < 64; o <<= 1) { const float t = __shfl_up(incl, o); if (w.lane >= o) incl += t; }
        __syncthreads();
        if (w.lane == 63) wtot[w.wave] = incl;
        __syncthreads();
        float pre = incl - run;
        for (int q = 0; q < w.wave; ++q) pre += wtot[q];
#pragma unroll
        for (int i = 0; i < 16; ++i) kb[(size_t)seq * SEQ + w.tid * 16 + i] = -(pre + loc[i]) * SQRT_DH;
    }
}

__device__ __forceinline__ void ph_ln1_router(const Ctx& c, int layer, LAS unsigned char* lds) {
    const Wv w = make_wv(); unsigned char* ws = c.ws;
    LAS unsigned* lcnt = (LAS unsigned*)lds; LAS unsigned* lbase = lcnt + 32;
    if (w.tid < 64) lcnt[w.tid] = 0u;
    __syncthreads();
    float* X1 = (float*)(ws + WS_LF); bf16_t* X1B = (bf16_t*)(ws + WS_XBF);
    const float* rwt = (const float*)(ws + WS_RWT);
    int* tope = (int*)(ws + WS_TOPE); float* topw = (float*)(ws + WS_TOPW); int* tpos = (int*)(ws + WS_TPOS); int* ste = (int*)(ws + WS_STE);
    const float* g1 = c.in[I_L1G] + layer * DM; const float* b1 = c.in[I_L1B] + layer * DM;
    for (int m = w.gw; m < T; m += w.ngw) {
        f32x4* xr = (f32x4*)(X1 + (size_t)m * DM) + w.lane; f32x4 v[4]; float s = 0.f;
#pragma unroll
        for (int j = 0; j < 4; ++j) { v[j] = xr[64 * j]; s += (v[j][0] + v[j][1]) + (v[j][2] + v[j][3]); }
        const float mean = wave_sum(s) * (1.f / DM); float s2 = 0.f;
#pragma unroll
        for (int j = 0; j < 4; ++j) { v[j] = v[j] - mean; s2 += (v[j][0] * v[j][0] + v[j][1] * v[j][1]) + (v[j][2] * v[j][2] + v[j][3] * v[j][3]); }
        const float rstd = rsqrtf(wave_sum(s2) * (1.f / DM) + LN_EPS);
#pragma unroll
        for (int j = 0; j < 4; ++j) { const f32x4 g = *(const f32x4*)(g1 + 256 * j + 4 * w.lane), bb = *(const f32x4*)(b1 + 256 * j + 4 * w.lane);
            v[j] = v[j] * rstd * g + bb; xr[64 * j] = v[j];
            u32x2 o; o.x = pk2(v[j][0], v[j][1]); o.y = pk2(v[j][2], v[j][3]); *(u32x2*)(X1B + (size_t)m * DM + 256 * j + 4 * w.lane) = o; }
        LAS float* Lw = (LAS float*)(lds + 512) + w.wave * 40;
#pragma unroll 2
        for (int q = 0; q < 36; ++q) { float a = 0.f;
#pragma unroll
            for (int j = 0; j < 4; ++j) { const f32x4 wv = *(const f32x4*)(rwt + q * DM + 256 * j + 4 * w.lane); a += (v[j][0] * wv[0] + v[j][1] * wv[1]) + (v[j][2] * wv[2] + v[j][3] * wv[3]); }
            a = wave_sum(a); if (w.lane == 0) Lw[q] = a; }
        asm volatile("s_waitcnt lgkmcnt(0)" ::: "memory");
        float gl[4];
#pragma unroll
        for (int q = 0; q < 4; ++q) gl[q] = Lw[q] + c.in[I_RGB][layer * NG + q];
        int grp = 0; float gm = gl[0];
#pragma unroll
        for (int q = 1; q < 4; ++q) if (gl[q] > gm) { gm = gl[q]; grp = q; }
        float gs = 0.f;
#pragma unroll
        for (int q = 0; q < 4; ++q) gs += expf(gl[q] - gm);
        const float pg = 1.f / gs;
        float el[8];
#pragma unroll
        for (int i = 0; i < 8; ++i) el[i] = Lw[4 + grp * EPG + i] + c.in[I_REB][layer * NE + grp * EPG + i];
        asm volatile("s_waitcnt lgkmcnt(0)" ::: "memory");
        int i0 = 0; float v0 = el[0];
#pragma unroll
        for (int i = 1; i < 8; ++i) if (el[i] > v0) { v0 = el[i]; i0 = i; }
        int i1 = -1; float v1 = -3.0e38f;
#pragma unroll
        for (int i = 0; i < 8; ++i) if (i != i0 && el[i] > v1) { v1 = el[i]; i1 = i; }
        const float w0 = 1.f / (1.f + expf(v1 - v0));
        if (w.lane == 0) { const int e0 = grp * EPG + i0, e1 = grp * EPG + i1;
            tope[2 * m] = e0; tope[2 * m + 1] = e1; topw[2 * m] = w0 * pg; topw[2 * m + 1] = (1.f - w0) * pg;
            tpos[2 * m] = (int)atomicAdd((unsigned*)&lcnt[e0], 1u); tpos[2 * m + 1] = (int)atomicAdd((unsigned*)&lcnt[e1], 1u); }
    }
    __syncthreads();
    if (w.tid < NE) lbase[w.tid] = atomicAdd((unsigned*)(ws + WS_CTL) + CW_CNT + layer * 64 + w.tid, lcnt[w.tid]);
    __syncthreads();
    for (int m = w.gw; m < T; m += w.ngw) {
        if (w.lane < 2) { const int e = tope[2 * m + w.lane]; const int p = tpos[2 * m + w.lane] + (int)lbase[e]; tpos[2 * m + w.lane] = p; ste[(size_t)e * T + p] = m; }
    }
}

__device__ __forceinline__ void moe_starts(const Ctx& c, int layer, LAS int* start  , LAS int* cnt  ) {
    if (threadIdx.x == 0) { const unsigned* gc = (const unsigned*)(c.ws + WS_CTL) + CW_CNT + layer * 64; int s = 0;
        for (int e = 0; e < NE; ++e) { const int n = (int)__hip_atomic_load(gc + e, __ATOMIC_RELAXED, __HIP_MEMORY_SCOPE_AGENT); cnt[e] = n; start[e] = s; s += (n + 255) & ~255; }
        start[NE] = s; }
    __syncthreads();
}

__device__ __forceinline__ void ph_ln2(const Ctx& c, int layer, LAS unsigned char* lds) {
    const Wv w = make_wv(); unsigned char* ws = c.ws;
    LAS int* start = (LAS int*)lds; LAS int* cnt = start + 40;
    moe_starts(c, layer, start, cnt);
    const float* X1 = (const float*)(ws + WS_LF); const bf16_t* YB = (const bf16_t*)(ws + WS_YB);
    const int* tope = (const int*)(ws + WS_TOPE); const float* topw = (const float*)(ws + WS_TOPW); const int* tpos = (const int*)(ws + WS_TPOS);
    const float* g2 = c.in[I_L2G] + layer * DM; const float* b2 = c.in[I_L2B] + layer * DM;
    float* dst = (layer == DEPTH - 1) ? c.out : (float*)(ws + WS_XA);
    for (int m = w.gw; m < T; m += w.ngw) {
        const int e0 = tope[2 * m], e1 = tope[2 * m + 1]; const float w0 = topw[2 * m], w1 = topw[2 * m + 1];
        const size_t s0 = (size_t)(start[e0] + tpos[2 * m]), s1 = (size_t)(start[e1] + tpos[2 * m + 1]);
        f32x4 v[4]; float s = 0.f;
#pragma unroll
        for (int j = 0; j < 4; ++j) { const f32x4 x = *((const f32x4*)(X1 + (size_t)m * DM) + w.lane + 64 * j);
            const u32x2 a = *(const u32x2*)(YB + s0 * DM + 256 * j + 4 * w.lane), b = *(const u32x2*)(YB + s1 * DM + 256 * j + 4 * w.lane);
            f32x4 ya, yb; ya[0] = __uint_as_float(a.x << 16); ya[1] = __uint_as_float(a.x & 0xffff0000u); ya[2] = __uint_as_float(a.y << 16); ya[3] = __uint_as_float(a.y & 0xffff0000u);
            yb[0] = __uint_as_float(b.x << 16); yb[1] = __uint_as_float(b.x & 0xffff0000u); yb[2] = __uint_as_float(b.y << 16); yb[3] = __uint_as_float(b.y & 0xffff0000u);
            v[j] = x * ALPHA + (ya * w0 + yb * w1); s += (v[j][0] + v[j][1]) + (v[j][2] + v[j][3]); }
        const float mean = wave_sum(s) * (1.f / DM); float s2 = 0.f;
#pragma unroll
        for (int j = 0; j < 4; ++j) { v[j] = v[j] - mean; s2 += (v[j][0] * v[j][0] + v[j][1] * v[j][1]) + (v[j][2] * v[j][2] + v[j][3] * v[j][3]); }
        const float rstd = rsqrtf(wave_sum(s2) * (1.f / DM) + LN_EPS);
#pragma unroll
        for (int j = 0; j < 4; ++j) { const f32x4 g = *(const f32x4*)(g2 + 256 * j + 4 * w.lane), bb = *(const f32x4*)(b2 + 256 * j + 4 * w.lane);
            v[j] = v[j] * rstd * g + bb; *((f32x4*)(dst + (size_t)m * DM) + w.lane + 64 * j) = v[j]; }
        if (layer + 1 < DEPTH) emit_xb_ffl(c, layer + 1, m, v, w.lane);
    }
}

template <int PH> __global__ void __launch_bounds__(NTHR, 2) k_thin(Ctx c, int layer) {
    extern __shared__ __attribute__((aligned(16))) unsigned char lds_raw[];
    LAS unsigned char* lds = (LAS unsigned char*)lds_raw;
    if (PH == 0) ph_convert(c, layer, lds);
    if (PH == 1) ph_xprep(c);
    if (PH == 2) ph_foxprep(c, layer, lds);
    if (PH == 3) ph_ln1_router(c, layer, lds);
    if (PH == 4) ph_ln2(c, layer, lds);
}

namespace nv {
template <class P> __global__ void __launch_bounds__(256) gemm(P p) {
    __shared__ float As[16][68], Bs[16][68], Bs2[P::DUAL ? 16 : 1][68];
    const int tid = threadIdx.x, tx = tid & 15, ty = tid >> 4, m0 = blockIdx.y * 64, n0 = blockIdx.x * 64;
    if (!p.begin_tile(m0)) return;
    float acc[4][4], acc2[4][4];
#pragma unroll
    for (int i = 0; i < 4; ++i)
#pragma unroll
        for (int j = 0; j < 4; ++j) { acc[i][j] = 0.f; acc2[i][j] = 0.f; }
    const int lr = tid >> 2, lk = (tid & 3) * 4;
    const bf16_t* ar = p.a_row(m0 + lr) + lk; const bf16_t* br = p.b_row(n0 + lr) + lk; const bf16_t* br2 = P::DUAL ? p.b_row2(n0 + lr) + lk : br;
    for (int k0 = 0; k0 < p.K; k0 += 16) {
        const u32x2 a = *(const u32x2*)(ar + k0), b = *(const u32x2*)(br + k0);
        As[lk + 0][lr] = __uint_as_float(a.x << 16); As[lk + 1][lr] = __uint_as_float(a.x & 0xffff0000u); As[lk + 2][lr] = __uint_as_float(a.y << 16); As[lk + 3][lr] = __uint_as_float(a.y & 0xffff0000u);
        Bs[lk + 0][lr] = __uint_as_float(b.x << 16); Bs[lk + 1][lr] = __uint_as_float(b.x & 0xffff0000u); Bs[lk + 2][lr] = __uint_as_float(b.y << 16); Bs[lk + 3][lr] = __uint_as_float(b.y & 0xffff0000u);
        if (P::DUAL) { const u32x2 b2 = *(const u32x2*)(br2 + k0);
            Bs2[lk + 0][lr] = __uint_as_float(b2.x << 16); Bs2[lk + 1][lr] = __uint_as_float(b2.x & 0xffff0000u); Bs2[lk + 2][lr] = __uint_as_float(b2.y << 16); Bs2[lk + 3][lr] = __uint_as_float(b2.y & 0xffff0000u); }
        __syncthreads();
#pragma unroll
        for (int kk = 0; kk < 16; ++kk) { float av[4], bv[4], bv2[4];
#pragma unroll
            for (int i = 0; i < 4; ++i) { av[i] = As[kk][ty * 4 + i]; bv[i] = Bs[kk][tx * 4 + i]; bv2[i] = P::DUAL ? Bs2[kk][tx * 4 + i] : 0.f; }
#pragma unroll
            for (int i = 0; i < 4; ++i)
#pragma unroll
                for (int j = 0; j < 4; ++j) { acc[i][j] += av[i] * bv[j]; if (P::DUAL) acc2[i][j] += av[i] * bv2[j]; } }
        __syncthreads();
    }
#pragma unroll
    for (int i = 0; i < 4; ++i)
#pragma unroll
        for (int j = 0; j < 4; ++j) p.store(m0 + ty * 4 + i, n0 + tx * 4 + j, acc[i][j], acc2[i][j]);
}
struct PInProj { static constexpr bool DUAL = false; const bf16_t* A; const bf16_t* Bt; InProjOut o; int K, pad;
    __device__ bool begin_tile(int) { return true; }
    __device__ const bf16_t* a_row(int m) const { return A + (size_t)m * DM; }
    __device__ const bf16_t* b_row(int n) const { return Bt + (size_t)n * DM; }
    __device__ const bf16_t* b_row2(int n) const { return nullptr; }
    __device__ void store(int m, int n, float v, float) const { inproj_store1(o, m, n, v); } };
struct PMerge { static constexpr bool DUAL = false; const bf16_t* A; const bf16_t* Bt; const bf16_t* gate; float* P1; bf16_t* MG; int K, pass;
    __device__ bool begin_tile(int) { return true; }
    __device__ const bf16_t* a_row(int m) const { return A + (size_t)m * DM; }
    __device__ const bf16_t* b_row(int n) const { return Bt + (size_t)n * DM; }
    __device__ const bf16_t* b_row2(int n) const { return nullptr; }
    __device__ void store(int m, int n, float v, float) const { const size_t i = (size_t)m * DM + n; const float g = bf2f(gate[i]);
        if (pass == 0) P1[i] = g * v; else MG[i] = (bf16_t)f2bf(P1[i] + g * v); } };
struct POut { static constexpr bool DUAL = false; const bf16_t* A; const bf16_t* Bt; const float* x; float* Y; int K, pad;
    __device__ bool begin_tile(int) { return true; }
    __device__ const bf16_t* a_row(int m) const { return A + (size_t)m * DM; }
    __device__ const bf16_t* b_row(int n) const { return Bt + (size_t)n * DM; }
    __device__ const bf16_t* b_row2(int n) const { return nullptr; }
    __device__ void store(int m, int n, float v, float) const { const size_t i = (size_t)m * DM + n; Y[i] = ALPHA * x[i] + v; } };
struct PMoeUp { static constexpr bool DUAL = true; const bf16_t* X1B; const bf16_t* WGU; const int* ste; const unsigned* gcnt; bf16_t* HB; int K, e, base, n_e;
    __device__ bool begin_tile(int m0) { int s = 0; e = -1;
        for (int q = 0; q < NE; ++q) { const int n = (int)gcnt[q], pn = (n + 255) & ~255; if (m0 >= s && m0 < s + pn) { e = q; base = s; n_e = n; } s += pn; }
        return e >= 0 && m0 - base < n_e; }
    __device__ const bf16_t* a_row(int m) const { const int i = m - base; const int tok = i < n_e ? ste[(size_t)e * T + i] : 0; return X1B + (size_t)tok * DM; }
    __device__ const bf16_t* b_row(int n) const { return WGU + ((size_t)e * 1024 + ((n >> 7) * 256 + (n & 127))) * DM; }
    __device__ const bf16_t* b_row2(int n) const { return b_row(n) + (size_t)128 * DM; }
    __device__ void store(int m, int n, float g, float u) const { HB[(size_t)m * DE + n] = (bf16_t)f2bf(silu(g) * u); } };
struct PMoeDn { static constexpr bool DUAL = false; const bf16_t* HB; const bf16_t* WD; const unsigned* gcnt; bf16_t* YB; int K, e, base, n_e;
    __device__ bool begin_tile(int m0) { int s = 0; e = -1;
        for (int q = 0; q < NE; ++q) { const int n = (int)gcnt[q], pn = (n + 255) & ~255; if (m0 >= s && m0 < s + pn) { e = q; base = s; n_e = n; } s += pn; }
        return e >= 0 && m0 - base < n_e; }
    __device__ const bf16_t* a_row(int m) const { return HB + (size_t)m * DE; }
    __device__ const bf16_t* b_row(int n) const { return WD + ((size_t)e * 1024 + n) * DE; }
    __device__ const bf16_t* b_row2(int n) const { return nullptr; }
    __device__ void store(int m, int n, float v, float) const { YB[(size_t)m * DM + n] = (bf16_t)f2bf(v); } };

__global__ void __launch_bounds__(128) hgrn2(const bf16_t* QA, const float* LF, const bf16_t* VA, const bf16_t* GA, const float* gain, bf16_t* OA) {
    __shared__ float sq[16][128], sf[16][128], sk[16][128], so[16][128], red[16][2];
    const int b = blockIdx.x >> 3, h = blockIdx.x & 7, vi = threadIdx.x, lane = vi & 63, wv = vi >> 6;
    float S[128];
#pragma unroll
    for (int k = 0; k < 128; ++k) S[k] = 0.f;
    const float gn = gain[vi];
    for (int t0 = 0; t0 < SEQ; t0 += 16) {
        for (int j = 0; j < 16; ++j) { const size_t idx = ((size_t)(b * SEQ + t0 + j)) * DM + h * DH + vi;
            sq[j][vi] = bf2f(QA[idx]); const float f = expf(LF[idx]); sf[j][vi] = f; sk[j][vi] = 1.f - f; so[j][vi] = bf2f(VA[idx]); }
        __syncthreads();
        for (int j = 0; j < 16; ++j) { const float vj = so[j][vi]; float a = 0.f;
#pragma unroll
            for (int k = 0; k < 128; ++k) { S[k] = sf[j][k] * S[k] + sk[j][k] * vj; a += sq[j][k] * S[k]; }
            so[j][vi] = a;
            const float ss = wave_sum(a * a); if (lane == 0) red[j][wv] = ss; }
        __syncthreads();
        for (int j = 0; j < 16; ++j) { const size_t idx = ((size_t)(b * SEQ + t0 + j)) * DM + h * DH + vi;
            const float r = rsqrtf((red[j][0] + red[j][1]) * (1.f / DH) + NORM_EPS);
            OA[idx] = (bf16_t)f2bf(so[j][vi] * r * gn * bf2f(GA[idx])); }
        __syncthreads();
    }
}
__global__ void __launch_bounds__(256) attn(const bf16_t* FQ, const bf16_t* FK, const bf16_t* FV, const float* KBIAS, bf16_t* OB) {
    __shared__ float sq[4][8][128], sp[4][8][64];
    const int tid = threadIdx.x, lane = tid & 63, wv = tid >> 6;
    const int bh = blockIdx.x >> 8, blk = blockIdx.x & 255, b = bh >> 3, h = bh & 7, t0 = blk * 32 + wv * 8;
    for (int r = 0; r < 8; ++r) { const bf16_t* q = FQ + ((size_t)(b * SEQ + t0 + r)) * DM + h * DH; sq[wv][r][lane] = bf2f(q[lane]); sq[wv][r][lane + 64] = bf2f(q[lane + 64]); }
    __syncthreads();
    const bf16_t* Kh = FK + (size_t)bh * SEQ * DH; const bf16_t* Vh = FV + (size_t)bh * SEQ * DH; const float* kb = KBIAS + (size_t)bh * SEQ;
    float mrun[8], lrun[8], o0[8], o1[8];
#pragma unroll
    for (int r = 0; r < 8; ++r) { mrun[r] = -1e30f; lrun[r] = 0.f; o0[r] = 0.f; o1[r] = 0.f; }
    for (int s0 = 0; s0 <= t0 + 7; s0 += 64) {
        const int s = s0 + lane; float sc[8];
#pragma unroll
        for (int r = 0; r < 8; ++r) sc[r] = 0.f;
        const bf16_t* kr = Kh + (size_t)s * DH;
        for (int d = 0; d < 128; d += 8) { const u32x4 raw = *(const u32x4*)(kr + d); float kf[8];
            kf[0] = __uint_as_float(raw.x << 16); kf[1] = __uint_as_float(raw.x & 0xffff0000u); kf[2] = __uint_as_float(raw.y << 16); kf[3] = __uint_as_float(raw.y & 0xffff0000u);
            kf[4] = __uint_as_float(raw.z << 16); kf[5] = __uint_as_float(raw.z & 0xffff0000u); kf[6] = __uint_as_float(raw.w << 16); kf[7] = __uint_as_float(raw.w & 0xffff0000u);
#pragma unroll
            for (int r = 0; r < 8; ++r)
#pragma unroll
                for (int i = 0; i < 8; ++i) sc[r] += kf[i] * sq[wv][r][d + i]; }
        const float bias = kb[s];
#pragma unroll
        for (int r = 0; r < 8; ++r) { float z = (s <= t0 + r) ? (sc[r] + bias) * ATT_SCALE : -__builtin_inff();
            const float mx = wave_max(z), mn = fmaxf(mrun[r], mx), al = __expf(mrun[r] - mn), p = __expf(z - mn);
            lrun[r] = lrun[r] * al + wave_sum(p); o0[r] *= al; o1[r] *= al; mrun[r] = mn; sp[wv][r][lane] = p; }
        asm volatile("s_waitcnt lgkmcnt(0)" ::: "memory");
        for (int j = 0; j < 64; ++j) { const unsigned vv = *(const unsigned*)(Vh + (size_t)(s0 + j) * DH + 2 * lane); const float v0 = __uint_as_float(vv << 16), v1 = __uint_as_float(vv & 0xffff0000u);
#pragma unroll
            for (int r = 0; r < 8; ++r) { const float p = sp[wv][r][j]; o0[r] += p * v0; o1[r] += p * v1; } }
    }
#pragma unroll
    for (int r = 0; r < 8; ++r) { const float il = 1.f / lrun[r]; *(unsigned*)(OB + ((size_t)(b * SEQ + t0 + r)) * DM + h * DH + 2 * lane) = pk2(o0[r] * il, o1[r] * il); }
}
}

extern "C" void kernel_launch(void* const* d_in, const int* in_sizes, int n_in, void* d_out, int out_size, void* d_ws, size_t ws_size, hipStream_t stream) {
    static int ok = 0;
    if (ok == 0) {
        if (n_in != 21 || in_sizes[0] != T * DM || out_size != T * DM || ws_size < WS_END) { fprintf(stderr, "kernel_launch: unexpected shapes (n_in %d in0 %d out %d ws %zu, need ws >= %zu)\n", n_in, n_in > 0 ? in_sizes[0] : -1, out_size, ws_size, (size_t)WS_END); ok = -1; return; }
        hipFuncSetAttribute((const void*)k_thin<0>, hipFuncAttributeMaxDynamicSharedMemorySize, 69632);
        ok = 1;
    }
    if (ok < 0) return;
    hipMemsetAsync((char*)d_ws + WS_CTL, 0, CTL_BYTES, stream);
    Ctx c{};
    for (int i = 0; i < 21; ++i) c.in[i] = (const float*)d_in[i];
    c.out = (float*)d_out; c.ws = (unsigned char*)d_ws;
    unsigned char* ws = c.ws;
    const int G = 256;
    hipLaunchKernelGGL(k_thin<1>, dim3(G), dim3(NTHR), 0, stream, c, 0);
    for (int l = 0; l < DEPTH; ++l) {
        hipLaunchKernelGGL(k_thin<0>, dim3(G), dim3(NTHR), 69632, stream, c, l);
        InProjOut ipo; ipo.QA = (bf16_t*)(ws + WS_QA); ipo.VA = (bf16_t*)(ws + WS_VA); ipo.GA = (bf16_t*)(ws + WS_GA); ipo.FQ = (bf16_t*)(ws + WS_FQ); ipo.FK = (bf16_t*)(ws + WS_FK); ipo.FV = (bf16_t*)(ws + WS_FV);
        ipo.SGA = (bf16_t*)(ws + WS_SGA); ipo.SGB = (bf16_t*)(ws + WS_SGB); ipo.LF = (float*)(ws + WS_LF); ipo.lb = (const float*)(ws + WS_LB);
        { nv::PInProj p{(const bf16_t*)(ws + WS_XBF), (const bf16_t*)(ws + WS_WIN), ipo, DM, 0};
          hipLaunchKernelGGL(nv::gemm<nv::PInProj>, dim3(INP / 64, T / 64), dim3(256), 0, stream, p); }
        hipLaunchKernelGGL(k_thin<2>, dim3(G), dim3(NTHR), 4096, stream, c, l);
        hipLaunchKernelGGL(nv::hgrn2, dim3(NB * NH), dim3(128), 0, stream, (const bf16_t*)(ws + WS_QA), (const float*)(ws + WS_LF), (const bf16_t*)(ws + WS_VA), (const bf16_t*)(ws + WS_GA),
                           (const float*)d_in[I_HGN] + l * DH, (bf16_t*)(ws + WS_QA));
        hipLaunchKernelGGL(nv::attn, dim3(NB * NH * 256), dim3(256), 0, stream, (const bf16_t*)(ws + WS_FQ), (const bf16_t*)(ws + WS_FK), (const bf16_t*)(ws + WS_FV), (const float*)(ws + WS_KBIAS), (bf16_t*)(ws + WS_FQ));
        { nv::PMerge p{(const bf16_t*)(ws + WS_QA), (const bf16_t*)(ws + WS_WA), (const bf16_t*)(ws + WS_SGA), (float*)(ws + WS_LF), (bf16_t*)(ws + WS_VA), DM, 0};
          hipLaunchKernelGGL(nv::gemm<nv::PMerge>, dim3(DM / 64, T / 64), dim3(256), 0, stream, p);
          nv::PMerge p2{(const bf16_t*)(ws + WS_FQ), (const bf16_t*)(ws + WS_WB), (const bf16_t*)(ws + WS_SGB), (float*)(ws + WS_LF), (bf16_t*)(ws + WS_VA), DM, 1};
          hipLaunchKernelGGL(nv::gemm<nv::PMerge>, dim3(DM / 64, T / 64), dim3(256), 0, stream, p2); }
        { nv::POut p{(const bf16_t*)(ws + WS_VA), (const bf16_t*)(ws + WS_WO), l == 0 ? (const float*)d_in[I_X] : (const float*)(ws + WS_XA), (float*)(ws + WS_LF), DM, 0};
          hipLaunchKernelGGL(nv::gemm<nv::POut>, dim3(DM / 64, T / 64), dim3(256), 0, stream, p); }
        hipLaunchKernelGGL(k_thin<3>, dim3(G), dim3(NTHR), 4096, stream, c, l);
        const unsigned* gcnt = (const unsigned*)(ws + WS_CTL) + CW_CNT + l * 64;
        { nv::PMoeUp p{(const bf16_t*)(ws + WS_XBF), (const bf16_t*)(ws + WS_WGU), (const int*)(ws + WS_STE), gcnt, (bf16_t*)(ws + WS_HB), DM, 0, 0, 0};
          hipLaunchKernelGGL(nv::gemm<nv::PMoeUp>, dim3(DE / 64, NSLOT / 64), dim3(256), 0, stream, p); }
        { nv::PMoeDn p{(const bf16_t*)(ws + WS_HB), (const bf16_t*)(ws + WS_WD), gcnt, (bf16_t*)(ws + WS_YB), DE, 0, 0, 0};
          hipLaunchKernelGGL(nv::gemm<nv::PMoeDn>, dim3(DM / 64, NSLOT / 64), dim3(256), 0, stream, p); }
        hipLaunchKernelGGL(k_thin<4>, dim3(G), dim3(NTHR), 4096, stream, c, l);
    }
}
```

```cpp
#include <hip/hip_runtime.h>
#include <stdint.h>
#include <stdio.h>

typedef unsigned short bf16_t;
typedef float f32x4 __attribute__((ext_vector_type(4)));
typedef unsigned u32x4 __attribute__((ext_vector_type(4)));
typedef unsigned u32x2 __attribute__((ext_vector_type(2)));
#define LAS __attribute__((address_space(3)))

constexpr int DM = 1024, NB = 4, SEQ = 8192, T = NB * SEQ, DEPTH = 4;
constexpr int NH = 8, DH = 128;
constexpr int IN_COLS = 9224, INP = 9216, FF_COL = 7168;
constexpr int NG = 4, EPG = 8, NE = 32, DE = 512;
constexpr float ALPHA = 1.6817928305074292f;
constexpr float LN_EPS = 1e-5f, NORM_EPS = 1e-6f;
constexpr float SQRT_DH = 11.313708498984761f;
constexpr float ATT_SCALE = 0.08838834764831845f;
constexpr int NSLOT = 2 * T + NE * 256;

constexpr size_t MiB = 1u << 20;
constexpr size_t WS_CTL = 0, CTL_BYTES = 1 * MiB;
constexpr size_t WS_LB = 1 * MiB;
constexpr size_t WS_RWT = 1 * MiB + 65536;
constexpr size_t WS_FFL = 2 * MiB;
constexpr size_t WS_KBIAS = 3 * MiB;
constexpr size_t WS_TOPE = 4 * MiB;
constexpr size_t WS_TOPW = 4 * MiB + 262144;
constexpr size_t WS_TPOS = 4 * MiB + 524288;
constexpr size_t WS_STE = 5 * MiB;
constexpr size_t WS_WIN = 16 * MiB;
constexpr size_t WS_WA = 34 * MiB, WS_WB = 36 * MiB, WS_WO = 38 * MiB;
constexpr size_t WS_WGU = 40 * MiB;
constexpr size_t WS_WD = 104 * MiB;
constexpr size_t WS_XA = 136 * MiB;
constexpr size_t WS_XBF = 264 * MiB;
constexpr size_t WS_QA = 328 * MiB;
constexpr size_t WS_LF = 392 * MiB;
constexpr size_t WS_VA = 520 * MiB;
constexpr size_t WS_GA = 584 * MiB;
constexpr size_t WS_FQ = 648 * MiB;
constexpr size_t WS_FK = 712 * MiB;
constexpr size_t WS_FV = 776 * MiB;
constexpr size_t WS_SGA = 840 * MiB, WS_SGB = 904 * MiB;
constexpr size_t WS_HB = 520 * MiB;
constexpr size_t WS_YB = 592 * MiB;
constexpr size_t WS_END = 968 * MiB;
static_assert(WS_HB + (size_t)NSLOT * 512 * 2 <= WS_YB && WS_YB + (size_t)NSLOT * 1024 * 2 <= 840 * MiB, "moe overlay");
constexpr int CW_CNT = 1024;

struct KArgs { const float* in[21]; float* out; unsigned char* ws; };
extern __shared__ __attribute__((aligned(16))) unsigned char g_lds[];
constexpr int LDS_STAGE_BYTES = 131072, LDS_MISC = LDS_STAGE_BYTES, LDS_CTX = LDS_MISC + 2048, LDS_TOTAL = LDS_MISC + 4096;
typedef __attribute__((address_space(4))) const unsigned long long cu64_t;
__device__ __forceinline__ void* ctx_ptr(int i) {
    const uintptr_t k = (uintptr_t)__builtin_amdgcn_kernarg_segment_ptr();
    unsigned lo = (unsigned)k, hi = (unsigned)(k >> 32); asm volatile("" : "+s"(lo), "+s"(hi));
    cu64_t* t = (cu64_t*)(((uintptr_t)hi << 32) | lo);
    return (void*)(uintptr_t)t[i];
}
struct Ctx {
    struct In { __device__ __forceinline__ const float* operator[](int i) const { return (const float*)ctx_ptr(i); } } in;
    __device__ __forceinline__ float* outp() const { return (float*)ctx_ptr(21); }
};
__device__ __forceinline__ unsigned char* wsl(const Ctx&) { return (unsigned char*)ctx_ptr(22); }
enum { I_X = 0, I_WIN, I_BFF, I_GQ, I_GK, I_LBL, I_HGN, I_WA, I_WB, I_WO, I_L1G, I_L1B, I_RGW, I_RGB, I_REW, I_REB, I_WG, I_WU, I_WD, I_L2G, I_L2B };

typedef __bf16 bf16v2_t __attribute__((ext_vector_type(2)));
typedef float f32v2_t __attribute__((ext_vector_type(2)));
__device__ __forceinline__ unsigned cvt_pk_bf16(float lo, float hi) { f32v2_t v = {lo, hi}; bf16v2_t b = __builtin_convertvector(v, bf16v2_t); return __builtin_bit_cast(unsigned, b); }
__device__ __forceinline__ int bidx() { int b = blockIdx.x; asm volatile("" : "+s"(b)); return b; }
__device__ __forceinline__ int tidx() { int t = threadIdx.x; asm volatile("" : "+v"(t)); return t; }
__device__ __forceinline__ float bf2f(bf16_t b) { return __uint_as_float(((unsigned)b) << 16); }
__device__ __forceinline__ unsigned f2bf(float f) { unsigned u = __float_as_uint(f); return (u + 0x7fffu + ((u >> 16) & 1u)) >> 16; }
__device__ __forceinline__ unsigned pk2(float lo, float hi) { return f2bf(lo) | (f2bf(hi) << 16); }
__device__ __forceinline__ float sigm(float x) { return 1.f / (1.f + __expf(-x)); }
__device__ __forceinline__ float silu(float x) { return x / (1.f + __expf(-x)); }
__device__ __forceinline__ float wave_sum(float v) {
#pragma unroll
    for (int o = 1; o < 64; o <<= 1) v += __shfl_xor(v, o);
    return v;
}
__device__ __forceinline__ float wave_max(float v) {
#pragma unroll
    for (int o = 1; o < 64; o <<= 1) v = fmaxf(v, __shfl_xor(v, o));
    return v;
}

struct InProjOut { bf16_t *QA, *VA, *GA, *FQ, *FK, *FV, *SGA, *SGB; float* LF; const float* lb; };
__device__ __forceinline__ InProjOut make_ipo(const Ctx& c) {
    InProjOut o; unsigned char* ws = wsl(c);
    o.QA = (bf16_t*)(ws + WS_QA); o.VA = (bf16_t*)(ws + WS_VA); o.GA = (bf16_t*)(ws + WS_GA); o.FQ = (bf16_t*)(ws + WS_FQ); o.FK = (bf16_t*)(ws + WS_FK); o.FV = (bf16_t*)(ws + WS_FV);
    o.SGA = (bf16_t*)(ws + WS_SGA); o.SGB = (bf16_t*)(ws + WS_SGB); o.LF = (float*)(ws + WS_LF); o.lb = (const float*)(ws + WS_LB); return o;
}
__device__ __forceinline__ size_t headmajor(int m, int c) { const int b = m >> 13, s = m & (SEQ - 1), h = c >> 7, d = c & 127; return ((size_t)((b * NH + h) * SEQ + s)) * DH + d; }
__device__ __forceinline__ void inproj_store1(const InProjOut& o, int m, int n, float v) {
    const int reg = n >> 10, c = n & 1023; const size_t tm = (size_t)m * DM + c;
    switch (reg) {
        case 0: o.QA[tm] = (bf16_t)f2bf(silu(v)); break;
        case 1: { const float lb = o.lb[c]; const float f = lb + (1.f - lb) * sigm(v); o.LF[tm] = logf(f); } break;
        case 2: o.VA[tm] = (bf16_t)f2bf(v); break;
        case 3: o.GA[tm] = (bf16_t)f2bf(silu(v)); break;
        case 4: o.FQ[tm] = (bf16_t)f2bf(v); break;
        case 5: o.FK[headmajor(m, c)] = (bf16_t)f2bf(v); break;
        case 6: o.FV[headmajor(m, c)] = (bf16_t)f2bf(v); break;
        case 7: o.SGA[tm] = (bf16_t)f2bf(sigm(v)); break;
        default: o.SGB[tm] = (bf16_t)f2bf(sigm(v)); break;
    }
}

constexpr int NTHR = 512, NWAVE = 8;
struct Wv { int tid, lane, wave, gw, ngw; };
__device__ __forceinline__ Wv make_wv() { Wv w; w.tid = tidx(); w.lane = w.tid & 63; w.wave = __builtin_amdgcn_readfirstlane(w.tid >> 6); w.gw = bidx() * NWAVE + w.wave; w.ngw = gridDim.x * NWAVE; return w; }

__device__ __forceinline__ void transpose_item(const float* src, int ld, int k0, int c0, bf16_t* dst_row0, int K, LAS float* scr, int lane) {
#pragma unroll 8
    for (int i = 0; i < 32; ++i) { const int kk = 2 * i + (lane >> 5); scr[kk * 33 + (lane & 31)] = src[(size_t)(k0 + kk) * ld + c0 + (lane & 31)]; }
    asm volatile("s_waitcnt lgkmcnt(0)" ::: "memory");
    const int c = lane & 7;
#pragma unroll
    for (int j = 0; j < 4; ++j) { const int n = (lane >> 3) + 8 * j; const LAS float* s = scr + (8 * c) * 33 + n;
        u32x4 o; o.x = pk2(s[0 * 33], s[1 * 33]); o.y = pk2(s[2 * 33], s[3 * 33]); o.z = pk2(s[4 * 33], s[5 * 33]); o.w = pk2(s[6 * 33], s[7 * 33]);
        *(u32x4*)(dst_row0 + (size_t)n * K + k0 + 8 * c) = o; }
    asm volatile("s_waitcnt lgkmcnt(0)" ::: "memory");
}
__device__ __forceinline__ void ph_convert(const Ctx& c, int layer, LAS unsigned char* lds) {
    const Wv w = make_wv(); LAS float* scr = (LAS float*)(lds + w.wave * 8448);
    unsigned char* ws = wsl(c);
    constexpr int I_IN = 16 * 288, I_SQ = 16 * 32, I_GU = 16 * 16, I_DN = 8 * 32;
    constexpr int NIT = I_IN + 3 * I_SQ + NE * 2 * I_GU + NE * I_DN;
    for (int it = w.gw; it < NIT; it += w.ngw) {
        int r = it;
        if (r < I_IN) { const int kb = r / 288, nb = r % 288, n0 = nb * 32; const int c0 = n0 + (n0 >= FF_COL ? 8 : 0);
            transpose_item(c.in[I_WIN] + (size_t)layer * DM * IN_COLS, IN_COLS, kb * 64, c0, (bf16_t*)(ws + WS_WIN) + (size_t)n0 * DM, DM, scr, w.lane); continue; }
        r -= I_IN;
        if (r < 3 * I_SQ) { const int which = r / I_SQ, q = r % I_SQ, kb = q / 32, nb = q % 32;
            const float* src = c.in[which == 0 ? I_WA : (which == 1 ? I_WB : I_WO)] + (size_t)layer * DM * DM;
            bf16_t* dst = (bf16_t*)(ws + (which == 0 ? WS_WA : (which == 1 ? WS_WB : WS_WO)));
            transpose_item(src, DM, kb * 64, nb * 32, dst + (size_t)(nb * 32) * DM, DM, scr, w.lane); continue; }
        r -= 3 * I_SQ;
        if (r < NE * 2 * I_GU) { const int e = r / (2 * I_GU), q = r % (2 * I_GU), up = q / I_GU, q2 = q % I_GU, kb = q2 / 16, nb = q2 % 16, j0 = nb * 32;
            const float* src = c.in[up ? I_WU : I_WG] + ((size_t)layer * NE + e) * DM * DE;
            const int drow = (j0 >> 7) * 256 + (j0 & 127) + up * 128;
            transpose_item(src, DE, kb * 64, j0, (bf16_t*)(ws + WS_WGU) + ((size_t)e * 1024 + drow) * DM, DM, scr, w.lane); continue; }
        r -= NE * 2 * I_GU;
        { const int e = r / I_DN, q = r % I_DN, kb = q / 32, nb = q % 32;
            const float* src = c.in[I_WD] + ((size_t)layer * NE + e) * DE * DM;
            transpose_item(src, DM, kb * 64, nb * 32, (bf16_t*)(ws + WS_WD) + ((size_t)e * 1024 + nb * 32) * DE, DE, scr, w.lane); }
    }
    const int gt = bidx() * NTHR + w.tid, ngt = gridDim.x * NTHR;
    float* rwt = (float*)(ws + WS_RWT);
    for (int i = gt; i < 36 * DM; i += ngt) { const int j = i / DM, k = i % DM;
        rwt[i] = j < 4 ? c.in[I_RGW][((size_t)layer * DM + k) * NG + j] : c.in[I_REW][((size_t)layer * DM + k) * NE + (j - 4)]; }
    float* lb = (float*)(ws + WS_LB);
    for (int i = gt; i < DM; i += ngt) { float l[DEPTH], mx = -1e30f;
#pragma unroll
        for (int q = 0; q < DEPTH; ++q) { l[q] = c.in[I_LBL][q * DM + i]; mx = fmaxf(mx, l[q]); }
        float s = 0.f, p[DEPTH];
#pragma unroll
        for (int q = 0; q < DEPTH; ++q) { p[q] = expf(l[q] - mx); s += p[q]; }
        float acc = 0.f;
#pragma unroll
        for (int q = 1; q < DEPTH; ++q) if (q <= layer) acc += p[q] / s;
        lb[i] = acc; }
}

__device__ __forceinline__ void emit_xb_ffl(const Ctx& c, int nl, int row, const f32x4 (&v)[4], int lane) {
    unsigned char* wsb = wsl(c); bf16_t* xb = (bf16_t*)(wsb + WS_XBF) + (size_t)row * DM;
#pragma unroll
    for (int j = 0; j < 4; ++j) { u32x2 o; o.x = pk2(v[j][0], v[j][1]); o.y = pk2(v[j][2], v[j][3]); *(u32x2*)(xb + 256 * j + 4 * lane) = o; }
    const float* wbase = c.in[I_WIN] + (size_t)nl * DM * IN_COLS + FF_COL;
    float z[8] = {0.f, 0.f, 0.f, 0.f, 0.f, 0.f, 0.f, 0.f};
#pragma unroll
    for (int j = 0; j < 4; ++j)
#pragma unroll
        for (int i = 0; i < 4; ++i) { const int k = 256 * j + 4 * lane + i; const float* wr = wbase + (size_t)k * IN_COLS;
            const f32x4 w0 = *(const f32x4*)wr, w1 = *(const f32x4*)(wr + 4); const float x = v[j][i];
            z[0] += x * w0[0]; z[1] += x * w0[1]; z[2] += x * w0[2]; z[3] += x * w0[3]; z[4] += x * w1[0]; z[5] += x * w1[1]; z[6] += x * w1[2]; z[7] += x * w1[3]; }
    float zz = 0.f;
#pragma unroll
    for (int h = 0; h < 8; ++h) { const float s = wave_sum(z[h]); zz = (lane == h) ? s : zz; }
    if (lane < 8) { zz += c.in[I_BFF][nl * NH + lane]; ((float*)(wsb + WS_FFL))[(size_t)row * 8 + lane] = fminf(zz, 0.f) - log1pf(expf(-fabsf(zz))); }
}
__device__ __forceinline__ void ph_xprep(const Ctx& c) {
    const Wv w = make_wv();
    for (int m = w.gw; m < T; m += w.ngw) { const f32x4* xr = (const f32x4*)(c.in[I_X] + (size_t)m * DM) + w.lane; f32x4 v[4];
#pragma unroll
        for (int j = 0; j < 4; ++j) v[j] = xr[64 * j];
        emit_xb_ffl(c, 0, m, v, w.lane); }
}

__device__ __forceinline__ void ph_foxprep(const Ctx& c, int layer, LAS unsigned char* lds) {
    const Wv w = make_wv(); unsigned char* ws = wsl(c);
    const int sub = w.lane & 15, grp = w.lane >> 4;
    const int NIT = 2 * T * NH;
    for (int it0 = w.gw * 4; it0 < NIT; it0 += w.ngw * 4) { const int it = it0 + grp; const int tensor = it / (T * NH), r = it % (T * NH);
        bf16_t* p = (bf16_t*)(ws + (tensor ? WS_FK : WS_FQ)) + (size_t)r * DH + sub * 8;
        const float* g = c.in[tensor ? I_GK : I_GQ] + layer * DH + sub * 8;
        const u32x4 raw = *(const u32x4*)p; float x[8];
        x[0] = __uint_as_float(raw.x << 16); x[1] = __uint_as_float(raw.x & 0xffff0000u); x[2] = __uint_as_float(raw.y << 16); x[3] = __uint_as_float(raw.y & 0xffff0000u);
        x[4] = __uint_as_float(raw.z << 16); x[5] = __uint_as_float(raw.z & 0xffff0000u); x[6] = __uint_as_float(raw.w << 16); x[7] = __uint_as_float(raw.w & 0xffff0000u);
        float ss = 0.f;
#pragma unroll
        for (int i = 0; i < 8; ++i) ss += x[i] * x[i];
        ss += __shfl_xor(ss, 1); ss += __shfl_xor(ss, 2); ss += __shfl_xor(ss, 4); ss += __shfl_xor(ss, 8);
        const float sc = rsqrtf(ss * (1.f / DH) + NORM_EPS);
        u32x4 o; o.x = pk2(x[0] * sc * g[0], x[1] * sc * g[1]); o.y = pk2(x[2] * sc * g[2], x[3] * sc * g[3]); o.z = pk2(x[4] * sc * g[4], x[5] * sc * g[5]); o.w = pk2(x[6] * sc * g[6], x[7] * sc * g[7]);
        *(u32x4*)p = o; }
    LAS float* wtot = (LAS float*)lds;
    const float* ffl = (const float*)(ws + WS_FFL); float* kb = (float*)(ws + WS_KBIAS);
    for (int seq = bidx(); seq < NB * NH; seq += gridDim.x) { const int b = seq >> 3, h = seq & 7;
        float loc[16], run = 0.f;
#pragma unroll
        for (int i = 0; i < 16; ++i) { run += ffl[((size_t)(b * SEQ + w.tid * 16 + i)) * 8 + h]; loc[i] = run; }
        float incl = run;
#pragma unroll
        for (int o = 1; o < 64; o <<= 1) { const float t = __shfl_up(incl, o); if (w.lane >= o) incl += t; }
        __syncthreads();
        if (w.lane == 63) wtot[w.wave] = incl;
        __syncthreads();
        float pre = incl - run;
        for (int q = 0; q < w.wave; ++q) pre += wtot[q];
#pragma unroll
        for (int i = 0; i < 16; ++i) kb[(size_t)seq * SEQ + w.tid * 16 + i] = -(pre + loc[i]) * SQRT_DH;
    }
}

__device__ __forceinline__ void ph_ln1_router(const Ctx& c, int layer, LAS unsigned char* lds) {
    const Wv w = make_wv(); unsigned char* ws = wsl(c);
    LAS unsigned* lcnt = (LAS unsigned*)lds; LAS unsigned* lbase = lcnt + 32;
    if (w.tid < 64) lcnt[w.tid] = 0u;
    __syncthreads();
    float* X1 = (float*)(ws + WS_LF); bf16_t* X1B = (bf16_t*)(ws + WS_XBF);
    const float* rwt = (const float*)(ws + WS_RWT);
    int* tope = (int*)(ws + WS_TOPE); float* topw = (float*)(ws + WS_TOPW); int* tpos = (int*)(ws + WS_TPOS); int* ste = (int*)(ws + WS_STE);
    const float* g1 = c.in[I_L1G] + layer * DM; const float* b1 = c.in[I_L1B] + layer * DM;
    for (int m = w.gw; m < T; m += w.ngw) {
        f32x4* xr = (f32x4*)(X1 + (size_t)m * DM) + w.lane; f32x4 v[4]; float s = 0.f;
#pragma unroll
        for (int j = 0; j < 4; ++j) { v[j] = xr[64 * j]; s += (v[j][0] + v[j][1]) + (v[j][2] + v[j][3]); }
        const float mean = wave_sum(s) * (1.f / DM); float s2 = 0.f;
#pragma unroll
        for (int j = 0; j < 4; ++j) { v[j] = v[j] - mean; s2 += (v[j][0] * v[j][0] + v[j][1] * v[j][1]) + (v[j][2] * v[j][2] + v[j][3] * v[j][3]); }
        const float rstd = rsqrtf(wave_sum(s2) * (1.f / DM) + LN_EPS);
#pragma unroll
        for (int j = 0; j < 4; ++j) { const f32x4 g = *(const f32x4*)(g1 + 256 * j + 4 * w.lane), bb = *(const f32x4*)(b1 + 256 * j + 4 * w.lane);
            v[j] = v[j] * rstd * g + bb; xr[64 * j] = v[j];
            u32x2 o; o.x = pk2(v[j][0], v[j][1]); o.y = pk2(v[j][2], v[j][3]); *(u32x2*)(X1B + (size_t)m * DM + 256 * j + 4 * w.lane) = o; }
        LAS float* Lw = (LAS float*)(lds + 512) + w.wave * 40;
#pragma unroll 2
        for (int q = 0; q < 36; ++q) { float a = 0.f;
#pragma unroll
            for (int j = 0; j < 4; ++j) { const f32x4 wv = *(const f32x4*)(rwt + q * DM + 256 * j + 4 * w.lane); a += (v[j][0] * wv[0] + v[j][1] * wv[1]) + (v[j][2] * wv[2] + v[j][3] * wv[3]); }
            a = wave_sum(a); if (w.lane == 0) Lw[q] = a; }
        asm volatile("s_waitcnt lgkmcnt(0)" ::: "memory");
        float gl[4];
#pragma unroll
        for (int q = 0; q < 4; ++q) gl[q] = Lw[q] + c.in[I_RGB][layer * NG + q];
        int grp = 0; float gm = gl[0];
#pragma unroll
        for (int q = 1; q < 4; ++q) if (gl[q] > gm) { gm = gl[q]; grp = q; }
        float gs = 0.f;
#pragma unroll
        for (int q = 0; q < 4; ++q) gs += expf(gl[q] - gm);
        const float pg = 1.f / gs;
        float el[8];
#pragma unroll
        for (int i = 0; i < 8; ++i) el[i] = Lw[4 + grp * EPG + i] + c.in[I_REB][layer * NE + grp * EPG + i];
        asm volatile("s_waitcnt lgkmcnt(0)" ::: "memory");
        int i0 = 0; float v0 = el[0];
#pragma unroll
        for (int i = 1; i < 8; ++i) if (el[i] > v0) { v0 = el[i]; i0 = i; }
        int i1 = -1; float v1 = -3.0e38f;
#pragma unroll
        for (int i = 0; i < 8; ++i) if (i != i0 && el[i] > v1) { v1 = el[i]; i1 = i; }
        const float w0 = 1.f / (1.f + expf(v1 - v0));
        if (w.lane == 0) { const int e0 = grp * EPG + i0, e1 = grp * EPG + i1;
            tope[2 * m] = e0; tope[2 * m + 1] = e1; topw[2 * m] = w0 * pg; topw[2 * m + 1] = (1.f - w0) * pg;
            tpos[2 * m] = (int)atomicAdd((unsigned*)&lcnt[e0], 1u); tpos[2 * m + 1] = (int)atomicAdd((unsigned*)&lcnt[e1], 1u); }
    }
    __syncthreads();
    if (w.tid < NE) lbase[w.tid] = atomicAdd((unsigned*)(ws + WS_CTL) + CW_CNT + layer * 64 + w.tid, lcnt[w.tid]);
    __syncthreads();
    for (int m = w.gw; m < T; m += w.ngw) {
        if (w.lane < 2) { const int e = tope[2 * m + w.lane]; const int p = tpos[2 * m + w.lane] + (int)lbase[e]; tpos[2 * m + w.lane] = p; ste[(size_t)e * T + p] = m; }
    }
}

__device__ __forceinline__ void moe_starts(const Ctx& c, int layer, LAS int* start  , LAS int* cnt  ) {
    const unsigned* gc = (const unsigned*)(wsl(c) + WS_CTL) + CW_CNT + layer * 64;
    if (threadIdx.x == 0) { int s = 0;
        for (int e = 0; e < NE; ++e) { const int n = (int)__hip_atomic_load(gc + e, __ATOMIC_RELAXED, __HIP_MEMORY_SCOPE_AGENT); cnt[e] = n; start[e] = s; s += (n + 255) & ~255; }
        start[NE] = s; }
    __syncthreads();
}

__device__ __forceinline__ void ph_ln2(const Ctx& c, int layer, LAS unsigned char* lds) {
    const Wv w = make_wv(); unsigned char* ws = wsl(c);
    LAS int* start = (LAS int*)lds; LAS int* cnt = start + 40;
    moe_starts(c, layer, start, cnt);
    const float* X1 = (const float*)(ws + WS_LF); const bf16_t* YB = (const bf16_t*)(ws + WS_YB);
    const int* tope = (const int*)(ws + WS_TOPE); const float* topw = (const float*)(ws + WS_TOPW); const int* tpos = (const int*)(ws + WS_TPOS);
    const float* g2 = c.in[I_L2G] + layer * DM; const float* b2 = c.in[I_L2B] + layer * DM;
    float* dst = (layer == DEPTH - 1) ? c.outp() : (float*)(ws + WS_XA);
    for (int m = w.gw; m < T; m += w.ngw) {
        const int e0 = tope[2 * m], e1 = tope[2 * m + 1]; const float w0 = topw[2 * m], w1 = topw[2 * m + 1];
        const size_t s0 = (size_t)(start[e0] + tpos[2 * m]), s1 = (size_t)(start[e1] + tpos[2 * m + 1]);
        f32x4 v[4]; float s = 0.f;
#pragma unroll
        for (int j = 0; j < 4; ++j) { const f32x4 x = *((const f32x4*)(X1 + (size_t)m * DM) + w.lane + 64 * j);
            const u32x2 a = *(const u32x2*)(YB + s0 * DM + 256 * j + 4 * w.lane), b = *(const u32x2*)(YB + s1 * DM + 256 * j + 4 * w.lane);
            f32x4 ya, yb; ya[0] = __uint_as_float(a.x << 16); ya[1] = __uint_as_float(a.x & 0xffff0000u); ya[2] = __uint_as_float(a.y << 16); ya[3] = __uint_as_float(a.y & 0xffff0000u);
            yb[0] = __uint_as_float(b.x << 16); yb[1] = __uint_as_float(b.x & 0xffff0000u); yb[2] = __uint_as_float(b.y << 16); yb[3] = __uint_as_float(b.y & 0xffff0000u);
            v[j] = x * ALPHA + (ya * w0 + yb * w1); s += (v[j][0] + v[j][1]) + (v[j][2] + v[j][3]); }
        const float mean = wave_sum(s) * (1.f / DM); float s2 = 0.f;
#pragma unroll
        for (int j = 0; j < 4; ++j) { v[j] = v[j] - mean; s2 += (v[j][0] * v[j][0] + v[j][1] * v[j][1]) + (v[j][2] * v[j][2] + v[j][3] * v[j][3]); }
        const float rstd = rsqrtf(wave_sum(s2) * (1.f / DM) + LN_EPS);
#pragma unroll
        for (int j = 0; j < 4; ++j) { const f32x4 g = *(const f32x4*)(g2 + 256 * j + 4 * w.lane), bb = *(const f32x4*)(b2 + 256 * j + 4 * w.lane);
            v[j] = v[j] * rstd * g + bb; *((f32x4*)(dst + (size_t)m * DM) + w.lane + 64 * j) = v[j]; }
        if (layer + 1 < DEPTH) emit_xb_ffl(c, layer + 1, m, v, w.lane);
    }
}


namespace pg8 {
typedef short bf16x8 __attribute__((ext_vector_type(8)));
constexpr int BM = 256, BK = 64, HALF = 128, HTB = HALF * BK * 2, STAGE_BYTES = 8 * HTB, NXCD = 8, WGM = 8;
__host__ __device__ __forceinline__ int lds_byte(int r, int c) { const int st = (r >> 4) * 2 + (c >> 5), rr = r & 15, cc = c & 31, ob = rr * 64 + cc * 2; return st * 1024 + (ob ^ (((ob >> 9) & 1) << 5)); }
__host__ __device__ __forceinline__ void stage_rc(int b, int& R, int& C) { const int st = b / 1024, sb = b % 1024, swz = sb ^ (((sb >> 9) & 1) << 5); R = (st >> 1) * 16 + swz / 64; C = (st & 1) * 32 + (swz % 64) / 2; }
__host__ __device__ __forceinline__ int perm32(int rho) { const int n = rho >> 4, i = rho & 15; return 8 * (i >> 2) + 4 * n + (i & 3); }
struct Unit { int pm, pn, e, rt; };
using ::cvt_pk_bf16;

struct StaticOrder {
    static constexpr bool GATHER = false;
    const char* A; const char* Bt; int nM, nN, nwg, G, c; size_t a_tstep, b_tstep;
    __device__ void init(const void* A_, const void* Bt_, int M, int N, int K, int G_, int c_) { A = (const char*)A_; Bt = (const char*)Bt_; nM = M / BM; nN = N / BM; nwg = nM * nN; G = G_; c = c_; a_tstep = (size_t)BM * K * 2; b_tstep = a_tstep; }
    __device__ bool next(int i, Unit& u) const {
        const long L = (long)i * G + c; if (L >= nwg) return false;
        int wgid = (int)L; { const int q = nwg / NXCD, r = nwg % NXCD, xcd = wgid % NXCD, off = wgid / NXCD; wgid = (xcd < r ? xcd * (q + 1) : r * (q + 1) + (xcd - r) * q) + off; }
        const int nig = WGM * nN, gid = wgid / nig, fm = gid * WGM, gsz = (nM - fm) < WGM ? (nM - fm) : WGM;
        u.pm = fm + ((wgid % nig) % gsz); u.pn = (wgid % nig) / gsz; u.e = 0; u.rt = 0; return true;
    }
    __device__ __forceinline__ const char* a_base(const Unit& u) const { return A + (size_t)u.pm * a_tstep; }
    __device__ __forceinline__ const char* b_base(const Unit& u) const { return Bt + (size_t)u.pn * b_tstep; }
    __device__ __forceinline__ int tok(const Unit&, int) const { return 0; }
};
template <bool UP> struct MoeOrder {
    static constexpr bool GATHER = UP;
    const char* A; const char* Bt; const int* ste; LAS const int* tp; LAS const int* start; LAS const int* cnt; int G, c;
    __device__ bool next(int i, Unit& u) const {
        const int L = i * G + c; if (L >= tp[NE] * 4) return false;
        const int rtg = L >> 2; int e = 0;
        for (int q = 1; q < NE; ++q) if (rtg >= tp[q]) e = q;
        u.e = e; u.rt = rtg - tp[e]; u.pm = (start[e] >> 8) + u.rt; u.pn = L & 3; return true;
    }
    __device__ __forceinline__ const char* a_base(const Unit& u) const { return UP ? A : A + (size_t)u.pm * (BM * DE * 2); }
    __device__ __forceinline__ const char* b_base(const Unit& u) const { return Bt + ((size_t)u.e * 1024 + u.pn * 256) * (UP ? DM : DE) * 2; }
    __device__ __forceinline__ int tok(const Unit& u, int r) const { const int i = u.rt * 256 + r; return i < cnt[u.e] ? ste[(size_t)u.e * T + i] : 0; }
};

template <int ACT> __device__ __forceinline__ float actf(float x) {
    if (ACT == 1) return x * __builtin_amdgcn_rcpf(1.f + __expf(-x));
    if (ACT == 2) return __builtin_amdgcn_rcpf(1.f + __expf(-x));
    return x;
}
template <int ACT> __device__ __forceinline__ u32x4 pack8_act(const f32x4 a, const f32x4 b) {
    u32x4 w; w.x = cvt_pk_bf16(actf<ACT>(a[0]), actf<ACT>(a[1])); w.y = cvt_pk_bf16(actf<ACT>(a[2]), actf<ACT>(a[3])); w.z = cvt_pk_bf16(actf<ACT>(b[0]), actf<ACT>(b[1])); w.w = cvt_pk_bf16(actf<ACT>(b[2]), actf<ACT>(b[3])); return w;
}
__device__ __forceinline__ void unpack8(const u32x4 r, f32x4& a, f32x4& b) {
    a[0] = __uint_as_float(r.x << 16); a[1] = __uint_as_float(r.x & 0xffff0000u); a[2] = __uint_as_float(r.y << 16); a[3] = __uint_as_float(r.y & 0xffff0000u);
    b[0] = __uint_as_float(r.z << 16); b[1] = __uint_as_float(r.z & 0xffff0000u); b[2] = __uint_as_float(r.w << 16); b[3] = __uint_as_float(r.w & 0xffff0000u);
}
struct EpiInProj {
    static constexpr bool PERM = true;
    InProjOut o;
    template <int ACT, bool HM> __device__ __forceinline__ void st16(bf16_t* base, const f32x4 (&acc)[2][2][4][2], int row0, int ctile, int wc, int fq) const {
#pragma unroll
        for (int ai = 0; ai < 2; ++ai)
#pragma unroll
            for (int m = 0; m < 4; ++m) { const int row = row0 + ai * HALF + m * 16;
                const size_t ro = HM ? ((size_t)((row >> 13) * (NH * SEQ) + (row & (SEQ - 1)))) * DH : (size_t)row * DM;
#pragma unroll
                for (int bj = 0; bj < 2; ++bj) { const int c0 = ctile + 128 * bj + 32 * wc + 8 * fq;
                    const size_t co = HM ? (size_t)(c0 >> 7) * SEQ * DH + (c0 & 127) : (size_t)c0;
                    *(u32x4*)(base + ro + co) = pack8_act<ACT>(acc[ai][bj][m][0], acc[ai][bj][m][1]); } }
    }
    __device__ __forceinline__ void operator()(const f32x4 (&acc)[2][2][4][2], const Unit& u, int wr, int wc, int fr, int fq) const {
        const int region = u.pn >> 2, ctile = (u.pn & 3) * 256, row0 = u.pm * BM + wr * 64 + fr;
        if (region == 0) st16<1, false>(o.QA, acc, row0, ctile, wc, fq);
        else if (region == 2) st16<0, false>(o.VA, acc, row0, ctile, wc, fq);
        else if (region == 3) st16<1, false>(o.GA, acc, row0, ctile, wc, fq);
        else if (region == 4) st16<0, false>(o.FQ, acc, row0, ctile, wc, fq);
        else if (region == 5) st16<0, true>(o.FK, acc, row0, ctile, wc, fq);
        else if (region == 6) st16<0, true>(o.FV, acc, row0, ctile, wc, fq);
        else if (region == 7) st16<2, false>(o.SGA, acc, row0, ctile, wc, fq);
        else if (region == 8) st16<2, false>(o.SGB, acc, row0, ctile, wc, fq);
        else {
#pragma unroll
            for (int bj = 0; bj < 2; ++bj) { const int c0 = ctile + 128 * bj + 32 * wc + 8 * fq;
                const f32x4 l0 = *(const f32x4*)(o.lb + c0), l1 = *(const f32x4*)(o.lb + c0 + 4);
#pragma unroll
                for (int ai = 0; ai < 2; ++ai)
#pragma unroll
                    for (int m = 0; m < 4; ++m) { const int row = row0 + ai * HALF + m * 16; float* p = o.LF + (size_t)row * DM + c0;
                        f32x4 r0, r1;
#pragma unroll
                        for (int j = 0; j < 4; ++j) { r0[j] = __logf(l0[j] + (1.f - l0[j]) * actf<2>(acc[ai][bj][m][0][j])); r1[j] = __logf(l1[j] + (1.f - l1[j]) * actf<2>(acc[ai][bj][m][1][j])); }
                        *(f32x4*)p = r0; *(f32x4*)(p + 4) = r1; } }
        }
    }
};
template <int PASS> struct EpiMerge {
    static constexpr bool PERM = true;
    const bf16_t* gate; float* P1; bf16_t* MG;
    __device__ __forceinline__ void operator()(const f32x4 (&acc)[2][2][4][2], const Unit& u, int wr, int wc, int fr, int fq) const {
        const int row0 = u.pm * BM + wr * 64 + fr, cb = u.pn * BM + 32 * wc + 8 * fq;
#pragma unroll
        for (int ai = 0; ai < 2; ++ai)
#pragma unroll
            for (int m = 0; m < 4; ++m) { const size_t ro = (size_t)(row0 + ai * HALF + m * 16) * DM;
#pragma unroll
                for (int bj = 0; bj < 2; ++bj) { const size_t i = ro + cb + 128 * bj; f32x4 g0, g1; unpack8(*(const u32x4*)(gate + i), g0, g1);
                    if (PASS == 0) { *(f32x4*)(P1 + i) = g0 * acc[ai][bj][m][0]; *(f32x4*)(P1 + i + 4) = g1 * acc[ai][bj][m][1]; }
                    else { const f32x4 p0 = *(const f32x4*)(P1 + i), p1 = *(const f32x4*)(P1 + i + 4);
                        *(u32x4*)(MG + i) = pack8_act<0>(p0 + g0 * acc[ai][bj][m][0], p1 + g1 * acc[ai][bj][m][1]); } }
                asm volatile("" ::: "memory"); }
    }
};
struct EpiOut {
    static constexpr bool PERM = true;
    const float* x; float* Y;
    __device__ __forceinline__ void operator()(const f32x4 (&acc)[2][2][4][2], const Unit& u, int wr, int wc, int fr, int fq) const {
        const int row0 = u.pm * BM + wr * 64 + fr, cb = u.pn * BM + 32 * wc + 8 * fq;
#pragma unroll
        for (int ai = 0; ai < 2; ++ai)
#pragma unroll
            for (int m = 0; m < 4; ++m) { const size_t ro = (size_t)(row0 + ai * HALF + m * 16) * DM;
#pragma unroll
                for (int bj = 0; bj < 2; ++bj) { const size_t i = ro + cb + 128 * bj; const f32x4 x0 = *(const f32x4*)(x + i), x1 = *(const f32x4*)(x + i + 4);
                    *(f32x4*)(Y + i) = x0 * ALPHA + acc[ai][bj][m][0]; *(f32x4*)(Y + i + 4) = x1 * ALPHA + acc[ai][bj][m][1]; }
                asm volatile("" ::: "memory"); }
    }
};
struct EpiMoeUp {
    static constexpr bool PERM = true;
    bf16_t* HB;
    __device__ __forceinline__ void operator()(const f32x4 (&acc)[2][2][4][2], const Unit& u, int wr, int wc, int fr, int fq) const {
        const int row0 = u.pm * BM + wr * 64 + fr, j0 = u.pn * 128 + 32 * wc + 8 * fq;
#pragma unroll
        for (int ai = 0; ai < 2; ++ai)
#pragma unroll
            for (int m = 0; m < 4; ++m) { f32x4 h0, h1;
#pragma unroll
                for (int j = 0; j < 4; ++j) { h0[j] = actf<1>(acc[ai][0][m][0][j]) * acc[ai][1][m][0][j]; h1[j] = actf<1>(acc[ai][0][m][1][j]) * acc[ai][1][m][1][j]; }
                *(u32x4*)(HB + (size_t)(row0 + ai * HALF + m * 16) * DE + j0) = pack8_act<0>(h0, h1); }
    }
};
struct EpiMoeDn {
    static constexpr bool PERM = true;
    bf16_t* YB;
    __device__ __forceinline__ void operator()(const f32x4 (&acc)[2][2][4][2], const Unit& u, int wr, int wc, int fr, int fq) const {
        const int row0 = u.pm * BM + wr * 64 + fr, cb = u.pn * BM + 32 * wc + 8 * fq;
#pragma unroll
        for (int ai = 0; ai < 2; ++ai)
#pragma unroll
            for (int m = 0; m < 4; ++m)
#pragma unroll
                for (int bj = 0; bj < 2; ++bj) *(u32x4*)(YB + (size_t)(row0 + ai * HALF + m * 16) * DM + cb + 128 * bj) = pack8_act<0>(acc[ai][bj][m][0], acc[ai][bj][m][1]);
    }
};

template <int K, class Epi, class Sched>
__device__ __forceinline__ void gemm_phase(LAS unsigned char* lds, const Sched& S, const Epi& E) {
    const int tid = tidx(), wid = __builtin_amdgcn_readfirstlane(tid >> 6), lane = tid & 63, wr = wid >> 2, wc = wid & 3, fr = lane & 15, fq = lane >> 4;
    constexpr int nt = K / BK;
    int RA[2]; unsigned CA2[2], voffB[2], voffA[2][2], voffN[2][2];
#pragma unroll
    for (int i = 0; i < 2; ++i) { int R, C; stage_rc(tid * 16 + i * 8192, R, C); const int Rb = Epi::PERM ? ((R & ~31) + perm32(R & 31)) : R;
        RA[i] = R; CA2[i] = (unsigned)C * 2u; voffB[i] = (unsigned)(Rb * K + C) * 2u; }
    const size_t kstep = (size_t)(BK * 2), hstepB = (size_t)HALF * K * 2;
    const unsigned ldsw = (unsigned)wid * 1024u;
    const int aoff = lds_byte(wr * 64 + fr, fq * 8), boff = lds_byte(wc * 32 + fr, fq * 8);
#define PG8_SA(b, h) (((b) * 2 + (h)) * HTB)
#define PG8_SB(b, h) ((4 + (b) * 2 + (h)) * HTB)
#define PG8_STAGE(bufoff, gbase, voff) do { _Pragma("unroll") for (int _i = 0; _i < 2; ++_i) \
        __builtin_amdgcn_global_load_lds((const unsigned*)((const char*)(gbase) + (voff)[_i]), (LAS unsigned*)(lds + (bufoff) + ldsw + _i * 8192), 16, 0, 0); } while (0)
#define PG8_LDA(dst, b, h) do { _Pragma("unroll") for (int m = 0; m < 4; ++m) _Pragma("unroll") for (int k = 0; k < 2; ++k) dst[m][k] = *(const LAS bf16x8*)(lds + PG8_SA(b, h) + aoff + m * 2048 + k * 1024); } while (0)
#define PG8_LDB(dst, b, h) do { _Pragma("unroll") for (int n = 0; n < 2; ++n) _Pragma("unroll") for (int k = 0; k < 2; ++k) dst[n][k] = *(const LAS bf16x8*)(lds + PG8_SB(b, h) + boff + n * 2048 + k * 1024); } while (0)
#define PG8_MMA(ai, bj, At, Bt) do { __builtin_amdgcn_s_setprio(1); _Pragma("unroll") for (int m = 0; m < 4; ++m) _Pragma("unroll") for (int n = 0; n < 2; ++n) _Pragma("unroll") for (int k = 0; k < 2; ++k) \
        acc[ai][bj][m][n] = __builtin_amdgcn_mfma_f32_16x16x32_bf16(Bt[n][k], At[m][k], acc[ai][bj][m][n], 0, 0, 0); __builtin_amdgcn_s_setprio(0); } while (0)
#define PG8_WAIT_V(n) asm volatile("s_waitcnt vmcnt(" #n ")" ::: "memory")
#define PG8_WAIT_L(n) asm volatile("s_waitcnt lgkmcnt(" #n ")" ::: "memory")
#define PG8_BAR __builtin_amdgcn_s_barrier()
#define PG8_SCHED __builtin_amdgcn_sched_barrier(0)
#define PG8_SETOFF(dst, u) do { _Pragma("unroll") for (int _h = 0; _h < 2; ++_h) _Pragma("unroll") for (int _i = 0; _i < 2; ++_i) \
        dst[_h][_i] = Sched::GATHER ? (unsigned)S.tok(u, RA[_i] + HALF * _h) * (unsigned)(K * 2) + CA2[_i] : (unsigned)((RA[_i] + HALF * _h) * K * 2) + CA2[_i]; } while (0)
    Unit cur, nxt; int ui = 0;
    if (!S.next(0, cur)) return;
    f32x4 acc[2][2][4][2];
#pragma unroll
    for (int a = 0; a < 2; ++a)
#pragma unroll
        for (int b = 0; b < 2; ++b)
#pragma unroll
            for (int m = 0; m < 4; ++m)
#pragma unroll
                for (int n = 0; n < 2; ++n) acc[a][b][m][n] = (f32x4){0.f, 0.f, 0.f, 0.f};
    bf16x8 At[4][2], B0[2][2], B1[2][2];
    PG8_SETOFF(voffA, cur);
    const char* cA = S.a_base(cur); const char* cB = S.b_base(cur);
    PG8_STAGE(PG8_SB(0, 0), cB, voffB); PG8_STAGE(PG8_SA(0, 0), cA, voffA[0]); PG8_STAGE(PG8_SB(0, 1), cB + hstepB, voffB); PG8_STAGE(PG8_SA(0, 1), cA, voffA[1]);
    if (wr == 1) PG8_BAR;
    PG8_WAIT_V(4); PG8_BAR;
    PG8_STAGE(PG8_SB(1, 0), cB + kstep, voffB); PG8_STAGE(PG8_SA(1, 0), cA + kstep, voffA[0]); PG8_STAGE(PG8_SB(1, 1), cB + hstepB + kstep, voffB);
    PG8_WAIT_V(6); PG8_BAR;
    for (;;) {
        const bool has_next = S.next(ui + 1, nxt);
        const char* nA = has_next ? S.a_base(nxt) : cA; const char* nB = has_next ? S.b_base(nxt) : cB;
        if (Sched::GATHER && has_next) { PG8_SETOFF(voffN, nxt); }
        else {
#pragma unroll
            for (int h = 0; h < 2; ++h)
#pragma unroll
                for (int i = 0; i < 2; ++i) voffN[h][i] = voffA[h][i]; }
        if (Sched::GATHER) asm volatile("" : "+v"(voffN[0][0]), "+v"(voffN[0][1]), "+v"(voffN[1][0]), "+v"(voffN[1][1]));
        for (int t = 0; t < nt; t += 2) {
            const bool last = (t == nt - 2);
            const char* a1 = cA + (size_t)(t + 1) * kstep;
            const char* a2 = last ? nA : cA + (size_t)(t + 2) * kstep; const char* b2 = last ? nB : cB + (size_t)(t + 2) * kstep;
            const char* a3 = a2 + kstep; const char* b3 = b2 + kstep;
            unsigned v2[2][2];
#pragma unroll
            for (int h = 0; h < 2; ++h)
#pragma unroll
                for (int i = 0; i < 2; ++i) v2[h][i] = last ? voffN[h][i] : voffA[h][i];
            PG8_LDB(B0, 0, 0); PG8_SCHED; PG8_LDA(At, 0, 0); PG8_STAGE(PG8_SA(1, 1), a1, voffA[1]);
            PG8_WAIT_L(8); PG8_BAR; PG8_WAIT_L(0); PG8_MMA(0, 0, At, B0); PG8_BAR; PG8_SCHED;
            PG8_LDB(B1, 0, 1); PG8_STAGE(PG8_SB(0, 0), b2, voffB);
            PG8_BAR; PG8_WAIT_L(0); PG8_MMA(0, 1, At, B1); PG8_BAR;
            PG8_LDA(At, 0, 1); PG8_STAGE(PG8_SA(0, 0), a2, v2[0]);
            PG8_BAR; PG8_WAIT_L(0); PG8_MMA(1, 0, At, B0); PG8_BAR; PG8_SCHED;
            PG8_STAGE(PG8_SB(0, 1), b2 + hstepB, voffB);
            PG8_WAIT_V(6); PG8_BAR; PG8_MMA(1, 1, At, B1); PG8_BAR;
            PG8_LDB(B0, 1, 0); PG8_SCHED; PG8_LDA(At, 1, 0); PG8_STAGE(PG8_SA(0, 1), a2, v2[1]);
            PG8_WAIT_L(8); PG8_BAR; PG8_WAIT_L(0); PG8_MMA(0, 0, At, B0); PG8_BAR; PG8_SCHED;
            PG8_LDB(B1, 1, 1); PG8_STAGE(PG8_SB(1, 0), b3, voffB);
            PG8_BAR; PG8_WAIT_L(0); PG8_MMA(0, 1, At, B1); PG8_BAR;
            PG8_LDA(At, 1, 1); PG8_STAGE(PG8_SA(1, 0), a3, v2[0]);
            PG8_BAR; PG8_WAIT_L(0); PG8_MMA(1, 0, At, B0); PG8_BAR; PG8_SCHED;
            PG8_STAGE(PG8_SB(1, 1), b3 + hstepB, voffB);
            PG8_WAIT_V(6); PG8_BAR; PG8_MMA(1, 1, At, B1); PG8_BAR;
        }
        E(acc, cur, wr, wc, fr, fq);
        if (!has_next) break;
#pragma unroll
        for (int a = 0; a < 2; ++a)
#pragma unroll
            for (int b = 0; b < 2; ++b)
#pragma unroll
                for (int m = 0; m < 4; ++m)
#pragma unroll
                    for (int n = 0; n < 2; ++n) acc[a][b][m][n] = (f32x4){0.f, 0.f, 0.f, 0.f};
        cur = nxt; cA = nA; cB = nB; ++ui;
#pragma unroll
        for (int h = 0; h < 2; ++h)
#pragma unroll
            for (int i = 0; i < 2; ++i) voffA[h][i] = voffN[h][i];
    }
    PG8_WAIT_V(0);
    if (wr == 0) PG8_BAR;
    PG8_BAR;
#undef PG8_SA
#undef PG8_SB
#undef PG8_STAGE
#undef PG8_LDA
#undef PG8_LDB
#undef PG8_MMA
#undef PG8_WAIT_V
#undef PG8_WAIT_L
#undef PG8_BAR
#undef PG8_SCHED
#undef PG8_SETOFF
}
}


namespace fa {
typedef short bf16x8 __attribute__((ext_vector_type(8)));
typedef short s16x4 __attribute__((ext_vector_type(4)));
typedef float f32x16 __attribute__((ext_vector_type(16)));
constexpr int D = 128, NW = 8, QBLK = 32, KVBLK = 64, QB = NW * QBLK, QS = DM;
constexpr int SHM_V = KVBLK * D * 2, SHM_K = KVBLK * D * 2;
constexpr int OFF_WS = 2 * SHM_V + 2 * SHM_K, OFF_BIAS = OFF_WS + NW * 64 * 4, LDS_BYTES = OFF_BIAS + 2 * 256;
constexpr float SCALE = ATT_SCALE, THR = 8.f;
#define KSWZ(row, colB) ((row) * 256 + ((colB) ^ (((row) & 7) << 4)))
#define SBAR() __builtin_amdgcn_sched_barrier(0)
__device__ __forceinline__ int v_st(int k, int c) { const int kk = (k & ~0xC) | ((k & 4) << 1) | ((k & 8) >> 1); return ((kk >> 3) * 4 + (c >> 5)) * 512 + ((kk & 7) * 32 + (c & 31)) * 2; }
__device__ __forceinline__ int v_rd_base(int lane) { return ((lane & 3) << 3) | (((lane >> 2) & 3) << 6) | (((lane >> 4) & 1) << 5) | (((lane >> 5) & 1) << 8); }
constexpr int v_rd_off(int d0, int ks, int half) { return d0 * 512 + ks * 4096 + half * 2048; }
__device__ __forceinline__ int crow(int r, int hi) { return (r & 3) + 8 * (r >> 2) + 4 * hi; }
__device__ __forceinline__ bf16x8 load8(const bf16_t* p) { return *reinterpret_cast<const bf16x8*>(p); }
__device__ __forceinline__ void mask_tile(f32x16& p0, f32x16& p1, int dq, unsigned W) {
    const float NEG = -__builtin_inff();
#pragma unroll
    for (int r = 0; r < 16; ++r) { const int c = (r & 3) + 8 * (r >> 2);
        if ((unsigned)(dq - c) >= W) p0[r] = NEG;
        if ((unsigned)(dq - c - 32) >= W) p1[r] = NEG; }
}
__device__ __forceinline__ void partialSM(f32x16& p0, f32x16& p1, float& m_reg, float& mn, float& alpha) {
    float pmax = p0[0];
#pragma unroll
    for (int r = 1; r < 16; ++r) pmax = fmaxf(pmax, p0[r]);
#pragma unroll
    for (int r = 0; r < 16; ++r) pmax = fmaxf(pmax, p1[r]);
    { auto rr = __builtin_amdgcn_permlane32_swap(__float_as_uint(pmax), __float_as_uint(pmax), false, false);
      pmax = fmaxf(__uint_as_float(rr[0]), __uint_as_float(rr[1])); }
    constexpr float C2 = 1.4426950408889634f * SCALE;
    if (__builtin_expect(__all((pmax - m_reg) * SCALE <= THR), 1)) { mn = m_reg; alpha = 1.f; }
    else { mn = fmaxf(m_reg, pmax); alpha = __builtin_amdgcn_exp2f((m_reg - mn) * C2); m_reg = mn; }
    const float mnL = -mn * C2;
#pragma unroll
    for (int r = 0; r < 16; ++r) p0[r] = fmaf(p0[r], C2, mnL);
#pragma unroll
    for (int r = 0; r < 16; ++r) p1[r] = fmaf(p1[r], C2, mnL);
#pragma unroll
    for (int r = 0; r < 16; ++r) p0[r] = __builtin_amdgcn_exp2f(p0[r]);
}
__device__ __forceinline__ void finishSM(f32x16& p0, f32x16& p1, float alpha, float& l_reg, bf16x8& pa0, bf16x8& pa1, bf16x8& pa2, bf16x8& pa3) {
#pragma unroll
    for (int r = 0; r < 16; ++r) p1[r] = __builtin_amdgcn_exp2f(p1[r]);
    float ps = 0;
#pragma unroll
    for (int r = 0; r < 16; ++r) ps += p0[r];
#pragma unroll
    for (int r = 0; r < 16; ++r) ps += p1[r];
    { auto rr = __builtin_amdgcn_permlane32_swap(__float_as_uint(ps), __float_as_uint(ps), false, false);
      ps = __uint_as_float(rr[0]) + __uint_as_float(rr[1]); }
    l_reg = l_reg * alpha + ps;
#define PK4(P, B_, OUT) do { unsigned a0 = cvt_pk_bf16(P[B_+0], P[B_+1]), a1 = cvt_pk_bf16(P[B_+2], P[B_+3]);                          \
        unsigned b0 = cvt_pk_bf16(P[B_+4], P[B_+5]), b1 = cvt_pk_bf16(P[B_+6], P[B_+7]);                                             \
        auto r0 = __builtin_amdgcn_permlane32_swap(a0, b0, false, false); auto r1 = __builtin_amdgcn_permlane32_swap(a1, b1, false, false); \
        u32x4 w = {r0[0], r1[0], r0[1], r1[1]}; OUT = *reinterpret_cast<bf16x8*>(&w); } while (0)
    PK4(p0, 0, pa0); PK4(p0, 8, pa1); PK4(p1, 0, pa2); PK4(p1, 8, pa3);
#undef PK4
}
template <int KB>
__device__ __forceinline__ void qkt(f32x16& p0, f32x16& p1, const char* K_lds, const char* B_lds, int r32, int hi, const bf16x8* qr) {
    { const f32x4* bb = reinterpret_cast<const f32x4*>(B_lds + KB * 256 + hi * 16);
      const f32x4 a0 = bb[0], a1 = bb[2], a2 = bb[4], a3 = bb[6], c0 = bb[8], c1 = bb[10], c2 = bb[12], c3 = bb[14];
      p0 = (f32x16){a0[0], a0[1], a0[2], a0[3], a1[0], a1[1], a1[2], a1[3], a2[0], a2[1], a2[2], a2[3], a3[0], a3[1], a3[2], a3[3]};
      p1 = (f32x16){c0[0], c0[1], c0[2], c0[3], c1[0], c1[1], c1[2], c1[3], c2[0], c2[1], c2[2], c2[3], c3[0], c3[1], c3[2], c3[3]}; }
    const char* kb[4];
#pragma unroll
    for (int dd = 0; dd < 4; ++dd) kb[dd] = K_lds + KB * SHM_K + KSWZ(r32, (dd * 16 + hi * 8) * 2);
#pragma unroll
    for (int d0 = 0; d0 < 8; ++d0) { const char* a = kb[d0 & 3] + (d0 >> 2) * 128;
        bf16x8 b0 = *reinterpret_cast<const bf16x8*>(a);
        bf16x8 b1 = *reinterpret_cast<const bf16x8*>(a + 32 * 256);
        p0 = __builtin_amdgcn_mfma_f32_32x32x16_bf16(b0, qr[d0], p0, 0, 0, 0);
        p1 = __builtin_amdgcn_mfma_f32_32x32x16_bf16(b1, qr[d0], p1, 0, 0, 0); }
}
template <int VB>
__device__ __forceinline__ void pv_tile(f32x16* o, int vb0, bf16x8 pa0, bf16x8 pa1, bf16x8 pa2, bf16x8 pa3) {
#define TRRD(dst, off) asm volatile("ds_read_b64_tr_b16 %0, %1 offset:%2" : "=&v"(dst) : "v"(vb0), "i"(off) : "memory")
#define PV_D0(d0) do { s16x4 l0, l1, l2, l3, h0, h1, h2, h3; constexpr int b_ = VB * SHM_V + v_rd_off(d0, 0, 0); \
        TRRD(l0, b_); TRRD(h0, b_ + 2048); TRRD(l1, b_ + 4096); TRRD(h1, b_ + 6144); TRRD(l2, b_ + 8192); TRRD(h2, b_ + 10240); TRRD(l3, b_ + 12288); TRRD(h3, b_ + 14336); \
        asm volatile("s_waitcnt lgkmcnt(0)" ::: "memory"); SBAR();   \
        o[d0] = __builtin_amdgcn_mfma_f32_32x32x16_bf16(pa0, (bf16x8){l0[0], l0[1], l0[2], l0[3], h0[0], h0[1], h0[2], h0[3]}, o[d0], 0, 0, 0);   \
        o[d0] = __builtin_amdgcn_mfma_f32_32x32x16_bf16(pa1, (bf16x8){l1[0], l1[1], l1[2], l1[3], h1[0], h1[1], h1[2], h1[3]}, o[d0], 0, 0, 0);   \
        o[d0] = __builtin_amdgcn_mfma_f32_32x32x16_bf16(pa2, (bf16x8){l2[0], l2[1], l2[2], l2[3], h2[0], h2[1], h2[2], h2[3]}, o[d0], 0, 0, 0);   \
        o[d0] = __builtin_amdgcn_mfma_f32_32x32x16_bf16(pa3, (bf16x8){l3[0], l3[1], l3[2], l3[3], h3[0], h3[1], h3[2], h3[3]}, o[d0], 0, 0, 0); } while (0)
    PV_D0(0); PV_D0(1); PV_D0(2); PV_D0(3);
#undef PV_D0
#undef TRRD
}
struct BlockRef { const bf16_t* Q; const bf16_t* K; const bf16_t* V; const float* KBp; bf16_t* O; int P0; };
struct Seam { bf16x8 qr[8]; bf16x8 st_v0, st_v1, st_k0, st_k1; float sb; };
#define GLD16(base, boff) (*reinterpret_cast<const bf16x8*>((const char*)(base) + (boff)))
#define VMW() asm volatile("s_waitcnt vmcnt(0)" ::: "memory")
#define VMWN(n) asm volatile("s_waitcnt vmcnt(%0)" :: "i"(n) : "memory")
#define SLOAD_H(Kp, Vp, Bp, k0) do { const char* kq_ = (const char*)(Kp) + (size_t)(k0) * (D * 2); const char* vq_ = (const char*)(Vp) + (size_t)(k0) * (D * 2); \
                         S.st_v0 = GLD16(vq_, kvoff); S.st_v1 = GLD16(vq_ + 32 * D * 2, kvoff); S.st_k0 = GLD16(kq_, kvoff); S.st_k1 = GLD16(kq_ + 32 * D * 2, kvoff); \
                         S.sb = *reinterpret_cast<const float*>((const char*)(Bp) + (size_t)(k0) * 4 + lane4); } while (0)
#define SWRITE_HK(bf) do { *(bf16x8*)(K_lds + (bf) * SHM_K + kws) = S.st_k0; *(bf16x8*)(K_lds + (bf) * SHM_K + kws + 32 * 256) = S.st_k1; \
                           if (wid == 0) *(float*)(B_lds + (bf) * 256 + lane * 4) = S.sb; } while (0)
#define SWRITE_HV(bf) do { *(bf16x8*)(V_lds + (bf) * SHM_V + vst0) = S.st_v0; *(bf16x8*)(V_lds + (bf) * SHM_V + vst1) = S.st_v1; } while (0)
#define SWRITE_H(bf) do { SWRITE_HV(bf); SWRITE_HK(bf); } while (0)
__device__ __forceinline__ void prime(const BlockRef& cur, char* lds, Seam& S) {
    const int tid = tidx(), wid = __builtin_amdgcn_readfirstlane(tid >> 6), lane = tid & 63, r32 = lane & 31, hi = lane >> 5;
    const int sr = tid >> 4, sc = (tid & 15) * 8, kws = KSWZ(sr, sc * 2); char* K_lds = lds + 2 * SHM_V; char* B_lds = lds + OFF_BIAS;
    const unsigned kvoff = (unsigned)(sr * D + sc) * 2u, lane4 = (unsigned)lane * 4u, qoff = (unsigned)((wid * QBLK + r32) * QS + hi * 8) * 2u;
#pragma unroll
    for (int d0 = 0; d0 < 8; ++d0) S.qr[d0] = GLD16(cur.Q, qoff + d0 * 32);
    SLOAD_H(cur.K, cur.V, cur.KBp, 0); VMW(); SWRITE_HK(0);
    __syncthreads();
}
__device__ __forceinline__ void block(const BlockRef& cur, const BlockRef& nxt, char* lds, Seam& S) {
    const int tid = tidx(), wid = __builtin_amdgcn_readfirstlane(tid >> 6), lane = tid & 63, r32 = lane & 31, hi = lane >> 5;
    const int NT = (cur.P0 + QB - 1) / KVBLK + 1;
    const int qlo = cur.P0 + wid * QBLK, qm = qlo + r32 - 4 * hi;
    char* V_lds = lds; char* K_lds = lds + 2 * SHM_V; char* B_lds = lds + OFF_BIAS;
    float* ws = (float*)(lds + OFF_WS) + wid * 64; float* li_l = ws; float* al_l = ws + 32;
    float m_reg = -1e30f, l_reg = 0; f32x16 o[4] = {};
    const int sr = tid >> 4, sc = (tid & 15) * 8, vst0 = v_st(sr, sc), vst1 = v_st(32 + sr, sc), kws = KSWZ(sr, sc * 2);
    const unsigned kvoff = (unsigned)(sr * D + sc) * 2u, lane4 = (unsigned)lane * 4u, qoff = (unsigned)((wid * QBLK + r32) * QS + hi * 8) * 2u;
    const int vb0 = (int)(uintptr_t)V_lds + v_rd_base(lane);
    const bf16_t* Kh = cur.K; const bf16_t* Vh = cur.V; const float* Bh = cur.KBp;
#define RESC(a) do { if (__any((a) < 1.f)) { if (hi == 0) al_l[r32] = (a); asm volatile("s_waitcnt lgkmcnt(0)" ::: "memory");              \
                     for (int d_ = 0; d_ < 4; ++d_) for (int r = 0; r < 16; ++r) o[d_][r] *= al_l[crow(r, hi)]; } } while (0)
#define KBASE(t) ((t) * KVBLK)
#define MASKT(P0_, P1_, t) do { const int kb_ = KBASE(t); if (kb_ + KVBLK - 1 > qlo) mask_tile(P0_, P1_, qm - kb_, 0x7fffffffu); } while (0)
    f32x16 pA0, pA1, pB0, pB1; float mnA, mnB, alA, alB; bf16x8 pa0, pa1, pa2, pa3;
    SWRITE_HV(0); SBAR();
    if (NT > 1) SLOAD_H(Kh, Vh, Bh, KBASE(1));
    SBAR(); qkt<0>(pA0, pA1, K_lds, B_lds, r32, hi, S.qr);
    MASKT(pA0, pA1, 0); partialSM(pA0, pA1, m_reg, mnA, alA);
    if (NT > 1) { VMW(); SWRITE_H(1); }
    __syncthreads();
#define HALF_STEP(PX0, PX1, mnX, alX, PY0, PY1, alY, t, KB, VB, SB) do {                                                      \
        SBAR(); qkt<KB>(PX0, PX1, K_lds, B_lds, r32, hi, S.qr);                                                               \
        finishSM(PY0, PY1, alY, l_reg, pa0, pa1, pa2, pa3); SBAR();                                                           \
        if ((t) + 1 < NT) { SLOAD_H(Kh, Vh, Bh, KBASE((t) + 1)); SBAR(); }                                                   \
        pv_tile<VB>(o, vb0, pa0, pa1, pa2, pa3); MASKT(PX0, PX1, (t)); partialSM(PX0, PX1, m_reg, mnX, alX);                 \
        __syncthreads();                                                                                                      \
        if ((t) + 1 < NT) { VMW(); SWRITE_H(SB); }                                                                            \
        RESC(alX); __syncthreads(); } while (0)
    for (int t = 1; t + 1 < NT; t += 2) {
        HALF_STEP(pB0, pB1, mnB, alB, pA0, pA1, alA, t, 1, 0, 0);
        HALF_STEP(pA0, pA1, mnA, alA, pB0, pB1, alB, t + 1, 0, 1, 1);
    }
    const bool even = (NT & 1) == 0;
    if (even) { SBAR(); qkt<1>(pB0, pB1, K_lds, B_lds, r32, hi, S.qr); SBAR(); }
    SLOAD_H(nxt.K, nxt.V, nxt.KBp, 0); SBAR();
#pragma unroll
    for (int d0 = 0; d0 < 8; ++d0) S.qr[d0] = GLD16(nxt.Q, qoff + d0 * 32);
    SBAR();
    finishSM(pA0, pA1, alA, l_reg, pa0, pa1, pa2, pa3); SBAR();
    pv_tile<0>(o, vb0, pa0, pa1, pa2, pa3);
    if (even) { MASKT(pB0, pB1, NT - 1); partialSM(pB0, pB1, m_reg, mnB, alB); __syncthreads(); RESC(alB);
        finishSM(pB0, pB1, alB, l_reg, pa0, pa1, pa2, pa3); SBAR(); pv_tile<1>(o, vb0, pa0, pa1, pa2, pa3); }
    SBAR(); VMWN(8); SWRITE_HK(0); SBAR();
    if (hi == 0) li_l[r32] = l_reg; asm volatile("s_waitcnt lgkmcnt(0)" ::: "memory");
    float rli[16];
#pragma unroll
    for (int r = 0; r < 16; ++r) rli[r] = __builtin_amdgcn_rcpf(li_l[crow(r, hi)]);
    char* Ow = (char*)cur.O; const unsigned ooff = (unsigned)((wid * QBLK + 4 * hi) * QS + r32) * 2u;
#pragma unroll
    for (int r = 0; r < 16; ++r) { const int orow = (r & 3) + 8 * (r >> 2);
#pragma unroll
        for (int d0 = 0; d0 < 4; ++d0) { const float v = o[d0][r] * rli[r]; const float vn = __shfl_xor(v, 1);
            if ((r32 & 1) == 0) *(unsigned*)(Ow + (size_t)(orow * QS + d0 * 32) * 2 + ooff) = cvt_pk_bf16(v, vn); } }
    __syncthreads();
#undef RESC
#undef KBASE
#undef MASKT
#undef HALF_STEP
}
#undef GLD16
#undef VMW
#undef VMWN
#undef SLOAD_H
#undef SWRITE_HK
#undef SWRITE_HV
#undef SWRITE_H
__device__ __forceinline__ BlockRef ref(const Ctx& c, int bh, int qb) {
    unsigned char* ws = wsl(c); const int b = bh >> 3, h = bh & 7; BlockRef r;
    const size_t qo = ((size_t)(b * SEQ + qb * QB)) * QS + h * DH;
    r.Q = (const bf16_t*)(ws + WS_FQ) + qo; r.O = (bf16_t*)(ws + WS_FQ) + qo;
    r.K = (const bf16_t*)(ws + WS_FK) + (size_t)bh * SEQ * DH; r.V = (const bf16_t*)(ws + WS_FV) + (size_t)bh * SEQ * DH;
    r.KBp = (const float*)(ws + WS_KBIAS) + (size_t)bh * SEQ; r.P0 = qb * QB; return r;
}
__device__ __forceinline__ void phase(const Ctx& c, char* lds) {
    constexpr int NQB = SEQ / QB, NX = NQB / 2, TOTAL = NX * NB * NH;
    const int stride = gridDim.x; int L = bidx(); if (L >= TOTAL) return;
    int pass = 0;
    BlockRef cur = ref(c, L / NX, L % NX);
    Seam S;
    prime(cur, lds, S);
    for (;;) {
        const bool more_pass = pass == 0, more_item = L + stride < TOTAL, last = !more_pass && !more_item;
        int Ln = L, passn = pass + 1;
        if (!more_pass) { passn = 0; Ln = more_item ? L + stride : L; }
        const int bhn = Ln / NX, xn = Ln % NX;
        const BlockRef nxt = last ? cur : ref(c, bhn, passn ? NQB - 1 - xn : xn);
        block(cur, nxt, lds, S);
        if (last) break;
        cur = nxt; pass = passn; L = Ln;
    }
}
#undef KSWZ
#undef SBAR
}


namespace hg {
typedef short bf16x8 __attribute__((ext_vector_type(8)));
typedef short s16x4 __attribute__((ext_vector_type(4)));
typedef float f32x16 __attribute__((ext_vector_type(16)));
constexpr int C = 64, NCH = SEQ / C, NUNIT = NB * NH * NCH;
constexpr size_t US_BYTES = (size_t)128 * 128 * 2;
constexpr size_t WS_US_LO = WS_XBF, WS_US_HI = 968 * MiB, WS_G = 1032 * MiB, WS_HG_END = 1034 * MiB;
__device__ __forceinline__ bf16_t* us_tile(unsigned char* ws, int unit) { return (bf16_t*)(ws + (unit < NUNIT / 2 ? WS_US_LO + (size_t)unit * US_BYTES : WS_US_HI + (size_t)(unit - NUNIT / 2) * US_BYTES)); }
#define KSWZ(row, colB) ((row) * 256 + ((colB) ^ (((row) & 7) << 4)))
__device__ __forceinline__ int v_st(int k, int c) { const int kk = (k & ~0xC) | ((k & 4) << 1) | ((k & 8) >> 1); return ((kk >> 3) * 4 + (c >> 5)) * 512 + ((kk & 7) * 32 + (c & 31)) * 2; }
__device__ __forceinline__ int v_rd_base(int lane) { return ((lane & 3) << 3) | (((lane >> 2) & 3) << 6) | (((lane >> 4) & 1) << 5) | (((lane >> 5) & 1) << 8); }
__device__ __forceinline__ int crow(int r, int hi) { return (r & 3) + 8 * (r >> 2) + 4 * hi; }
#define TRRD(dst, addr, off) asm volatile("ds_read_b64_tr_b16 %0, %1 offset:%2" : "=&v"(dst) : "v"(addr), "i"(off) : "memory")
#define FRAG4(F0, F1, F2, F3, vaddr, d0) do { s16x4 l0, l1, l2, l3, h0, h1, h2, h3; constexpr int b_ = (d0) * 512; \
        TRRD(l0, vaddr, b_); TRRD(h0, vaddr, b_ + 2048); TRRD(l1, vaddr, b_ + 4096); TRRD(h1, vaddr, b_ + 6144); TRRD(l2, vaddr, b_ + 8192); TRRD(h2, vaddr, b_ + 10240); TRRD(l3, vaddr, b_ + 12288); TRRD(h3, vaddr, b_ + 14336); \
        asm volatile("s_waitcnt lgkmcnt(0)" ::: "memory"); __builtin_amdgcn_sched_barrier(0); \
        F0 = (bf16x8){l0[0], l0[1], l0[2], l0[3], h0[0], h0[1], h0[2], h0[3]}; F1 = (bf16x8){l1[0], l1[1], l1[2], l1[3], h1[0], h1[1], h1[2], h1[3]}; \
        F2 = (bf16x8){l2[0], l2[1], l2[2], l2[3], h2[0], h2[1], h2[2], h2[3]}; F3 = (bf16x8){l3[0], l3[1], l3[2], l3[3], h3[0], h3[1], h3[2], h3[3]}; } while (0)
struct Strip { float cum[8][2]; float tot[2]; };
__device__ __forceinline__ void strip_cum(const float* lf_chunk  , int kp, int rg, int lane, float (&l)[8][2], Strip& st) {
    float run0 = 0.f, run1 = 0.f;
#pragma unroll
    for (int i = 0; i < 8; ++i) { const float2 x = *reinterpret_cast<const float2*>(lf_chunk + (size_t)(8 * rg + i) * DM + 2 * kp); l[i][0] = x.x; l[i][1] = x.y; run0 += x.x; run1 += x.y; st.cum[i][0] = run0; st.cum[i][1] = run1; }
    float in0 = run0, in1 = run1;
#pragma unroll
    for (int o = 1; o < 8; o <<= 1) { const float a = __shfl_up(in0, o), b = __shfl_up(in1, o); if ((lane & 7) >= o) { in0 += a; in1 += b; } }
    const float ex0 = in0 - run0, ex1 = in1 - run1;
#pragma unroll
    for (int i = 0; i < 8; ++i) { st.cum[i][0] += ex0; st.cum[i][1] += ex1; }
    st.tot[0] = __shfl(in0, (lane & ~7) | 7); st.tot[1] = __shfl(in1, (lane & ~7) | 7);
}
constexpr int A_TK = 0, A_TV = 16384, A_LDS = 32768;
__device__ __forceinline__ void pass_a(const Ctx& c, char* lds) {
    const int tid = tidx(), wid = __builtin_amdgcn_readfirstlane(tid >> 6), lane = tid & 63, r32 = lane & 31, hi = lane >> 5;
    const int kp = tid >> 3, rg = tid & 7, sr = tid >> 4, sc = (tid & 15) * 8;
    unsigned char* ws = wsl(c); const float* LF = (const float*)(ws + WS_LF); const bf16_t* VA = (const bf16_t*)(ws + WS_VA); float* G = (float*)(ws + WS_G);
    const int vaddr_k = (int)(uintptr_t)(lds + A_TK) + v_rd_base(lane), vaddr_v = (int)(uintptr_t)(lds + A_TV) + v_rd_base(lane);
    for (int unit = bidx(); unit < NUNIT; unit += gridDim.x) {
        const int bh = unit >> 7, ch = unit & (NCH - 1), b = bh >> 3, h = bh & 7; const size_t row0 = (size_t)(b * SEQ + ch * C);
        float l[8][2]; Strip st; strip_cum(LF + row0 * DM + h * DH, kp, rg, lane, l, st);
#pragma unroll
        for (int i = 0; i < 8; ++i) { const float k0 = (1.f - __expf(l[i][0])) * __expf(st.tot[0] - st.cum[i][0]), k1 = (1.f - __expf(l[i][1])) * __expf(st.tot[1] - st.cum[i][1]);
            *(unsigned*)(lds + A_TK + v_st(8 * rg + i, 2 * kp)) = cvt_pk_bf16(k0, k1); }
        if (rg == 7) *reinterpret_cast<float2*>(G + (size_t)unit * DH + 2 * kp) = make_float2(__expf(st.tot[0]), __expf(st.tot[1]));
        { const bf16_t* vp = VA + (row0 + sr) * DM + h * DH + sc; const bf16x8 v0 = *(const bf16x8*)vp, v1 = *(const bf16x8*)(vp + (size_t)32 * DM);
          *(bf16x8*)(lds + A_TV + v_st(sr, sc)) = v0; *(bf16x8*)(lds + A_TV + v_st(32 + sr, sc)) = v1; }
        __syncthreads();
        const int kb = wid >> 1; bf16x8 a0, a1, a2, a3;
        if (kb == 0) FRAG4(a0, a1, a2, a3, vaddr_k, 0); else if (kb == 1) FRAG4(a0, a1, a2, a3, vaddr_k, 1); else if (kb == 2) FRAG4(a0, a1, a2, a3, vaddr_k, 2); else FRAG4(a0, a1, a2, a3, vaddr_k, 3);
        bf16_t* U = us_tile(ws, unit);
#pragma unroll
        for (int j = 0; j < 2; ++j) { bf16x8 b0, b1, b2, b3; const int vb = 2 * (wid & 1) + j;
            if (wid & 1) { if (j == 0) FRAG4(b0, b1, b2, b3, vaddr_v, 2); else FRAG4(b0, b1, b2, b3, vaddr_v, 3); } else { if (j == 0) FRAG4(b0, b1, b2, b3, vaddr_v, 0); else FRAG4(b0, b1, b2, b3, vaddr_v, 1); }
            f32x16 acc = {};
            acc = __builtin_amdgcn_mfma_f32_32x32x16_bf16(a0, b0, acc, 0, 0, 0); acc = __builtin_amdgcn_mfma_f32_32x32x16_bf16(a1, b1, acc, 0, 0, 0);
            acc = __builtin_amdgcn_mfma_f32_32x32x16_bf16(a2, b2, acc, 0, 0, 0); acc = __builtin_amdgcn_mfma_f32_32x32x16_bf16(a3, b3, acc, 0, 0, 0);
#pragma unroll
            for (int r = 0; r < 16; ++r) { const float v = acc[r], vn = __shfl_xor(v, 1);
                if ((r32 & 1) == 0) *(unsigned*)(U + (size_t)(32 * kb + crow(r, hi)) * DH + 32 * vb + r32) = cvt_pk_bf16(v, vn); } }
        __syncthreads();
    }
}
__device__ __forceinline__ void pass_b(const Ctx& c) {
    unsigned char* ws = wsl(c); const float* G = (const float*)(ws + WS_G);
    const int tid = tidx();
    for (int job = bidx(); job < NB * NH * 4; job += gridDim.x) { const int bh = job >> 2, q = job & 3;
        const int e = (q * NTHR + tid) * 8, k = e >> 7, v = e & 127;
        float s[8];
#pragma unroll
        for (int i = 0; i < 8; ++i) s[i] = 0.f;
        for (int c0 = 0; c0 < NCH; c0 += 8) { u32x4 u[8]; float g[8];
#pragma unroll
            for (int j = 0; j < 8; ++j) { const int unit = bh * NCH + c0 + j; u[j] = *(const u32x4*)(us_tile(ws, unit) + k * DH + v); g[j] = G[(size_t)unit * DH + k]; }
#pragma unroll
            for (int j = 0; j < 8; ++j) { const int unit = bh * NCH + c0 + j;
                u32x4 o; o.x = cvt_pk_bf16(s[0], s[1]); o.y = cvt_pk_bf16(s[2], s[3]); o.z = cvt_pk_bf16(s[4], s[5]); o.w = cvt_pk_bf16(s[6], s[7]);
                *(u32x4*)(us_tile(ws, unit) + k * DH + v) = o;
                s[0] = g[j] * s[0] + __uint_as_float(u[j].x << 16); s[1] = g[j] * s[1] + __uint_as_float(u[j].x & 0xffff0000u); s[2] = g[j] * s[2] + __uint_as_float(u[j].y << 16); s[3] = g[j] * s[3] + __uint_as_float(u[j].y & 0xffff0000u);
                s[4] = g[j] * s[4] + __uint_as_float(u[j].z << 16); s[5] = g[j] * s[5] + __uint_as_float(u[j].z & 0xffff0000u); s[6] = g[j] * s[6] + __uint_as_float(u[j].w << 16); s[7] = g[j] * s[7] + __uint_as_float(u[j].w & 0xffff0000u); }
        }
    }
}
constexpr int C_TQ = 0, C_TKD = 16384, C_TV = 32768, C_TS = 49152, C_ER = 81920, C_PS = 82432, C_LDS = 83456;
__device__ __forceinline__ void pass_c(const Ctx& c, int layer, char* lds) {
    const int tid = tidx(), wid = __builtin_amdgcn_readfirstlane(tid >> 6), lane = tid & 63, r32 = lane & 31, hi = lane >> 5;
    const int kp = tid >> 3, rg = tid & 7, sr = tid >> 4, sc = (tid & 15) * 8, rh = wid >> 2, vq = wid & 3;
    unsigned char* ws = wsl(c); const float* LF = (const float*)(ws + WS_LF); const bf16_t* VA = (const bf16_t*)(ws + WS_VA); bf16_t* QA = (bf16_t*)(ws + WS_QA); const bf16_t* GA = (const bf16_t*)(ws + WS_GA);
    const int vaddr_v = (int)(uintptr_t)(lds + C_TV) + v_rd_base(lane), vaddr_s0 = (int)(uintptr_t)(lds + C_TS) + v_rd_base(lane), vaddr_s1 = vaddr_s0 + 16384;
    float* ER = (float*)(lds + C_ER); float* PS = (float*)(lds + C_PS);
    const float gain = c.in[I_HGN][layer * DH + 32 * vq + r32];
    for (int unit = bidx(); unit < NUNIT; unit += gridDim.x) {
        const int bh = unit >> 7, ch = unit & (NCH - 1), b = bh >> 3, h = bh & 7; const size_t row0 = (size_t)(b * SEQ + ch * C);
        float l[8][2]; Strip st; strip_cum(LF + row0 * DM + h * DH, kp, rg, lane, l, st);
        const float ref0 = __shfl(st.cum[7][0], (lane & ~7) | 3), ref1 = __shfl(st.cum[7][1], (lane & ~7) | 3);
#pragma unroll
        for (int i = 0; i < 8; ++i) { const int row = 8 * rg + i;
            const unsigned qq = *(const unsigned*)(QA + (row0 + row) * DM + h * DH + 2 * kp); const float q0 = __uint_as_float(qq << 16), q1 = __uint_as_float(qq & 0xffff0000u);
            const float d0 = st.cum[i][0] - ref0, d1 = st.cum[i][1] - ref1;
            *(unsigned*)(lds + C_TQ + KSWZ(row, 4 * kp)) = cvt_pk_bf16(q0 * __expf(d0), q1 * __expf(d1));
            *(unsigned*)(lds + C_TKD + KSWZ(row, 4 * kp)) = cvt_pk_bf16((1.f - __expf(l[i][0])) * __expf(-d0), (1.f - __expf(l[i][1])) * __expf(-d1)); }
        if (rg == 0) { ER[2 * kp] = __expf(ref0); ER[2 * kp + 1] = __expf(ref1); }
        { const bf16_t* vp = VA + (row0 + sr) * DM + h * DH + sc; const bf16x8 v0 = *(const bf16x8*)vp, v1 = *(const bf16x8*)(vp + (size_t)32 * DM);
          *(bf16x8*)(lds + C_TV + v_st(sr, sc)) = v0; *(bf16x8*)(lds + C_TV + v_st(32 + sr, sc)) = v1; }
        u32x4 sraw[4]; const bf16_t* Sg = us_tile(ws, unit);
#pragma unroll
        for (int j = 0; j < 4; ++j) sraw[j] = *(const u32x4*)(Sg + (size_t)(sr + 32 * j) * DH + sc);
        __syncthreads();
#pragma unroll
        for (int j = 0; j < 4; ++j) { const int k = sr + 32 * j; const float e = ER[k]; const u32x4 x = sraw[j]; u32x4 o;
            o.x = cvt_pk_bf16(__uint_as_float(x.x << 16) * e, __uint_as_float(x.x & 0xffff0000u) * e); o.y = cvt_pk_bf16(__uint_as_float(x.y << 16) * e, __uint_as_float(x.y & 0xffff0000u) * e);
            o.z = cvt_pk_bf16(__uint_as_float(x.z << 16) * e, __uint_as_float(x.z & 0xffff0000u) * e); o.w = cvt_pk_bf16(__uint_as_float(x.w << 16) * e, __uint_as_float(x.w & 0xffff0000u) * e);
            *(u32x4*)(lds + C_TS + (k >> 6) * 16384 + v_st(k & 63, sc)) = o; }
        __syncthreads();
        bf16x8 qr[8];
#pragma unroll
        for (int d0 = 0; d0 < 8; ++d0) qr[d0] = *(const bf16x8*)(lds + C_TQ + KSWZ(32 * rh + r32, (d0 * 16 + hi * 8) * 2));
        f32x16 p0 = {}, p1 = {};
#pragma unroll
        for (int d0 = 0; d0 < 8; ++d0) { const bf16x8 k0 = *(const bf16x8*)(lds + C_TKD + KSWZ(r32, (d0 * 16 + hi * 8) * 2)), k1 = *(const bf16x8*)(lds + C_TKD + KSWZ(32 + r32, (d0 * 16 + hi * 8) * 2));
            p0 = __builtin_amdgcn_mfma_f32_32x32x16_bf16(k0, qr[d0], p0, 0, 0, 0); p1 = __builtin_amdgcn_mfma_f32_32x32x16_bf16(k1, qr[d0], p1, 0, 0, 0); }
        { const int t = 32 * rh + r32;
#pragma unroll
          for (int r = 0; r < 16; ++r) { const int key = crow(r, hi); if (key > t) p0[r] = 0.f; if (key + 32 > t) p1[r] = 0.f; } }
        bf16x8 pa0, pa1, pa2, pa3;
#define PK4(P, B_, OUT) do { unsigned a0 = cvt_pk_bf16(P[B_+0], P[B_+1]), a1 = cvt_pk_bf16(P[B_+2], P[B_+3]);                          \
        unsigned b0 = cvt_pk_bf16(P[B_+4], P[B_+5]), b1 = cvt_pk_bf16(P[B_+6], P[B_+7]);                                             \
        auto r0 = __builtin_amdgcn_permlane32_swap(a0, b0, false, false); auto r1 = __builtin_amdgcn_permlane32_swap(a1, b1, false, false); \
        u32x4 w = {r0[0], r1[0], r0[1], r1[1]}; OUT = *reinterpret_cast<bf16x8*>(&w); } while (0)
        PK4(p0, 0, pa0); PK4(p0, 8, pa1); PK4(p1, 0, pa2); PK4(p1, 8, pa3);
#undef PK4
        f32x16 o = {};
#define ACC_TILE(vaddr, A0, A1, A2, A3) do { bf16x8 b0, b1, b2, b3; \
        if (vq == 0) FRAG4(b0, b1, b2, b3, vaddr, 0); else if (vq == 1) FRAG4(b0, b1, b2, b3, vaddr, 1); else if (vq == 2) FRAG4(b0, b1, b2, b3, vaddr, 2); else FRAG4(b0, b1, b2, b3, vaddr, 3); \
        o = __builtin_amdgcn_mfma_f32_32x32x16_bf16(A0, b0, o, 0, 0, 0); o = __builtin_amdgcn_mfma_f32_32x32x16_bf16(A1, b1, o, 0, 0, 0); \
        o = __builtin_amdgcn_mfma_f32_32x32x16_bf16(A2, b2, o, 0, 0, 0); o = __builtin_amdgcn_mfma_f32_32x32x16_bf16(A3, b3, o, 0, 0, 0); } while (0)
        ACC_TILE(vaddr_v, pa0, pa1, pa2, pa3);
        ACC_TILE(vaddr_s0, qr[0], qr[1], qr[2], qr[3]);
        ACC_TILE(vaddr_s1, qr[4], qr[5], qr[6], qr[7]);
#undef ACC_TILE
#pragma unroll
        for (int r = 0; r < 16; ++r) { float ss = o[r] * o[r];
            ss += __shfl_xor(ss, 1); ss += __shfl_xor(ss, 2); ss += __shfl_xor(ss, 4); ss += __shfl_xor(ss, 8); ss += __shfl_xor(ss, 16);
            if (r32 == 0) PS[(32 * rh + crow(r, hi)) * 4 + vq] = ss; }
        __syncthreads();
#pragma unroll
        for (int r = 0; r < 16; ++r) { const int t = 32 * rh + crow(r, hi); const f32x4 ps = *(const f32x4*)(PS + t * 4);
            const float rstd = rsqrtf(((ps[0] + ps[1]) + (ps[2] + ps[3])) * (1.f / DH) + NORM_EPS);
            const size_t gi = (row0 + t) * DM + h * DH + 32 * vq + r32;
            const float val = o[r] * rstd * gain * bf2f(GA[gi]); const float vn = __shfl_xor(val, 1);
            if ((r32 & 1) == 0) *(unsigned*)(QA + gi) = cvt_pk_bf16(val, vn); }
        __syncthreads();
    }
}
#undef KSWZ
#undef TRRD
#undef FRAG4
}

static_assert(LDS_STAGE_BYTES == pg8::STAGE_BYTES, "stage region");
__device__ __forceinline__ void moe_tables(const Ctx& c, int layer, LAS int* tab) {
    const unsigned* gc = (const unsigned*)(wsl(c) + WS_CTL) + CW_CNT + layer * 64;
    if (threadIdx.x == 0) { int s = 0, t = 0;
        for (int e = 0; e < NE; ++e) { const int n = (int)__hip_atomic_load(gc + e, __ATOMIC_RELAXED, __HIP_MEMORY_SCOPE_AGENT); tab[80 + e] = n; tab[e] = t; tab[40 + e] = s; s += (n + 255) & ~255; t += (n + 255) >> 8; }
        tab[NE] = t; tab[40 + NE] = s; }
    __syncthreads();
}
template <int GP> __device__ __forceinline__ void ph_gemm(const Ctx& c, int layer, LAS unsigned char* lds) {
    unsigned char* ws = wsl(c); const int G = gridDim.x, cid = bidx();
    if (GP == 0) { pg8::StaticOrder S; S.init(ws + WS_XBF, ws + WS_WIN, T, INP, DM, G, cid); pg8::EpiInProj E{make_ipo(c)}; pg8::gemm_phase<DM>(lds, S, E); }
    if (GP == 1) { pg8::StaticOrder S; S.init(ws + WS_QA, ws + WS_WA, T, DM, DM, G, cid); pg8::EpiMerge<0> E{(const bf16_t*)(ws + WS_SGA), (float*)(ws + WS_LF), (bf16_t*)(ws + WS_VA)}; pg8::gemm_phase<DM>(lds, S, E); }
    if (GP == 2) { pg8::StaticOrder S; S.init(ws + WS_FQ, ws + WS_WB, T, DM, DM, G, cid); pg8::EpiMerge<1> E{(const bf16_t*)(ws + WS_SGB), (float*)(ws + WS_LF), (bf16_t*)(ws + WS_VA)}; pg8::gemm_phase<DM>(lds, S, E); }
    if (GP == 3) { pg8::StaticOrder S; S.init(ws + WS_VA, ws + WS_WO, T, DM, DM, G, cid); pg8::EpiOut E{layer == 0 ? c.in[I_X] : (const float*)(ws + WS_XA), (float*)(ws + WS_LF)}; pg8::gemm_phase<DM>(lds, S, E); }
    if (GP == 4 || GP == 5) { LAS int* tab = (LAS int*)(lds + LDS_MISC + 1024); moe_tables(c, layer, tab);
        if (GP == 4) { pg8::MoeOrder<true> S{(const char*)(ws + WS_XBF), (const char*)(ws + WS_WGU), (const int*)(ws + WS_STE), tab, tab + 40, tab + 80, G, cid}; pg8::EpiMoeUp E{(bf16_t*)(ws + WS_HB)}; pg8::gemm_phase<DM>(lds, S, E); }
        else { pg8::MoeOrder<false> S{(const char*)(ws + WS_HB), (const char*)(ws + WS_WD), (const int*)(ws + WS_STE), tab, tab + 40, tab + 80, G, cid}; pg8::EpiMoeDn E{(bf16_t*)(ws + WS_YB)}; pg8::gemm_phase<DE>(lds, S, E); } }
}


#define XB_TMO      128
#define XB_XCNT(j)  (256  + 64 * (j))
#define XB_XSUB(j)  (1280 + 64 * (j))
#define XB_XGEN(j)  (2304 + 64 * (j))
#define XB_TOP      3328
#define XB_TOPGEN   3392
#define XCD_BAR_WORDS 3456
#define XB_SPIN_CAP (1u << 18)
__device__ __forceinline__ unsigned xb_ld(unsigned* p)              { return __hip_atomic_load(p, __ATOMIC_RELAXED, __HIP_MEMORY_SCOPE_AGENT); }
__device__ __forceinline__ unsigned xb_add(unsigned* p, unsigned v) { return __hip_atomic_fetch_add(p, v, __ATOMIC_RELAXED, __HIP_MEMORY_SCOPE_AGENT); }
__device__ __forceinline__ unsigned xb_xcc_id() { return (unsigned)__builtin_amdgcn_s_getreg((3 << 11) | 20) & 0xFu; }
#define XB_SPIN(cond, bar) do { unsigned _sp = 0; while (cond) { __builtin_amdgcn_s_sleep(1); \
    if ((++_sp & 255u) == 0u) { if (xb_ld(&(bar)[XB_TMO])) break; if (_sp > XB_SPIN_CAP) { atomicAdd(&(bar)[XB_TMO], 1u); break; } } } } while (0)
struct XcdBarrier { unsigned* bar; unsigned x; volatile LAS unsigned* st; };
__device__ __forceinline__ XcdBarrier xcd_barrier_post(unsigned* bar, volatile LAS unsigned* st) {
    XcdBarrier b; b.bar = bar; b.x = xb_xcc_id(); b.st = st;
    if (threadIdx.x == 0) (void)xb_add(&bar[XB_XCNT(b.x)], 1u);
    return b;
}
__device__ __forceinline__ void xcd_barrier_complete(unsigned* bar, unsigned x, unsigned& nloc, unsigned& nx) {
    const unsigned G = gridDim.x * gridDim.y * gridDim.z;
    unsigned sum, cnt, mine, sp = 0u;
    for (;;) {
        sum = 0u; cnt = 0u; mine = 0u;
#pragma unroll
        for (unsigned j = 0; j < 16; ++j) { const unsigned c = xb_ld(&bar[XB_XCNT(j)]); sum += c; cnt += (c > 0u) ? 1u : 0u; mine = (j == x) ? c : mine; }
        if (sum == G) break;
        __builtin_amdgcn_s_sleep(1);
        if ((++sp & 255u) == 0u) { if (xb_ld(&bar[XB_TMO])) break; if (sp > XB_SPIN_CAP) { atomicAdd(&bar[XB_TMO], 1u); break; } }
    }
    nloc = mine > 0u ? mine : 1u; nx = cnt > 0u ? cnt : 1u;
}
__device__ __forceinline__ void xcd_barrier(const XcdBarrier& b) {
    asm volatile("s_waitcnt vmcnt(0)" ::: "memory");
    __syncthreads();
    if (threadIdx.x == 0) {
        unsigned* bar = b.bar; asm volatile("" : "+s"(bar));
        const unsigned bx = (unsigned)__builtin_amdgcn_readfirstlane((int)xb_xcc_id());
        __builtin_amdgcn_s_waitcnt(0);
        unsigned nloc = b.st[0], nx = b.st[1];
        if (nloc == 0u) { xcd_barrier_complete(bar, bx, nloc, nx); b.st[0] = nloc; b.st[1] = nx; }
        const unsigned old = xb_add(&bar[XB_XSUB(bx)], 1u);
        const unsigned gen = old / nloc;
        if (old + 1u == (gen + 1u) * nloc) {
            __builtin_amdgcn_fence(__ATOMIC_RELEASE, "agent");
            asm volatile("s_waitcnt vmcnt(0)" ::: "memory");
            const unsigned og = xb_add(&bar[XB_TOP], 1u);
            const unsigned tg = og / nx;
            if (og + 1u == (tg + 1u) * nx) xb_add(&bar[XB_TOPGEN], 1u);
            else XB_SPIN(xb_ld(&bar[XB_TOPGEN]) == tg, bar);
            __builtin_amdgcn_fence(__ATOMIC_ACQUIRE, "agent");
            xb_add(&bar[XB_XGEN(bx)], 1u);
            asm volatile("s_waitcnt vmcnt(0)" ::: "memory");
        } else {
            XB_SPIN(xb_ld(&bar[XB_XGEN(bx)]) == gen, bar);
            __builtin_amdgcn_fence(__ATOMIC_ACQUIRE, "agent");
            asm volatile("s_waitcnt vmcnt(0)" ::: "memory");
        }
    }
    __syncthreads();
}

constexpr int CW_BAR = 8192;
static_assert((CW_BAR + XCD_BAR_WORDS) * 4 <= (int)CTL_BYTES, "ctl");
__global__ void __launch_bounds__(NTHR, 2) k_mega(KArgs a) {
    LAS unsigned char* lds = (LAS unsigned char*)g_lds; char* ldsg = (char*)g_lds;
    if (threadIdx.x < 4) ((LAS unsigned*)(lds + LDS_MISC))[threadIdx.x] = 0u;
    __syncthreads();
    const Ctx c{};
    const XcdBarrier bar = xcd_barrier_post((unsigned*)(wsl(c) + WS_CTL) + CW_BAR, (volatile LAS unsigned*)(lds + LDS_MISC));
    ph_xprep(c);
    ph_convert(c, 0, lds);
    xcd_barrier(bar);
    for (int l = 0; l < DEPTH; ++l) {
        ph_gemm<0>(c, l, lds);          xcd_barrier(bar);
        ph_foxprep(c, l, lds); __syncthreads(); hg::pass_a(c, ldsg);     xcd_barrier(bar);
        hg::pass_b(c);                  xcd_barrier(bar);
        hg::pass_c(c, l, ldsg);         xcd_barrier(bar);
        fa::phase(c, ldsg);             xcd_barrier(bar);
        ph_gemm<1>(c, l, lds); ph_gemm<2>(c, l, lds);                     xcd_barrier(bar);
        ph_gemm<3>(c, l, lds);          xcd_barrier(bar);
        ph_ln1_router(c, l, lds);       xcd_barrier(bar);
        ph_gemm<4>(c, l, lds);          xcd_barrier(bar);
        ph_gemm<5>(c, l, lds);          xcd_barrier(bar);
        ph_ln2(c, l, lds);
        if (l + 1 < DEPTH) { __syncthreads(); ph_convert(c, l + 1, lds); xcd_barrier(bar); }
    }
}
extern "C" void kernel_launch(void* const* d_in, const int* in_sizes, int n_in, void* d_out, int out_size, void* d_ws, size_t ws_size, hipStream_t stream) {
    static int ok = 0;
    if (ok == 0) {
        if (n_in != 21 || in_sizes[0] != T * DM || out_size != T * DM || ws_size < hg::WS_HG_END) { fprintf(stderr, "kernel_launch: unexpected shapes (n_in %d in0 %d out %d ws %zu, need ws >= %zu)\n", n_in, n_in > 0 ? in_sizes[0] : -1, out_size, ws_size, (size_t)hg::WS_HG_END); ok = -1; return; }
        if (hipFuncSetAttribute((const void*)k_mega, hipFuncAttributeMaxDynamicSharedMemorySize, LDS_TOTAL) != hipSuccess) { fprintf(stderr, "kernel_launch: hipFuncSetAttribute failed\n"); ok = -1; return; }
        ok = 1;
    }
    if (ok < 0) return;
    (void)hipMemsetAsync((char*)d_ws + WS_CTL, 0, CTL_BYTES, stream);
    KArgs a{};
    for (int i = 0; i < 21; ++i) a.in[i] = (const float*)d_in[i];
    a.out = (float*)d_out; a.ws = (unsigned char*)d_ws;
    hipLaunchKernelGGL(k_mega, dim3(256), dim3(NTHR), LDS_TOTAL, stream, a);
}
```

```cpp
#include <hip/hip_runtime.h>
#include <stdint.h>
#include <stdio.h>

typedef unsigned short bf16_t;
typedef float f32x4 __attribute__((ext_vector_type(4)));
typedef unsigned u32x4 __attribute__((ext_vector_type(4)));
typedef unsigned u32x2 __attribute__((ext_vector_type(2)));
#define LAS __attribute__((address_space(3)))

constexpr int DM = 1024, NB = 4, SEQ = 8192, T = NB * SEQ, DEPTH = 4;
constexpr int NH = 8, DH = 128;
constexpr int IN_COLS = 9224, INP = 9216, FF_COL = 7168;
constexpr int NG = 4, EPG = 8, NE = 32, DE = 512;
constexpr float ALPHA = 1.6817928305074292f;
constexpr float LN_EPS = 1e-5f, NORM_EPS = 1e-6f;
constexpr float SQRT_DH = 11.313708498984761f;
constexpr float ATT_SCALE = 0.08838834764831845f;
constexpr int NSLOT = 2 * T + NE * 256;

constexpr size_t MiB = 1u << 20;
constexpr size_t WS_CTL = 0, CTL_BYTES = 1 * MiB;
constexpr size_t WS_LB = 1 * MiB;
constexpr size_t WS_RWT = 1 * MiB + 65536;
constexpr size_t WS_FFL = 2 * MiB;
constexpr size_t WS_KBIAS = 3 * MiB;
constexpr size_t WS_TOPE = 4 * MiB;
constexpr size_t WS_TOPW = 4 * MiB + 262144;
constexpr size_t WS_TPOS = 4 * MiB + 524288;
constexpr size_t WS_STE = 5 * MiB;
constexpr size_t WS_WIN = 16 * MiB;
constexpr float WIN_SCALE = 32.f;
constexpr size_t WS_WA = 34 * MiB, WS_WB = 36 * MiB, WS_WO = 38 * MiB;
constexpr float MG_SCALE = 8.f;
constexpr size_t WS_WGU = 40 * MiB;
constexpr size_t WS_WD = 104 * MiB;
constexpr size_t WS_USLO = 136 * MiB;
constexpr size_t WS_X18 = 232 * MiB;
constexpr size_t WS_XB8 = 200 * MiB;
constexpr size_t WS_XBF = 264 * MiB;
constexpr size_t WS_QA = 328 * MiB;
constexpr size_t WS_OA = 456 * MiB;
constexpr size_t WS_OB = 488 * MiB;
constexpr size_t WS_LF = 392 * MiB;
constexpr size_t WS_YX = 392 * MiB;
constexpr size_t WS_VA = 520 * MiB;
constexpr size_t WS_GA = 584 * MiB;
constexpr size_t WS_FQ = 648 * MiB;
constexpr size_t WS_FK = 712 * MiB;
constexpr size_t WS_FV = 776 * MiB;
constexpr size_t WS_SGA = 840 * MiB, WS_SGB = 904 * MiB;
constexpr size_t WS_HB = 520 * MiB;
constexpr size_t WS_YB = 592 * MiB;
constexpr size_t WS_END = 968 * MiB;
static_assert(WS_HB + (size_t)NSLOT * 512 * 2 <= WS_YB && WS_YB + (size_t)NSLOT * 1024 * 2 <= 840 * MiB, "moe overlay");
constexpr int CW_CNT = 1024;

struct KArgs { const float* in[21]; float* out; unsigned char* ws; };
extern __shared__ __attribute__((aligned(16))) unsigned char g_lds[];
constexpr int LDS_STAGE_BYTES = 131072, LDS_TOTAL = 163840, LDS_MISC = LDS_TOTAL - 4096;
typedef __attribute__((address_space(4))) const unsigned long long cu64_t;
__device__ __forceinline__ void* ctx_ptr(int i) {
    const uintptr_t k = (uintptr_t)__builtin_amdgcn_kernarg_segment_ptr();
    unsigned lo = (unsigned)k, hi = (unsigned)(k >> 32); asm volatile("" : "+s"(lo), "+s"(hi));
    cu64_t* t = (cu64_t*)(((uintptr_t)hi << 32) | lo);
    return (void*)(__attribute__((address_space(1))) void*)(uintptr_t)t[i];
}
struct Ctx {
    struct In { __device__ __forceinline__ const float* operator[](int i) const { return (const float*)ctx_ptr(i); } } in;
    __device__ __forceinline__ float* outp() const { return (float*)ctx_ptr(21); }
};
__device__ __forceinline__ unsigned char* wsl(const Ctx&) { return (unsigned char*)ctx_ptr(22); }
enum { I_X = 0, I_WIN, I_BFF, I_GQ, I_GK, I_LBL, I_HGN, I_WA, I_WB, I_WO, I_L1G, I_L1B, I_RGW, I_RGB, I_REW, I_REB, I_WG, I_WU, I_WD, I_L2G, I_L2B };

typedef __bf16 bf16v2_t __attribute__((ext_vector_type(2)));
typedef float f32v2_t __attribute__((ext_vector_type(2)));
typedef _Float16 f16v4_t __attribute__((ext_vector_type(4)));
typedef _Float16 f16v8_t __attribute__((ext_vector_type(8)));
__device__ __forceinline__ unsigned cvt_pk_bf16(float lo, float hi) { f32v2_t v = {lo, hi}; bf16v2_t b = __builtin_convertvector(v, bf16v2_t); return __builtin_bit_cast(unsigned, b); }
__device__ __forceinline__ int bidx() { int b = blockIdx.x; asm volatile("" : "+s"(b)); return b; }
__device__ __forceinline__ int tidx() { int t = threadIdx.x; asm volatile("" : "+v"(t)); return t; }
__device__ __forceinline__ float bf2f(bf16_t b) { return __uint_as_float(((unsigned)b) << 16); }
__device__ __forceinline__ unsigned f2bf(float f) { unsigned u = __float_as_uint(f); return (u + 0x7fffu + ((u >> 16) & 1u)) >> 16; }
__device__ __forceinline__ unsigned pk2(float lo, float hi) { return f2bf(lo) | (f2bf(hi) << 16); }
__device__ __forceinline__ float sigm(float x) { return 1.f / (1.f + __expf(-x)); }
__device__ __forceinline__ float silu(float x) { return x / (1.f + __expf(-x)); }
typedef _Float16 f16v2_t __attribute__((ext_vector_type(2)));
__device__ __forceinline__ unsigned cvt_pk_f16(float lo, float hi) { f32v2_t v = {lo, hi}; f16v2_t h = __builtin_convertvector(v, f16v2_t); return __builtin_bit_cast(unsigned, h); }
__device__ __forceinline__ void unpack_f16x2(unsigned u, float& lo, float& hi) { const f16v2_t h = __builtin_bit_cast(f16v2_t, u); lo = (float)h[0]; hi = (float)h[1]; }
__device__ __forceinline__ f32x4 unpack_f16x4(unsigned a, unsigned b) { const f16v2_t h0 = __builtin_bit_cast(f16v2_t, a), h1 = __builtin_bit_cast(f16v2_t, b); return (f32x4){(float)h0[0], (float)h0[1], (float)h1[0], (float)h1[1]}; }
__device__ __forceinline__ unsigned pack4_fp8(float a, float b, float c, float d) { int v = __builtin_amdgcn_cvt_pk_fp8_f32(a, b, 0, false); v = __builtin_amdgcn_cvt_pk_fp8_f32(c, d, v, true); return (unsigned)v; }
typedef float f32v2u_t __attribute__((ext_vector_type(2)));
__device__ __forceinline__ f32x4 unpack4_fp8(unsigned u) { const f32v2u_t a = __builtin_amdgcn_cvt_pk_f32_fp8((int)u, false), b = __builtin_amdgcn_cvt_pk_f32_fp8((int)u, true); return (f32x4){a[0], a[1], b[0], b[1]}; }
#define DPPF(v, ctrl, rmask, bc) __builtin_bit_cast(float, __builtin_amdgcn_update_dpp(0, __builtin_bit_cast(int, (float)(v)), ctrl, rmask, 0xF, bc))
__device__ __forceinline__ float dpp_xor1(float v) { return DPPF(v, 0xB1, 0xF, false); }
__device__ __forceinline__ float dpp_xor2(float v) { return DPPF(v, 0x4E, 0xF, false); }
__device__ __forceinline__ float row_sum16(float v) { v += DPPF(v, 0xB1, 0xF, false); v += DPPF(v, 0x4E, 0xF, false); v += DPPF(v, 0x141, 0xF, false); v += DPPF(v, 0x140, 0xF, false); return v; }
__device__ __forceinline__ float dpp_sum64(float v) { v = row_sum16(v); v += DPPF(v, 0x142, 0xA, false); v += DPPF(v, 0x143, 0xC, false); return v; }
__device__ __forceinline__ float wave_sum(float v) { return __builtin_bit_cast(float, __builtin_amdgcn_readlane(__builtin_bit_cast(int, dpp_sum64(v)), 63)); }
__device__ __forceinline__ float dpp_shr(float v, int n) {
    return n == 1 ? DPPF(v, 0x111, 0xF, true) : (n == 2 ? DPPF(v, 0x112, 0xF, true) : (n == 4 ? DPPF(v, 0x114, 0xF, true) : DPPF(v, 0x118, 0xF, true)));
}
__device__ __forceinline__ float bperm(float v, int src_lane) { return __builtin_bit_cast(float, __builtin_amdgcn_ds_bpermute(src_lane << 2, __builtin_bit_cast(int, v))); }
struct InProjOut { unsigned char *QA, *VA, *GA, *SGA, *SGB  ; bf16_t *FQ, *FK, *FV; bf16_t* LF  ; const float* lb; };
__device__ __forceinline__ InProjOut make_ipo(const Ctx& c) {
    InProjOut o; unsigned char* ws = wsl(c);
    o.QA = ws + WS_QA; o.VA = ws + WS_VA; o.GA = ws + WS_GA; o.FQ = (bf16_t*)(ws + WS_FQ); o.FK = (bf16_t*)(ws + WS_FK); o.FV = (bf16_t*)(ws + WS_FV);
    o.SGA = ws + WS_SGA; o.SGB = ws + WS_SGB; o.LF = (bf16_t*)(ws + WS_LF); o.lb = (const float*)(ws + WS_LB); return o;
}
__device__ __forceinline__ size_t headmajor(int m, int c) { const int b = m >> 13, s = m & (SEQ - 1), h = c >> 7, d = c & 127; return ((size_t)((b * NH + h) * SEQ + s)) * DH + d; }
constexpr int NTHR = 512, NWAVE = 8;
struct Wv { int tid, lane, wave, gw, ngw; };
__device__ __forceinline__ Wv make_wv() { Wv w; w.tid = tidx(); w.lane = w.tid & 63; w.wave = __builtin_amdgcn_readfirstlane(w.tid >> 6); w.gw = bidx() * NWAVE + w.wave; w.ngw = gridDim.x * NWAVE; return w; }

template <bool F8>
__device__ __forceinline__ void transpose_item(const float* src, int ld, int k0, int c0, void* dst_row0, int K, LAS float* scr, int lane) {
    f32x4 v[16];
#pragma unroll
    for (int i = 0; i < 16; ++i) v[i] = *(const f32x4*)(src + (size_t)(k0 + 4 * i + (lane >> 4)) * ld + c0 + (lane & 15) * 4);
#pragma unroll
    for (int i = 0; i < 16; ++i) { LAS float* p = scr + (4 * i + (lane >> 4)) * 65 + (lane & 15) * 4; p[0] = v[i][0]; p[1] = v[i][1]; p[2] = v[i][2]; p[3] = v[i][3]; }
    asm volatile("s_waitcnt lgkmcnt(0)" ::: "memory");
    const int kc = (lane & 7) * 8;
#pragma unroll
    for (int i = 0; i < 8; ++i) { const int n = 8 * i + (lane >> 3); const LAS float* q = scr + kc * 65 + n;
        if (F8) { u32x2 o; o.x = pack4_fp8(q[0 * 65] * WIN_SCALE, q[1 * 65] * WIN_SCALE, q[2 * 65] * WIN_SCALE, q[3 * 65] * WIN_SCALE); o.y = pack4_fp8(q[4 * 65] * WIN_SCALE, q[5 * 65] * WIN_SCALE, q[6 * 65] * WIN_SCALE, q[7 * 65] * WIN_SCALE);
            *(u32x2*)((unsigned char*)dst_row0 + (size_t)n * K + k0 + kc) = o; }
        else { u32x4 o; o.x = cvt_pk_bf16(q[0 * 65], q[1 * 65]); o.y = cvt_pk_bf16(q[2 * 65], q[3 * 65]); o.z = cvt_pk_bf16(q[4 * 65], q[5 * 65]); o.w = cvt_pk_bf16(q[6 * 65], q[7 * 65]);
            *(u32x4*)((bf16_t*)dst_row0 + (size_t)n * K + k0 + kc) = o; } }
    asm volatile("s_waitcnt lgkmcnt(0)" ::: "memory");
}
constexpr int CV_IN = 16 * 144, CV_SQ = 16 * 16, CV_GU = 16 * 8, CV_DN = 8 * 16;
constexpr int CV_A_END = CV_IN + 3 * CV_SQ, CV_B_END = CV_A_END + (NE / 2) * 2 * CV_GU, CV_ALL = CV_IN + 3 * CV_SQ + NE * 2 * CV_GU + NE * CV_DN;
struct CvItem { const float* src; int ld, k0, c0; unsigned char* dst; int K; };
__device__ __forceinline__ CvItem cv_item(const Ctx& c, int layer, int it) {
    unsigned char* ws = wsl(c); CvItem d; int r = it;
    if (r < CV_IN) { const int kb = r / 144, nb = r % 144, n0 = nb * 64;
        d.src = c.in[I_WIN] + (size_t)layer * DM * IN_COLS; d.ld = IN_COLS; d.k0 = kb * 64; d.c0 = n0 + (n0 >= FF_COL ? 8 : 0); d.dst = (unsigned char*)(ws + WS_WIN) + (size_t)n0 * DM; d.K = DM; return d; }
    r -= CV_IN;
    if (r < 3 * CV_SQ) { const int which = r / CV_SQ, q = r % CV_SQ, kb = q / 16, nb = q % 16;
        d.src = c.in[which == 0 ? I_WA : (which == 1 ? I_WB : I_WO)] + (size_t)layer * DM * DM; d.ld = DM; d.k0 = kb * 64; d.c0 = nb * 64;
        d.dst = ws + (which == 0 ? WS_WA : (which == 1 ? WS_WB : WS_WO)) + (size_t)(nb * 64) * DM; d.K = DM; return d; }
    r -= 3 * CV_SQ;
    if (r < NE * 2 * CV_GU) { const int e = r / (2 * CV_GU), q = r % (2 * CV_GU), up = q / CV_GU, q2 = q % CV_GU, kb = q2 / 8, nb = q2 % 8, j0 = nb * 64;
        d.src = c.in[up ? I_WU : I_WG] + ((size_t)layer * NE + e) * DM * DE; d.ld = DE; d.k0 = kb * 64; d.c0 = j0;
        d.dst = (unsigned char*)(ws + WS_WGU) + ((size_t)e * 1024 + (j0 >> 7) * 256 + (j0 & 127) + up * 128) * DM; d.K = DM; return d; }
    r -= NE * 2 * CV_GU;
    { const int e = r / CV_DN, q = r % CV_DN, kb = q / 16, nb = q % 16;
        d.src = c.in[I_WD] + ((size_t)layer * NE + e) * DE * DM; d.ld = DM; d.k0 = kb * 64; d.c0 = nb * 64; d.dst = (unsigned char*)(ws + WS_WD) + ((size_t)e * 1024 + nb * 64) * DE; d.K = DE; return d; }
}
__device__ __forceinline__ void cv_load(f32x4 (&v)[16], const CvItem& d, int lane) {
#pragma unroll
    for (int i = 0; i < 16; ++i) v[i] = *(const f32x4*)(d.src + (size_t)(d.k0 + 4 * i + (lane >> 4)) * d.ld + d.c0 + (lane & 15) * 4);
}
__device__ __forceinline__ void cv_store(const f32x4 (&v)[16], const CvItem& d, LAS float* scr, int lane) {
#pragma unroll
    for (int i = 0; i < 16; ++i) { LAS float* p = scr + (4 * i + (lane >> 4)) * 65 + (lane & 15) * 4; p[0] = v[i][0]; p[1] = v[i][1]; p[2] = v[i][2]; p[3] = v[i][3]; }
    asm volatile("s_waitcnt lgkmcnt(0)" ::: "memory");
    const int kc = (lane & 7) * 8;
#pragma unroll
    for (int i = 0; i < 8; ++i) { const int n = 8 * i + (lane >> 3); const LAS float* q = scr + kc * 65 + n; u32x2 o;
        o.x = pack4_fp8(q[0 * 65] * WIN_SCALE, q[1 * 65] * WIN_SCALE, q[2 * 65] * WIN_SCALE, q[3 * 65] * WIN_SCALE); o.y = pack4_fp8(q[4 * 65] * WIN_SCALE, q[5 * 65] * WIN_SCALE, q[6 * 65] * WIN_SCALE, q[7 * 65] * WIN_SCALE);
        *(u32x2*)(d.dst + (size_t)n * d.K + d.k0 + kc) = o; }
    asm volatile("s_waitcnt lgkmcnt(0)" ::: "memory");
}
__device__ __forceinline__ void ph_convert(const Ctx& c, int layer, LAS unsigned char* lds, int it_lo = 0, int it_hi = CV_ALL, int gw = -1, int ngw = 1, bool tail = true) {
    const Wv w = make_wv(); LAS float* scr = (LAS float*)(lds + w.wave * 16640);
    unsigned char* ws = wsl(c);
    constexpr int I_IN = CV_IN, I_SQ = CV_SQ, I_GU = CV_GU, I_DN = CV_DN;
    if (gw < 0) { gw = w.gw; ngw = w.ngw; }
    for (int it = it_lo + gw; it < it_hi; it += ngw) {
        int r = it;
        if (r < I_IN) { const int kb = r / 144, nb = r % 144, n0 = nb * 64; const int c0 = n0 + (n0 >= FF_COL ? 8 : 0);
            transpose_item<true>(c.in[I_WIN] + (size_t)layer * DM * IN_COLS, IN_COLS, kb * 64, c0, (unsigned char*)(ws + WS_WIN) + (size_t)n0 * DM, DM, scr, w.lane); continue; }
        r -= I_IN;
        if (r < 3 * I_SQ) { const int which = r / I_SQ, q = r % I_SQ, kb = q / 16, nb = q % 16;
            const float* src = c.in[which == 0 ? I_WA : (which == 1 ? I_WB : I_WO)] + (size_t)layer * DM * DM;
            unsigned char* dst = ws + (which == 0 ? WS_WA : (which == 1 ? WS_WB : WS_WO));
            transpose_item<true>(src, DM, kb * 64, nb * 64, dst + (size_t)(nb * 64) * DM, DM, scr, w.lane); continue; }
        r -= 3 * I_SQ;
        if (r < NE * 2 * I_GU) { const int e = r / (2 * I_GU), q = r % (2 * I_GU), up = q / I_GU, q2 = q % I_GU, kb = q2 / 8, nb = q2 % 8, j0 = nb * 64;
            const float* src = c.in[up ? I_WU : I_WG] + ((size_t)layer * NE + e) * DM * DE;
            const int drow = (j0 >> 7) * 256 + (j0 & 127) + up * 128;
            transpose_item<true>(src, DE, kb * 64, j0, (unsigned char*)(ws + WS_WGU) + ((size_t)e * 1024 + drow) * DM, DM, scr, w.lane); continue; }
        r -= NE * 2 * I_GU;
        { const int e = r / I_DN, q = r % I_DN, kb = q / 16, nb = q % 16;
            const float* src = c.in[I_WD] + ((size_t)layer * NE + e) * DE * DM;
            transpose_item<true>(src, DM, kb * 64, nb * 64, (unsigned char*)(ws + WS_WD) + ((size_t)e * 1024 + nb * 64) * DE, DE, scr, w.lane); }
    }
    if (!tail) return;
    const int gt = bidx() * NTHR + w.tid, ngt = gridDim.x * NTHR;
    float* rwt = (float*)(ws + WS_RWT);
    for (int i = gt; i < 36 * DM; i += ngt) { const int j = i / DM, k = i % DM;
        rwt[i] = j < 4 ? c.in[I_RGW][((size_t)layer * DM + k) * NG + j] : c.in[I_REW][((size_t)layer * DM + k) * NE + (j - 4)]; }
    float* lb = (float*)(ws + WS_LB);
    for (int i = gt; i < DM; i += ngt) { float l[DEPTH], mx = -1e30f;
#pragma unroll
        for (int q = 0; q < DEPTH; ++q) { l[q] = c.in[I_LBL][q * DM + i]; mx = fmaxf(mx, l[q]); }
        float s = 0.f, p[DEPTH];
#pragma unroll
        for (int q = 0; q < DEPTH; ++q) { p[q] = expf(l[q] - mx); s += p[q]; }
        float acc = 0.f;
#pragma unroll
        for (int q = 1; q < DEPTH; ++q) if (q <= layer) acc += p[q] / s;
        lb[i] = acc; }
}

__device__ __forceinline__ void stage_ffw(const Ctx& c, int nl, LAS float* ffw, int tid) {
    const float* wbase = c.in[I_WIN] + (size_t)nl * DM * IN_COLS + FF_COL;
#pragma unroll
    for (int q = 0; q < 2; ++q) { const int k = tid + q * NTHR; const float* wr = wbase + (size_t)k * IN_COLS; const f32x4 w0 = *(const f32x4*)wr, w1 = *(const f32x4*)(wr + 4);
        ffw[0 * DM + k] = w0[0]; ffw[1 * DM + k] = w0[1]; ffw[2 * DM + k] = w0[2]; ffw[3 * DM + k] = w0[3]; ffw[4 * DM + k] = w1[0]; ffw[5 * DM + k] = w1[1]; ffw[6 * DM + k] = w1[2]; ffw[7 * DM + k] = w1[3]; }
    __syncthreads();
}
__device__ __forceinline__ void emit_xb_ffl(const Ctx& c, int nl, int row, const f32x4 (&v)[4], int lane, const LAS float* ffw) {
    unsigned char* wsb = wsl(c); bf16_t* xb = (bf16_t*)(wsb + WS_XBF) + (size_t)row * DM;
#pragma unroll
    for (int j = 0; j < 4; ++j) { u32x2 o; o.x = cvt_pk_f16(v[j][0], v[j][1]); o.y = cvt_pk_f16(v[j][2], v[j][3]); *(u32x2*)(xb + 256 * j + 4 * lane) = o;
        *(unsigned*)(wsb + WS_XB8 + (size_t)row * DM + 256 * j + 4 * lane) = pack4_fp8(v[j][0], v[j][1], v[j][2], v[j][3]); }
    float zz = 0.f;
#pragma unroll
    for (int h = 0; h < 8; ++h) { float z = 0.f;
#pragma unroll
        for (int j = 0; j < 4; ++j) { const f32x4 wv = *(const LAS f32x4*)(ffw + h * DM + 256 * j + 4 * lane); z += (v[j][0] * wv[0] + v[j][1] * wv[1]) + (v[j][2] * wv[2] + v[j][3] * wv[3]); }
        const float s = wave_sum(z); zz = (lane == h) ? s : zz; }
    if (lane < 8) { zz += c.in[I_BFF][nl * NH + lane]; ((float*)(wsb + WS_FFL))[(size_t)row * 8 + lane] = fminf(zz, 0.f) - log1pf(expf(-fabsf(zz))); }
}
__device__ __forceinline__ void ph_xprep(const Ctx& c, LAS unsigned char* lds) {
    const Wv w = make_wv(); LAS float* ffw = (LAS float*)(lds + 1024);
    stage_ffw(c, 0, ffw, w.tid);
    static_assert(T == 16 * NWAVE * 256, "ph_xprep: 16 rows per wave at the 256-workgroup grid");
    const float* X = c.in[I_X];
#define XP_LOAD(V, i) do { const f32x4* xr_ = (const f32x4*)(X + (size_t)(w.gw + (i) * w.ngw) * DM) + w.lane; _Pragma("unroll") for (int j = 0; j < 4; ++j) V[j] = xr_[64 * j]; __builtin_amdgcn_sched_barrier(0); } while (0)
    f32x4 va[4], vb[4];
    XP_LOAD(va, 0);
#pragma unroll 1
    for (int i = 0; i < 16; i += 2) {
        XP_LOAD(vb, i + 1);
        emit_xb_ffl(c, 0, w.gw + i * w.ngw, va, w.lane, ffw); __builtin_amdgcn_sched_barrier(0);
        if (i + 2 < 16) XP_LOAD(va, i + 2);
        emit_xb_ffl(c, 0, w.gw + (i + 1) * w.ngw, vb, w.lane, ffw); __builtin_amdgcn_sched_barrier(0);
    }
#undef XP_LOAD
    __syncthreads();
}

__device__ __forceinline__ void ph_foxprep(const Ctx& c, int layer, LAS unsigned char* lds) {
    const Wv w = make_wv(); unsigned char* ws = wsl(c);
    LAS float* wtot = (LAS float*)lds;
    const float* ffl = (const float*)(ws + WS_FFL); float* kb = (float*)(ws + WS_KBIAS);
    for (int seq = bidx(); seq < NB * NH; seq += gridDim.x) { const int b = seq >> 3, h = seq & 7;
        float loc[16], run = 0.f;
#pragma unroll
        for (int i = 0; i < 16; ++i) { run += ffl[((size_t)(b * SEQ + w.tid * 16 + i)) * 8 + h]; loc[i] = run; }
        float incl = run;
#pragma unroll
        for (int o = 1; o < 16; o <<= 1) incl += dpp_shr(incl, o);
        incl += DPPF(incl, 0x142, 0xA, false); incl += DPPF(incl, 0x143, 0xC, false);
        __syncthreads();
        if (w.lane == 63) wtot[w.wave] = incl;
        __syncthreads();
        float pre = incl - run;
        for (int q = 0; q < w.wave; ++q) pre += wtot[q];
#pragma unroll
        for (int i = 0; i < 16; ++i) kb[(size_t)seq * SEQ + w.tid * 16 + i] = -(pre + loc[i]) * SQRT_DH;
    }
}

constexpr int RW_PITCH = DM + 8;
constexpr int L1_W = 0, L1_WL = 36 * RW_PITCH * 2, L1_C = 2 * L1_WL, L1_CP = L1_C + 384, L1_ST = L1_CP + 4608, L1_CNT = L1_ST + 1024;
static_assert(L1_CNT + 256 <= LDS_MISC, "ln1 LDS map");
__device__ __forceinline__ void ph_ln1_router(const Ctx& c, int layer, LAS unsigned char* lds) {
    const Wv w = make_wv(); unsigned char* ws = wsl(c);
    LAS _Float16* Wh = (LAS _Float16*)(lds + L1_W); LAS _Float16* Wl = (LAS _Float16*)(lds + L1_WL); LAS float* c1 = (LAS float*)(lds + L1_C); LAS float* c2 = c1 + 48; LAS float* cp = (LAS float*)(lds + L1_CP);
    LAS float* st = (LAS float*)(lds + L1_ST); LAS unsigned* lcnt = (LAS unsigned*)(lds + L1_CNT); LAS unsigned* lbase = lcnt + 32;
    const float* g1 = c.in[I_L1G] + layer * DM; const float* b1 = c.in[I_L1B] + layer * DM; const float* rwt = (const float*)(ws + WS_RWT);
    const float* rgb = c.in[I_RGB] + layer * NG; const float* reb = c.in[I_REB] + layer * NE;
    for (int p = w.tid; p < 36 * 16; p += NTHR) { const int n = p >> 4, ch = p & 15; float s1 = 0.f, s2 = 0.f;
#pragma unroll 4
        for (int i = 0; i < 16; ++i) { const int k = ch * 64 + 4 * i; const f32x4 wv = *(const f32x4*)(rwt + n * DM + k), g = *(const f32x4*)(g1 + k), bb = *(const f32x4*)(b1 + k);
            const f32x4 wg = wv * g, wb = wv * bb; s1 += (wg[0] + wg[1]) + (wg[2] + wg[3]); s2 += (wb[0] + wb[1]) + (wb[2] + wb[3]);
            const f16v4_t hi = __builtin_convertvector(wg, f16v4_t); const f32x4 res = (wg - __builtin_convertvector(hi, f32x4)) * 2048.f; const f16v4_t lo = __builtin_convertvector(res, f16v4_t);
            *(LAS f16v4_t*)(Wh + n * RW_PITCH + k) = hi; *(LAS f16v4_t*)(Wl + n * RW_PITCH + k) = lo; }
        cp[(n * 16 + ch) * 2] = s1; cp[(n * 16 + ch) * 2 + 1] = s2; }
    if (w.tid < 64) lcnt[w.tid] = 0u;
    __syncthreads();
    if (w.tid < 36) { float s1 = 0.f, s2 = 0.f;
        for (int ch = 0; ch < 16; ++ch) { s1 += cp[(w.tid * 16 + ch) * 2]; s2 += cp[(w.tid * 16 + ch) * 2 + 1]; }
        c1[w.tid] = s1; c2[w.tid] = s2 + (w.tid < 4 ? rgb[w.tid] : reb[w.tid - 4]); }
    __syncthreads();
    const int x = w.lane & 15, kq = w.lane >> 4, row0 = w.gw * 16;
    bf16_t* Y = (bf16_t*)(ws + WS_YX);
    const bf16_t* yrow = Y + (size_t)(row0 + x) * DM + 8 * kq;
    const int wo0 = x * RW_PITCH + 8 * kq, wo1 = (16 + x) * RW_PITCH + 8 * kq, wo2 = (32 + x < 36 ? 32 + x : 35) * RW_PITCH + 8 * kq;
    f32x4 acc0 = {0.f, 0.f, 0.f, 0.f}, acc1 = acc0, acc2 = acc0, lo0 = acc0, lo1 = acc0, lo2 = acc0; float s1 = 0.f, s2 = 0.f;
    u32x4 ybuf[4];
#pragma unroll
    for (int u = 0; u < 4; ++u) ybuf[u] = *(const u32x4*)(yrow + 32 * u);
    for (int s0 = 0; s0 < 32; s0 += 4) {
#pragma unroll
        for (int u = 0; u < 4; ++u) { const int s = s0 + u; const u32x4 yr = ybuf[u];
            if (s + 4 < 32) ybuf[u] = *(const u32x4*)(yrow + 32 * (s + 4));
            const f32x4 ya = unpack_f16x4(yr.x, yr.y), yb = unpack_f16x4(yr.z, yr.w);
            s1 += ((ya[0] + ya[1]) + (ya[2] + ya[3])) + ((yb[0] + yb[1]) + (yb[2] + yb[3]));
            s2 += ((ya[0] * ya[0] + ya[1] * ya[1]) + (ya[2] * ya[2] + ya[3] * ya[3])) + ((yb[0] * yb[0] + yb[1] * yb[1]) + (yb[2] * yb[2] + yb[3] * yb[3]));
            const f16v8_t ay = __builtin_bit_cast(f16v8_t, yr);
            const f16v8_t h0 = *(const LAS f16v8_t*)(Wh + wo0 + 32 * s), h1 = *(const LAS f16v8_t*)(Wh + wo1 + 32 * s), h2 = *(const LAS f16v8_t*)(Wh + wo2 + 32 * s);
            const f16v8_t l0 = *(const LAS f16v8_t*)(Wl + wo0 + 32 * s), l1 = *(const LAS f16v8_t*)(Wl + wo1 + 32 * s), l2 = *(const LAS f16v8_t*)(Wl + wo2 + 32 * s);
            acc0 = __builtin_amdgcn_mfma_f32_16x16x32_f16(ay, h0, acc0, 0, 0, 0); acc1 = __builtin_amdgcn_mfma_f32_16x16x32_f16(ay, h1, acc1, 0, 0, 0); acc2 = __builtin_amdgcn_mfma_f32_16x16x32_f16(ay, h2, acc2, 0, 0, 0);
            lo0 = __builtin_amdgcn_mfma_f32_16x16x32_f16(ay, l0, lo0, 0, 0, 0); lo1 = __builtin_amdgcn_mfma_f32_16x16x32_f16(ay, l1, lo1, 0, 0, 0); lo2 = __builtin_amdgcn_mfma_f32_16x16x32_f16(ay, l2, lo2, 0, 0, 0); } }
    acc0 += lo0 * (1.f / 2048.f); acc1 += lo1 * (1.f / 2048.f); acc2 += lo2 * (1.f / 2048.f);
    s1 += bperm(s1, w.lane ^ 16); s1 += bperm(s1, w.lane ^ 32); s2 += bperm(s2, w.lane ^ 16); s2 += bperm(s2, w.lane ^ 32);
    { const float mean = s1 * (1.f / DM), var = fmaxf(s2 * (1.f / DM) - mean * mean, 0.f);
      if (kq == 0) { st[(w.wave * 16 + x) * 2] = mean; st[(w.wave * 16 + x) * 2 + 1] = rsqrtf(var + LN_EPS); } }
    __syncthreads();
    LAS float* Lw = (LAS float*)lds + w.wave * 640;
#pragma unroll
    for (int r = 0; r < 4; ++r) { const int row = 4 * kq + r; const float mean = st[(w.wave * 16 + row) * 2], rstd = st[(w.wave * 16 + row) * 2 + 1];
        Lw[row * 40 + x] = rstd * (acc0[r] - mean * c1[x]) + c2[x]; Lw[row * 40 + 16 + x] = rstd * (acc1[r] - mean * c1[16 + x]) + c2[16 + x];
        if (x < 4) Lw[row * 40 + 32 + x] = rstd * (acc2[r] - mean * c1[32 + x]) + c2[32 + x]; }
    asm volatile("s_waitcnt lgkmcnt(0)" ::: "memory");
    int* tope = (int*)(ws + WS_TOPE); float* topw = (float*)(ws + WS_TOPW); int* tpos = (int*)(ws + WS_TPOS); int* ste = (int*)(ws + WS_STE);
    if (w.lane < 16) { const int m = row0 + w.lane; const LAS float* L = Lw + w.lane * 40;
        float gl[4];
#pragma unroll
        for (int q = 0; q < 4; ++q) gl[q] = L[q];
        int grp = 0; float gm = gl[0];
#pragma unroll
        for (int q = 1; q < 4; ++q) if (gl[q] > gm) { gm = gl[q]; grp = q; }
        float gs = 0.f;
#pragma unroll
        for (int q = 0; q < 4; ++q) gs += expf(gl[q] - gm);
        const float pg = 1.f / gs;
        float el[8];
#pragma unroll
        for (int i = 0; i < 8; ++i) el[i] = L[4 + grp * EPG + i];
        int i0 = 0; float v0 = el[0];
#pragma unroll
        for (int i = 1; i < 8; ++i) if (el[i] > v0) { v0 = el[i]; i0 = i; }
        int i1 = -1; float v1 = -3.0e38f;
#pragma unroll
        for (int i = 0; i < 8; ++i) if (i != i0 && el[i] > v1) { v1 = el[i]; i1 = i; }
        const float w0 = 1.f / (1.f + expf(v1 - v0));
        const int e0 = grp * EPG + i0, e1 = grp * EPG + i1;
        tope[2 * m] = e0; tope[2 * m + 1] = e1; topw[2 * m] = w0 * pg; topw[2 * m + 1] = (1.f - w0) * pg;
        tpos[2 * m] = (int)atomicAdd((unsigned*)&lcnt[e0], 1u); tpos[2 * m + 1] = (int)atomicAdd((unsigned*)&lcnt[e1], 1u); }
    f32x4 gg[4], bb[4];
#pragma unroll
    for (int j = 0; j < 4; ++j) { gg[j] = *(const f32x4*)(g1 + 256 * j + 4 * w.lane); bb[j] = *(const f32x4*)(b1 + 256 * j + 4 * w.lane); }
#define L1_LOAD(R, g) do { _Pragma("unroll") for (int r = 0; r < 4; ++r) _Pragma("unroll") for (int j = 0; j < 4; ++j) R[r][j] = *(const u32x2*)(Y + (size_t)(row0 + 4 * (g) + r) * DM + 256 * j + 4 * w.lane); \
        __builtin_amdgcn_sched_barrier(0); } while (0)
#define L1_APPLY(R, g) do { const int m0 = row0 + 4 * (g);                                                                                                       \
        _Pragma("unroll") for (int r = 0; r < 4; ++r) { const float mean = st[(w.wave * 16 + 4 * (g) + r) * 2], rstd = st[(w.wave * 16 + 4 * (g) + r) * 2 + 1];   \
            _Pragma("unroll") for (int j = 0; j < 4; ++j) { const f32x4 v = (unpack_f16x4(R[r][j].x, R[r][j].y) - mean) * rstd * gg[j] + bb[j];                   \
                u32x2 o; o.x = cvt_pk_f16(v[0], v[1]); o.y = cvt_pk_f16(v[2], v[3]); *(u32x2*)(Y + (size_t)(m0 + r) * DM + 256 * j + 4 * w.lane) = o;            \
                *(unsigned*)(ws + WS_X18 + (size_t)(m0 + r) * DM + 256 * j + 4 * w.lane) = pack4_fp8(v[0], v[1], v[2], v[3]); } }                                 \
        __builtin_amdgcn_sched_barrier(0); } while (0)
    { u32x2 ra[4][4], rb[4][4];
      L1_LOAD(ra, 0); L1_LOAD(rb, 1); L1_APPLY(ra, 0); L1_LOAD(ra, 2); L1_APPLY(rb, 1); L1_LOAD(rb, 3); L1_APPLY(ra, 2); L1_APPLY(rb, 3); }
#undef L1_LOAD
#undef L1_APPLY
    __syncthreads();
    if (w.tid < NE) lbase[w.tid] = atomicAdd((unsigned*)(ws + WS_CTL) + CW_CNT + layer * 64 + w.tid, lcnt[w.tid]);
    __syncthreads();
    if (w.lane < 32) { const int m = row0 + (w.lane >> 1), k = w.lane & 1; const int e = tope[2 * m + k]; const int p = tpos[2 * m + k] + (int)lbase[e]; tpos[2 * m + k] = p; ste[(size_t)e * T + p] = m; }
}

__device__ __forceinline__ void moe_starts(const Ctx& c, int layer, LAS int* start  , LAS int* cnt  ) {
    const unsigned* gc = (const unsigned*)(wsl(c) + WS_CTL) + CW_CNT + layer * 64;
    if (threadIdx.x < NE) cnt[threadIdx.x] = (int)__hip_atomic_load(gc + threadIdx.x, __ATOMIC_RELAXED, __HIP_MEMORY_SCOPE_AGENT);
    __syncthreads();
    if (threadIdx.x == 0) { int s = 0;
        for (int e = 0; e < NE; ++e) { const int n = cnt[e]; start[e] = s; s += (n + 255) & ~255; }
        start[NE] = s; }
    __syncthreads();
}

__device__ __forceinline__ void ph_ln2(const Ctx& c, int layer, LAS unsigned char* lds, float oscale = 1.f) {
    const Wv w = make_wv(); unsigned char* ws = wsl(c);
    LAS int* start = (LAS int*)lds; LAS int* cnt = start + 40; LAS float* ffw = (LAS float*)(lds + 1024);
    if (layer + 1 < DEPTH) stage_ffw(c, layer + 1, ffw, w.tid);
    moe_starts(c, layer, start, cnt);
    const bf16_t* X1 = (const bf16_t*)(ws + WS_YX); const bf16_t* YB = (const bf16_t*)(ws + WS_YB);
    const int* tope = (const int*)(ws + WS_TOPE); const float* topw = (const float*)(ws + WS_TOPW); const int* tpos = (const int*)(ws + WS_TPOS);
    const float* g2 = c.in[I_L2G] + layer * DM; const float* b2 = c.in[I_L2B] + layer * DM;
    float* dst = c.outp();
    for (int mA = w.gw; mA < T; mA += 2 * w.ngw) { const int mB = mA + w.ngw;
        int mm[2] = {mA, mB}; size_t s0[2], s1[2]; float w0[2], w1[2];
#pragma unroll
        for (int q = 0; q < 2; ++q) { const int m = mm[q]; const int e0 = tope[2 * m], e1 = tope[2 * m + 1]; w0[q] = topw[2 * m]; w1[q] = topw[2 * m + 1];
            s0[q] = (size_t)(start[e0] + tpos[2 * m]); s1[q] = (size_t)(start[e1] + tpos[2 * m + 1]); }
        u32x2 xr[2][4], ar[2][4], br[2][4];
#pragma unroll
        for (int q = 0; q < 2; ++q)
#pragma unroll
            for (int j = 0; j < 4; ++j) { xr[q][j] = *(const u32x2*)(X1 + (size_t)mm[q] * DM + 256 * j + 4 * w.lane);
                ar[q][j] = *(const u32x2*)(YB + s0[q] * DM + 256 * j + 4 * w.lane); br[q][j] = *(const u32x2*)(YB + s1[q] * DM + 256 * j + 4 * w.lane); }
#pragma unroll
        for (int q = 0; q < 2; ++q) { const int m = mm[q]; f32x4 v[4]; float s = 0.f;
#pragma unroll
            for (int j = 0; j < 4; ++j) { const f32x4 x = unpack_f16x4(xr[q][j].x, xr[q][j].y); const u32x2 a = ar[q][j], b = br[q][j];
                f32x4 ya, yb; ya[0] = __uint_as_float(a.x << 16); ya[1] = __uint_as_float(a.x & 0xffff0000u); ya[2] = __uint_as_float(a.y << 16); ya[3] = __uint_as_float(a.y & 0xffff0000u);
                yb[0] = __uint_as_float(b.x << 16); yb[1] = __uint_as_float(b.x & 0xffff0000u); yb[2] = __uint_as_float(b.y << 16); yb[3] = __uint_as_float(b.y & 0xffff0000u);
                v[j] = x * ALPHA + (ya * w0[q] + yb * w1[q]); s += (v[j][0] + v[j][1]) + (v[j][2] + v[j][3]); }
            const float mean = wave_sum(s) * (1.f / DM); float s2 = 0.f;
#pragma unroll
            for (int j = 0; j < 4; ++j) { v[j] = v[j] - mean; s2 += (v[j][0] * v[j][0] + v[j][1] * v[j][1]) + (v[j][2] * v[j][2] + v[j][3] * v[j][3]); }
            const float rstd = rsqrtf(wave_sum(s2) * (1.f / DM) + LN_EPS);
#pragma unroll
            for (int j = 0; j < 4; ++j) { const f32x4 g = *(const f32x4*)(g2 + 256 * j + 4 * w.lane), bb = *(const f32x4*)(b2 + 256 * j + 4 * w.lane);
                v[j] = v[j] * rstd * g + bb; if (layer == DEPTH - 1) *((f32x4*)(dst + (size_t)m * DM) + w.lane + 64 * j) = v[j] * oscale; }
            if (layer + 1 < DEPTH) emit_xb_ffl(c, layer + 1, m, v, w.lane, ffw); }
    }
}


namespace pg8 {
typedef short bf16x8 __attribute__((ext_vector_type(8)));
typedef int v8i_t __attribute__((ext_vector_type(8)));
typedef int i32x4_t __attribute__((ext_vector_type(4)));
constexpr int BM = 256, BK = 64, HALF = 128, HTB = HALF * BK * 2, STAGE_BYTES = 8 * HTB, NXCD = 8, WGM = 8;
__host__ __device__ __forceinline__ int lds_byte(int r, int c) { const int st = (r >> 4) * 2 + (c >> 5), rr = r & 15, cc = c & 31, ob = rr * 64 + cc * 2; return st * 1024 + (ob ^ (((ob >> 9) & 1) << 5)); }
__host__ __device__ __forceinline__ void stage_rc(int b, int& R, int& C) { const int st = b / 1024, sb = b % 1024, swz = sb ^ (((sb >> 9) & 1) << 5); R = (st >> 1) * 16 + swz / 64; C = (st & 1) * 32 + (swz % 64) / 2; }
__host__ __device__ __forceinline__ int perm32(int rho) { const int n = rho >> 4, i = rho & 15; return 8 * (i >> 2) + 4 * n + (i & 3); }
struct Unit { int pm, pn, e, rt; };
using ::cvt_pk_bf16;

struct StaticOrder {
    static constexpr bool GATHER = false;
    const char* A; const char* Bt; int nM, nN, nwg, G, c; size_t a_tstep, b_tstep;
    __device__ void init(const void* A_, const void* Bt_, int M, int N, int K, int G_, int c_, int elt_bytes = 2) { A = (const char*)A_; Bt = (const char*)Bt_; nM = M / BM; nN = N / BM; nwg = nM * nN; G = G_; c = c_; a_tstep = (size_t)BM * K * elt_bytes; b_tstep = a_tstep; }
    __device__ bool next(int i, Unit& u) const {
        const long L = (long)i * G + c; if (L >= nwg) return false;
        int wgid = (int)L; { const int q = nwg / NXCD, r = nwg % NXCD, xcd = wgid % NXCD, off = wgid / NXCD; wgid = (xcd < r ? xcd * (q + 1) : r * (q + 1) + (xcd - r) * q) + off; }
        const int nig = WGM * nN, gid = wgid / nig, fm = gid * WGM, gsz = (nM - fm) < WGM ? (nM - fm) : WGM;
        u.pm = fm + ((wgid % nig) % gsz); u.pn = (wgid % nig) / gsz; u.e = 0; u.rt = 0; return true;
    }
    __device__ __forceinline__ const char* a_base(const Unit& u) const { return A + (size_t)u.pm * a_tstep; }
    __device__ __forceinline__ const char* b_base(const Unit& u) const { return Bt + (size_t)u.pn * b_tstep; }
    __device__ __forceinline__ int tok(const Unit&, int) const { return 0; }
};
template <bool UP> struct MoeOrder {
    static constexpr bool GATHER = UP;
    const char* A; const char* Bt; const int* ste; LAS const int* tp; LAS const int* start; LAS const int* cnt; int G, c;
    __device__ bool next(int i, Unit& u) const {
        const int L = i * G + c; if (L >= tp[NE] * 4) return false;
        const int rtg = L >> 2; int e = 0;
        for (int q = 1; q < NE; ++q) if (rtg >= tp[q]) e = q;
        u.e = e; u.rt = rtg - tp[e]; u.pm = (start[e] >> 8) + u.rt; u.pn = L & 3; return true;
    }
    __device__ __forceinline__ const char* a_base(const Unit& u) const { return UP ? A : A + (size_t)u.pm * (BM * DE); }
    __device__ __forceinline__ const char* b_base(const Unit& u) const { return Bt + ((size_t)u.e * 1024 + u.pn * 256) * (UP ? DM : DE); }
    __device__ __forceinline__ int tok(const Unit& u, int r) const { const int i = u.rt * 256 + r; return i < cnt[u.e] ? ste[(size_t)u.e * T + i] : 0; }
};

template <int ACT> __device__ __forceinline__ float actf(float x) {
    if (ACT == 1) return x * __builtin_amdgcn_rcpf(1.f + __expf(-x));
    if (ACT == 2) return __builtin_amdgcn_rcpf(1.f + __expf(-x));
    return x;
}
template <int ACT> __device__ __forceinline__ f32x4 act4(const f32x4 x) {
    if (ACT == 0) return x;
    const f32x4 t = x * -1.4426950408889634f;
    const f32x4 e = {__builtin_amdgcn_exp2f(t[0]), __builtin_amdgcn_exp2f(t[1]), __builtin_amdgcn_exp2f(t[2]), __builtin_amdgcn_exp2f(t[3])};
    const f32x4 d = e + 1.f;
    const f32x4 r = {__builtin_amdgcn_rcpf(d[0]), __builtin_amdgcn_rcpf(d[1]), __builtin_amdgcn_rcpf(d[2]), __builtin_amdgcn_rcpf(d[3])};
    return ACT == 1 ? x * r : r;
}
template <int ACT> __device__ __forceinline__ u32x4 pack8_act(const f32x4 a, const f32x4 b) {
    u32x4 w; w.x = cvt_pk_bf16(actf<ACT>(a[0]), actf<ACT>(a[1])); w.y = cvt_pk_bf16(actf<ACT>(a[2]), actf<ACT>(a[3])); w.z = cvt_pk_bf16(actf<ACT>(b[0]), actf<ACT>(b[1])); w.w = cvt_pk_bf16(actf<ACT>(b[2]), actf<ACT>(b[3])); return w;
}
__device__ __forceinline__ void unpack8(const u32x4 r, f32x4& a, f32x4& b) {
    a[0] = __uint_as_float(r.x << 16); a[1] = __uint_as_float(r.x & 0xffff0000u); a[2] = __uint_as_float(r.y << 16); a[3] = __uint_as_float(r.y & 0xffff0000u);
    b[0] = __uint_as_float(r.z << 16); b[1] = __uint_as_float(r.z & 0xffff0000u); b[2] = __uint_as_float(r.w << 16); b[3] = __uint_as_float(r.w & 0xffff0000u);
}
struct EpiInProj {
    static constexpr bool PERM = true;
    InProjOut o; float sc;
    const float* gq; const float* gk; LAS float* xch; int lane;
    template <int ACT, bool HM> __device__ __forceinline__ void st16(bf16_t* base, const f32x4 (&acc)[2][2][4][2], int row0, int ctile, int wc, int fq) const {
#pragma unroll
        for (int ai = 0; ai < 2; ++ai)
#pragma unroll
            for (int m = 0; m < 4; ++m) { const int row = row0 + ai * HALF + m * 16;
                const size_t ro = HM ? ((size_t)((row >> 13) * (NH * SEQ) + (row & (SEQ - 1)))) * DH : (size_t)row * DM;
#pragma unroll
                for (int bj = 0; bj < 2; ++bj) { const int c0 = ctile + 128 * bj + 32 * wc + 8 * fq;
                    const size_t co = HM ? (size_t)(c0 >> 7) * SEQ * DH + (c0 & 127) : (size_t)c0;
                    *(u32x4*)(base + ro + co) = pack8_act<ACT>(acc[ai][bj][m][0] * sc, acc[ai][bj][m][1] * sc); } }
    }
    template <int ACT> __device__ __forceinline__ void st8(unsigned char* base, const f32x4 (&acc)[2][2][4][2], int row0, int ctile, int wc, int fq) const {
#pragma unroll
        for (int ai = 0; ai < 2; ++ai)
#pragma unroll
            for (int m = 0; m < 4; ++m)
#pragma unroll
                for (int bj = 0; bj < 2; ++bj) { const f32x4 a = act4<ACT>(acc[ai][bj][m][0] * sc), b = act4<ACT>(acc[ai][bj][m][1] * sc); u32x2 w;
                    w.x = pack4_fp8(a[0], a[1], a[2], a[3]); w.y = pack4_fp8(b[0], b[1], b[2], b[3]);
                    *(u32x2*)(base + (size_t)(row0 + ai * HALF + m * 16) * DM + ctile + 128 * bj + 32 * wc + 8 * fq) = w; }
    }
    template <bool HM> __device__ __forceinline__ void st_norm(bf16_t* base, const float* gain, const f32x4 (&acc)[2][2][4][2], int row0, int ctile, int wr, int wc, int fr, int fq, int par) const {
        LAS float* tb = xch + par * 2048;
#pragma unroll
        for (int ai = 0; ai < 2; ++ai)
#pragma unroll
            for (int m = 0; m < 4; ++m)
#pragma unroll
                for (int bj = 0; bj < 2; ++bj) { const f32x4 a = acc[ai][bj][m][0], b = acc[ai][bj][m][1];
                    float ss = ((a[0] * a[0] + a[1] * a[1]) + (a[2] * a[2] + a[3] * a[3])) + ((b[0] * b[0] + b[1] * b[1]) + (b[2] * b[2] + b[3] * b[3]));
                    ss += bperm(ss, lane ^ 16); ss += bperm(ss, lane ^ 32);
                    if (fq == 0) tb[((ai * HALF + wr * 64 + m * 16 + fr) * 2 + bj) * 4 + wc] = ss; }
        asm volatile("s_waitcnt lgkmcnt(0)" ::: "memory"); __builtin_amdgcn_s_barrier(); asm volatile("" ::: "memory");
#pragma unroll
        for (int bj = 0; bj < 2; ++bj) { const int c0 = ctile + 128 * bj + 32 * wc + 8 * fq; const f32x4 g0 = *(const f32x4*)(gain + (c0 & 127)), g1 = *(const f32x4*)(gain + (c0 & 127) + 4);
            const size_t co = HM ? (size_t)(c0 >> 7) * SEQ * DH + (c0 & 127) : (size_t)c0;
#pragma unroll
            for (int ai = 0; ai < 2; ++ai)
#pragma unroll
                for (int m = 0; m < 4; ++m) { const int row = row0 + ai * HALF + m * 16;
                    const f32x4 ps = *(const LAS f32x4*)(tb + ((ai * HALF + wr * 64 + m * 16 + fr) * 2 + bj) * 4);
                    const float r = rsqrtf(((ps[0] + ps[1]) + (ps[2] + ps[3])) * (sc * sc * (1.f / DH)) + NORM_EPS) * sc;
                    const size_t ro = HM ? ((size_t)((row >> 13) * (NH * SEQ) + (row & (SEQ - 1)))) * DH : (size_t)row * DM;
                    *(u32x4*)(base + ro + co) = pack8_act<0>(acc[ai][bj][m][0] * r * g0, acc[ai][bj][m][1] * r * g1); } }
    }
    __device__ __forceinline__ bool operator()(const f32x4 (&acc)[2][2][4][2], const Unit& u, int wr, int wc, int fr, int fq) const {
        const int region = u.pn >> 2, ctile = (u.pn & 3) * 256, row0 = u.pm * BM + wr * 64 + fr;
        if (region == 0) st8<1>(o.QA, acc, row0, ctile, wc, fq);
        else if (region == 2) st8<0>(o.VA, acc, row0, ctile, wc, fq);
        else if (region == 3) st8<1>(o.GA, acc, row0, ctile, wc, fq);
        else if (region == 4) st_norm<false>(o.FQ, gq, acc, row0, ctile, wr, wc, fr, fq, 0);
        else if (region == 5) st_norm<true>(o.FK, gk, acc, row0, ctile, wr, wc, fr, fq, 1);
        else if (region == 6) st16<0, true>(o.FV, acc, row0, ctile, wc, fq);
        else if (region == 7) st8<2>(o.SGA, acc, row0, ctile, wc, fq);
        else if (region == 8) st8<2>(o.SGB, acc, row0, ctile, wc, fq);
        else {
#pragma unroll
            for (int bj = 0; bj < 2; ++bj) { const int c0 = ctile + 128 * bj + 32 * wc + 8 * fq;
                const f32x4 l0 = *(const f32x4*)(o.lb + c0), l1 = *(const f32x4*)(o.lb + c0 + 4);
#pragma unroll
                for (int ai = 0; ai < 2; ++ai)
#pragma unroll
                    for (int m = 0; m < 4; ++m) { const int row = row0 + ai * HALF + m * 16; bf16_t* p = o.LF + (size_t)row * DM + c0;
                        f32x4 r0, r1;
#pragma unroll
                        for (int j = 0; j < 4; ++j) { r0[j] = __logf(l0[j] + (1.f - l0[j]) * actf<2>(acc[ai][bj][m][0][j] * sc)); r1[j] = __logf(l1[j] + (1.f - l1[j]) * actf<2>(acc[ai][bj][m][1][j] * sc)); }
                        u32x4 w; w.x = cvt_pk_f16(r0[0], r0[1]); w.y = cvt_pk_f16(r0[2], r0[3]); w.z = cvt_pk_f16(r1[0], r1[1]); w.w = cvt_pk_f16(r1[2], r1[3]); *(u32x4*)p = w; } }
        }
        return false;
    }
};
struct EpiMergeChain {
    static constexpr bool PERM = true;
    const unsigned char* sga; const unsigned char* sgb; unsigned char* MG; float sc;
    __device__ __forceinline__ bool operator()(f32x4 (&acc)[2][2][4][2], const Unit& u, int wr, int wc, int fr, int fq) const {
        const int row0 = u.pm * BM + wr * 64 + fr, cb = u.pn * BM + 32 * wc + 8 * fq;
#pragma unroll
        for (int ai = 0; ai < 2; ++ai) { u32x2 gb[4][2], ga[4][2];
#pragma unroll
            for (int m = 0; m < 4; ++m)
#pragma unroll
                for (int bj = 0; bj < 2; ++bj) { const size_t i = (size_t)(row0 + ai * HALF + m * 16) * DM + cb + 128 * bj; gb[m][bj] = *(const u32x2*)(sgb + i); if (u.e == 0) ga[m][bj] = *(const u32x2*)(sga + i); }
#pragma unroll
            for (int m = 0; m < 4; ++m)
#pragma unroll
                for (int bj = 0; bj < 2; ++bj) { const size_t i = (size_t)(row0 + ai * HALF + m * 16) * DM + cb + 128 * bj; const f32x4 b0 = unpack4_fp8(gb[m][bj].x), b1 = unpack4_fp8(gb[m][bj].y);
                    if (u.e == 0) { const f32x4 a0 = unpack4_fp8(ga[m][bj].x), a1 = unpack4_fp8(ga[m][bj].y);
#pragma unroll
                        for (int j = 0; j < 4; ++j) { acc[ai][bj][m][0][j] *= a0[j] * __builtin_amdgcn_rcpf(fmaxf(b0[j], 1e-30f)); acc[ai][bj][m][1][j] *= a1[j] * __builtin_amdgcn_rcpf(fmaxf(b1[j], 1e-30f)); } }
                    else { const f32x4 y0 = acc[ai][bj][m][0] * b0 * sc, y1 = acc[ai][bj][m][1] * b1 * sc; u32x2 w; w.x = pack4_fp8(y0[0], y0[1], y0[2], y0[3]); w.y = pack4_fp8(y1[0], y1[1], y1[2], y1[3]); *(u32x2*)(MG + i) = w; } }
            asm volatile("" ::: "memory"); }
        return u.e == 0;
    }
};
struct MergeOrder {
    static constexpr bool GATHER = false;
    StaticOrder base; const char* A2; const char* B2;
    __device__ bool next(int i, Unit& u) const { if (!base.next(i >> 1, u)) return false; u.e = i & 1; return true; }
    __device__ __forceinline__ const char* a_base(const Unit& u) const { return (u.e ? A2 : base.A) + (size_t)u.pm * base.a_tstep; }
    __device__ __forceinline__ const char* b_base(const Unit& u) const { return (u.e ? B2 : base.Bt) + (size_t)u.pn * base.b_tstep; }
    __device__ __forceinline__ int tok(const Unit&, int) const { return 0; }
};
struct EpiOut {
    static constexpr bool PERM = true;
    const bf16_t* x; bf16_t* Y; float sc;
    __device__ __forceinline__ bool operator()(const f32x4 (&acc)[2][2][4][2], const Unit& u, int wr, int wc, int fr, int fq) const {
        const int row0 = u.pm * BM + wr * 64 + fr, cb = u.pn * BM + 32 * wc + 8 * fq;
#pragma unroll
        for (int ai = 0; ai < 2; ++ai) { u32x4 xv[4][2];
#pragma unroll
            for (int m = 0; m < 4; ++m)
#pragma unroll
                for (int bj = 0; bj < 2; ++bj) xv[m][bj] = *(const u32x4*)(x + (size_t)(row0 + ai * HALF + m * 16) * DM + cb + 128 * bj);
#pragma unroll
            for (int m = 0; m < 4; ++m)
#pragma unroll
                for (int bj = 0; bj < 2; ++bj) { f32x4 x0, x1; const u32x4 r = xv[m][bj];
                    x0 = unpack_f16x4(r.x, r.y); x1 = unpack_f16x4(r.z, r.w);
                    const f32x4 y0 = x0 * ALPHA + acc[ai][bj][m][0] * sc, y1 = x1 * ALPHA + acc[ai][bj][m][1] * sc;
                    u32x4 w; w.x = cvt_pk_f16(y0[0], y0[1]); w.y = cvt_pk_f16(y0[2], y0[3]); w.z = cvt_pk_f16(y1[0], y1[1]); w.w = cvt_pk_f16(y1[2], y1[3]);
                    *(u32x4*)(Y + (size_t)(row0 + ai * HALF + m * 16) * DM + cb + 128 * bj) = w; }
            asm volatile("" ::: "memory"); }
        return false;
    }
};
struct EpiMoeUp {
    static constexpr bool PERM = true;
    unsigned char* HB; float sc;
    __device__ __forceinline__ bool operator()(const f32x4 (&acc)[2][2][4][2], const Unit& u, int wr, int wc, int fr, int fq) const {
        const int row0 = u.pm * BM + wr * 64 + fr, j0 = u.pn * 128 + 32 * wc + 8 * fq;
#pragma unroll
        for (int ai = 0; ai < 2; ++ai)
#pragma unroll
            for (int m = 0; m < 4; ++m) { f32x4 h0, h1;
                h0 = act4<1>(acc[ai][0][m][0] * sc) * (acc[ai][1][m][0] * sc); h1 = act4<1>(acc[ai][0][m][1] * sc) * (acc[ai][1][m][1] * sc);
                u32x2 w; w.x = pack4_fp8(h0[0], h0[1], h0[2], h0[3]); w.y = pack4_fp8(h1[0], h1[1], h1[2], h1[3]);
                *(u32x2*)(HB + (size_t)(row0 + ai * HALF + m * 16) * DE + j0) = w; }
        return false;
    }
};
struct EpiMoeDn {
    static constexpr bool PERM = true;
    bf16_t* YB; float sc;
    __device__ __forceinline__ bool operator()(const f32x4 (&acc)[2][2][4][2], const Unit& u, int wr, int wc, int fr, int fq) const {
        const int row0 = u.pm * BM + wr * 64 + fr, cb = u.pn * BM + 32 * wc + 8 * fq;
#pragma unroll
        for (int ai = 0; ai < 2; ++ai)
#pragma unroll
            for (int m = 0; m < 4; ++m)
#pragma unroll
                for (int bj = 0; bj < 2; ++bj) *(u32x4*)(YB + (size_t)(row0 + ai * HALF + m * 16) * DM + cb + 128 * bj) = pack8_act<0>(acc[ai][bj][m][0] * sc, acc[ai][bj][m][1] * sc);
        return false;
    }
};

template <int K, class Epi, class Sched, bool F8 = false>
__device__ __forceinline__ void gemm_phase(LAS unsigned char* lds, const Sched& S, const Epi& E) {
    const int tid = tidx(), wid = __builtin_amdgcn_readfirstlane(tid >> 6), lane = tid & 63, wr = wid >> 2, wc = wid & 3, fr = lane & 15, fq = lane >> 4;
    constexpr int RB = F8 ? K : K * 2, nt = RB / 128;
    int RA[2]; unsigned CA2[2], voffB[2], voffA[2][2], voffN[2][2];
#pragma unroll
    for (int i = 0; i < 2; ++i) { int R, C2;
        if (F8) { const int q = tid + 512 * i; R = 16 * (q >> 7) + (q & 15); C2 = (2 * ((q >> 4) & 3) + ((q >> 6) & 1)) * 16; }
        else { int C; stage_rc(tid * 16 + i * 8192, R, C); C2 = 2 * C; }
        const int Rb = Epi::PERM ? ((R & ~31) + perm32(R & 31)) : R;
        RA[i] = R; CA2[i] = (unsigned)C2; voffB[i] = (unsigned)(Rb * RB + C2); }
    const size_t kstep = (size_t)128, hstepB = (size_t)HALF * RB;
    const unsigned ldsw = (unsigned)wid * 1024u;
    const int aoff = F8 ? (4 * wr) * 2048 + lane * 16 : lds_byte(wr * 64 + fr, fq * 8), boff = F8 ? (2 * wc) * 2048 + lane * 16 : lds_byte(wc * 32 + fr, fq * 8);
#define PG8_SA(b, h) (((b) * 2 + (h)) * HTB)
#define PG8_SB(b, h) ((4 + (b) * 2 + (h)) * HTB)
#define PG8_STAGE(bufoff, gbase, voff) do { _Pragma("unroll") for (int _i = 0; _i < 2; ++_i) \
        __builtin_amdgcn_global_load_lds((const unsigned*)((const char*)(gbase) + (voff)[_i]), (LAS unsigned*)(lds + (bufoff) + ldsw + _i * 8192), 16, 0, 0); } while (0)
#define PG8_LDA(dst, b, h) do { if (F8) { unsigned ab_ = (unsigned)aoff; asm volatile("" : "+v"(ab_)); const LAS unsigned char* ap_ = lds + ab_ + PG8_SA(b, h); \
            _Pragma("unroll") for (int m = 0; m < 4; ++m) dst##8[m] = __builtin_shufflevector(*(const LAS i32x4_t*)(ap_ + m * 2048), *(const LAS i32x4_t*)(ap_ + m * 2048 + 1024), 0, 1, 2, 3, 4, 5, 6, 7); } \
        else { _Pragma("unroll") for (int m = 0; m < 4; ++m) _Pragma("unroll") for (int k = 0; k < 2; ++k) dst[m][k] = *(const LAS bf16x8*)(lds + PG8_SA(b, h) + aoff + m * 2048 + k * 1024); } } while (0)
#define PG8_LDB(dst, b, h) do { if (F8) { unsigned bb_ = (unsigned)boff; asm volatile("" : "+v"(bb_)); const LAS unsigned char* bp_ = lds + bb_ + PG8_SB(b, h); \
            _Pragma("unroll") for (int n = 0; n < 2; ++n) dst##8[n] = __builtin_shufflevector(*(const LAS i32x4_t*)(bp_ + n * 2048), *(const LAS i32x4_t*)(bp_ + n * 2048 + 1024), 0, 1, 2, 3, 4, 5, 6, 7); } \
        else { _Pragma("unroll") for (int n = 0; n < 2; ++n) _Pragma("unroll") for (int k = 0; k < 2; ++k) dst[n][k] = *(const LAS bf16x8*)(lds + PG8_SB(b, h) + boff + n * 2048 + k * 1024); } } while (0)
#define PG8_MMA(ai, bj, At, Bt) do { __builtin_amdgcn_s_setprio(1); \
        if (F8) { _Pragma("unroll") for (int m = 0; m < 4; ++m) _Pragma("unroll") for (int n = 0; n < 2; ++n) \
            asm volatile("v_mfma_f32_16x16x128_f8f6f4 %0, %1, %2, %0" : "+v"(acc[ai][bj][m][n]) : "v"(Bt##8[n]), "v"(At##8[m])); } \
        else { _Pragma("unroll") for (int m = 0; m < 4; ++m) _Pragma("unroll") for (int n = 0; n < 2; ++n) _Pragma("unroll") for (int k = 0; k < 2; ++k) \
            acc[ai][bj][m][n] = __builtin_amdgcn_mfma_f32_16x16x32_bf16(Bt[n][k], At[m][k], acc[ai][bj][m][n], 0, 0, 0); } \
        __builtin_amdgcn_s_setprio(0); } while (0)
#define PG8_WAIT_V(n) asm volatile("s_waitcnt vmcnt(" #n ")" ::: "memory")
#define PG8_WAIT_L(n) asm volatile("s_waitcnt lgkmcnt(" #n ")" ::: "memory")
#define PG8_BAR __builtin_amdgcn_s_barrier()
#define PG8_SCHED __builtin_amdgcn_sched_barrier(0)
#define PG8_SETOFF(dst, u) do { _Pragma("unroll") for (int _h = 0; _h < 2; ++_h) _Pragma("unroll") for (int _i = 0; _i < 2; ++_i) \
        dst[_h][_i] = Sched::GATHER ? (unsigned)S.tok(u, RA[_i] + HALF * _h) * (unsigned)RB + CA2[_i] : (unsigned)((RA[_i] + HALF * _h) * RB) + CA2[_i]; } while (0)
    Unit cur, nxt; int ui = 0;
    if (!S.next(0, cur)) return;
    f32x4 acc[2][2][4][2];
#pragma unroll
    for (int a = 0; a < 2; ++a)
#pragma unroll
        for (int b = 0; b < 2; ++b)
#pragma unroll
            for (int m = 0; m < 4; ++m)
#pragma unroll
                for (int n = 0; n < 2; ++n) acc[a][b][m][n] = (f32x4){0.f, 0.f, 0.f, 0.f};
    bf16x8 At[4][2], B0[2][2], B1[2][2]; v8i_t At8[4], B08[2], B18[2];
    PG8_SETOFF(voffA, cur);
    const char* cA = S.a_base(cur); const char* cB = S.b_base(cur);
    PG8_STAGE(PG8_SB(0, 0), cB, voffB); PG8_STAGE(PG8_SA(0, 0), cA, voffA[0]); PG8_STAGE(PG8_SB(0, 1), cB + hstepB, voffB); PG8_STAGE(PG8_SA(0, 1), cA, voffA[1]);
    if (wr == 1) PG8_BAR;
    PG8_WAIT_V(4); PG8_BAR;
    PG8_STAGE(PG8_SB(1, 0), cB + kstep, voffB); PG8_STAGE(PG8_SA(1, 0), cA + kstep, voffA[0]); PG8_STAGE(PG8_SB(1, 1), cB + hstepB + kstep, voffB);
    PG8_WAIT_V(6); PG8_BAR;
    for (;;) {
        const bool has_next = S.next(ui + 1, nxt);
        const char* nA = has_next ? S.a_base(nxt) : cA; const char* nB = has_next ? S.b_base(nxt) : cB;
        if (Sched::GATHER) { if (has_next) { PG8_SETOFF(voffN, nxt); } else {
#pragma unroll
            for (int h = 0; h < 2; ++h)
#pragma unroll
                for (int i = 0; i < 2; ++i) voffN[h][i] = voffA[h][i]; } }
        if (Sched::GATHER) asm volatile("" : "+v"(voffN[0][0]), "+v"(voffN[0][1]), "+v"(voffN[1][0]), "+v"(voffN[1][1]));
#pragma unroll 1
        for (int t = 0; t < nt; t += 2) {
            const bool last = (t == nt - 2);
            const char* a1 = cA + (size_t)(t + 1) * kstep;
            const char* a2 = last ? nA : cA + (size_t)(t + 2) * kstep; const char* b2 = last ? nB : cB + (size_t)(t + 2) * kstep;
            const char* a3 = a2 + kstep; const char* b3 = b2 + kstep;
            unsigned v2[2][2];
#pragma unroll
            for (int h = 0; h < 2; ++h)
#pragma unroll
                for (int i = 0; i < 2; ++i) v2[h][i] = (Sched::GATHER && last) ? voffN[h][i] : voffA[h][i];
            PG8_LDB(B0, 0, 0); PG8_SCHED; PG8_LDA(At, 0, 0); PG8_STAGE(PG8_SA(1, 1), a1, voffA[1]);
            PG8_WAIT_L(8); PG8_BAR; PG8_WAIT_L(0); PG8_MMA(0, 0, At, B0); PG8_BAR; PG8_SCHED;
            PG8_LDB(B1, 0, 1); PG8_STAGE(PG8_SB(0, 0), b2, voffB);
            PG8_BAR; PG8_WAIT_L(0); PG8_MMA(0, 1, At, B1); PG8_BAR;
            PG8_LDA(At, 0, 1); PG8_STAGE(PG8_SA(0, 0), a2, v2[0]);
            PG8_BAR; PG8_WAIT_L(0); PG8_MMA(1, 0, At, B0); PG8_BAR; PG8_SCHED;
            PG8_STAGE(PG8_SB(0, 1), b2 + hstepB, voffB);
            PG8_WAIT_V(6); PG8_BAR; PG8_MMA(1, 1, At, B1); PG8_BAR;
            PG8_LDB(B0, 1, 0); PG8_SCHED; PG8_LDA(At, 1, 0); PG8_STAGE(PG8_SA(0, 1), a2, v2[1]);
            PG8_WAIT_L(8); PG8_BAR; PG8_WAIT_L(0); PG8_MMA(0, 0, At, B0); PG8_BAR; PG8_SCHED;
            PG8_LDB(B1, 1, 1); PG8_STAGE(PG8_SB(1, 0), b3, voffB);
            PG8_BAR; PG8_WAIT_L(0); PG8_MMA(0, 1, At, B1); PG8_BAR;
            PG8_LDA(At, 1, 1); PG8_STAGE(PG8_SA(1, 0), a3, v2[0]);
            PG8_BAR; PG8_WAIT_L(0); PG8_MMA(1, 0, At, B0); PG8_BAR; PG8_SCHED;
            PG8_STAGE(PG8_SB(1, 1), b3 + hstepB, voffB);
            PG8_WAIT_V(6); PG8_BAR; PG8_MMA(1, 1, At, B1); PG8_BAR;
        }
        if (F8) asm volatile("s_nop 15\n\ts_nop 15" ::: "memory");
        const bool keep = E(acc, cur, wr, wc, fr, fq);
        if (!has_next) break;
        if (!keep) {
#pragma unroll
        for (int a = 0; a < 2; ++a)
#pragma unroll
            for (int b = 0; b < 2; ++b)
#pragma unroll
                for (int m = 0; m < 4; ++m)
#pragma unroll
                    for (int n = 0; n < 2; ++n) acc[a][b][m][n] = (f32x4){0.f, 0.f, 0.f, 0.f}; }
        cur = nxt; cA = nA; cB = nB; ++ui;
        if (Sched::GATHER) {
#pragma unroll
        for (int h = 0; h < 2; ++h)
#pragma unroll
            for (int i = 0; i < 2; ++i) voffA[h][i] = voffN[h][i]; }
    }
    PG8_WAIT_V(0);
    if (wr == 0) PG8_BAR;
    PG8_BAR;
#undef PG8_SA
#undef PG8_SB
#undef PG8_STAGE
#undef PG8_LDA
#undef PG8_LDB
#undef PG8_MMA
#undef PG8_WAIT_V
#undef PG8_WAIT_L
#undef PG8_BAR
#undef PG8_SCHED
#undef PG8_SETOFF
}
}


namespace fa {
typedef short bf16x8 __attribute__((ext_vector_type(8)));
typedef short s16x4 __attribute__((ext_vector_type(4)));
typedef float f32x16 __attribute__((ext_vector_type(16)));
constexpr int D = 128, NW = 8, QBLK = 32, KVBLK = 64, QB = NW * QBLK, QS = DM;
constexpr int SHM_V = KVBLK * D * 2, SHM_K = KVBLK * D * 2;
constexpr int OFF_WS = 2 * SHM_V + 2 * SHM_K, OFF_BIAS = OFF_WS + NW * 64 * 4, LDS_BYTES = OFF_BIAS + 2 * 256 + 16;
constexpr float SCALE = ATT_SCALE, THR = 8.f;
#define KSWZ(row, colB) ((row) * 256 + ((colB) ^ (((row) & 7) << 4)))
#define SBAR() __builtin_amdgcn_sched_barrier(0)
__device__ __forceinline__ int v_st(int k, int c) { const int kk = (k & ~0xC) | ((k & 4) << 1) | ((k & 8) >> 1); return ((kk >> 3) * 4 + (c >> 5)) * 512 + ((kk & 7) * 32 + (c & 31)) * 2; }
__device__ __forceinline__ int v_rd_base(int lane) { return ((lane & 3) << 3) | (((lane >> 2) & 3) << 6) | (((lane >> 4) & 1) << 5) | (((lane >> 5) & 1) << 8); }
constexpr int v_rd_off(int d0, int ks, int half) { return d0 * 512 + ks * 4096 + half * 2048; }
__device__ __forceinline__ int crow(int r, int hi) { return (r & 3) + 8 * (r >> 2) + 4 * hi; }
__device__ __forceinline__ bf16x8 load8(const bf16_t* p) { return *reinterpret_cast<const bf16x8*>(p); }
__device__ __forceinline__ void mask_tile(f32x16& p0, f32x16& p1, int dq, unsigned W) {
    const float NEG = -__builtin_inff();
#pragma unroll
    for (int r = 0; r < 16; ++r) { const int c = (r & 3) + 8 * (r >> 2);
        if ((unsigned)(dq - c) >= W) p0[r] = NEG;
        if ((unsigned)(dq - c - 32) >= W) p1[r] = NEG; }
}
__device__ __forceinline__ void partialSM(f32x16& p0, f32x16& p1, float& m_reg, float& mn, float& alpha) {
    float pmax = p0[0];
#pragma unroll
    for (int r = 1; r < 16; ++r) pmax = fmaxf(pmax, p0[r]);
#pragma unroll
    for (int r = 0; r < 16; ++r) pmax = fmaxf(pmax, p1[r]);
    { auto rr = __builtin_amdgcn_permlane32_swap(__float_as_uint(pmax), __float_as_uint(pmax), false, false);
      pmax = fmaxf(__uint_as_float(rr[0]), __uint_as_float(rr[1])); }
    constexpr float C2 = 1.4426950408889634f * SCALE;
    if (__builtin_expect(__all((pmax - m_reg) * SCALE <= THR), 1)) { mn = m_reg; alpha = 1.f; }
    else { mn = fmaxf(m_reg, pmax); alpha = __builtin_amdgcn_exp2f((m_reg - mn) * C2); m_reg = mn; }
    const float mnL = -mn * C2;
#pragma unroll
    for (int r = 0; r < 16; ++r) p0[r] = fmaf(p0[r], C2, mnL);
#pragma unroll
    for (int r = 0; r < 16; ++r) p1[r] = fmaf(p1[r], C2, mnL);
#pragma unroll
    for (int r = 0; r < 16; ++r) p0[r] = __builtin_amdgcn_exp2f(p0[r]);
}
__device__ __forceinline__ void finishSM(f32x16& p0, f32x16& p1, float alpha, float& l_reg, bf16x8& pa0, bf16x8& pa1, bf16x8& pa2, bf16x8& pa3) {
#pragma unroll
    for (int r = 0; r < 16; ++r) p1[r] = __builtin_amdgcn_exp2f(p1[r]);
    float ps = 0;
#pragma unroll
    for (int r = 0; r < 16; ++r) ps += p0[r];
#pragma unroll
    for (int r = 0; r < 16; ++r) ps += p1[r];
    { auto rr = __builtin_amdgcn_permlane32_swap(__float_as_uint(ps), __float_as_uint(ps), false, false);
      ps = __uint_as_float(rr[0]) + __uint_as_float(rr[1]); }
    l_reg = l_reg * alpha + ps;
#define PK4(P, B_, OUT) do { unsigned a0 = cvt_pk_bf16(P[B_+0], P[B_+1]), a1 = cvt_pk_bf16(P[B_+2], P[B_+3]);                          \
        unsigned b0 = cvt_pk_bf16(P[B_+4], P[B_+5]), b1 = cvt_pk_bf16(P[B_+6], P[B_+7]);                                             \
        auto r0 = __builtin_amdgcn_permlane32_swap(a0, b0, false, false); auto r1 = __builtin_amdgcn_permlane32_swap(a1, b1, false, false); \
        u32x4 w = {r0[0], r1[0], r0[1], r1[1]}; OUT = *reinterpret_cast<bf16x8*>(&w); } while (0)
    PK4(p0, 0, pa0); PK4(p0, 8, pa1); PK4(p1, 0, pa2); PK4(p1, 8, pa3);
#undef PK4
}
template <int KB>
__device__ __forceinline__ void qkt(f32x16& p0, f32x16& p1, const char* K_lds, const char* B_lds, int r32, int hi, const bf16x8* qr) {
    { const f32x4* bb = reinterpret_cast<const f32x4*>(B_lds + KB * 256 + hi * 16);
      const f32x4 a0 = bb[0], a1 = bb[2], a2 = bb[4], a3 = bb[6], c0 = bb[8], c1 = bb[10], c2 = bb[12], c3 = bb[14];
      p0 = (f32x16){a0[0], a0[1], a0[2], a0[3], a1[0], a1[1], a1[2], a1[3], a2[0], a2[1], a2[2], a2[3], a3[0], a3[1], a3[2], a3[3]};
      p1 = (f32x16){c0[0], c0[1], c0[2], c0[3], c1[0], c1[1], c1[2], c1[3], c2[0], c2[1], c2[2], c2[3], c3[0], c3[1], c3[2], c3[3]}; }
    const char* kb[4];
#pragma unroll
    for (int dd = 0; dd < 4; ++dd) kb[dd] = K_lds + KB * SHM_K + KSWZ(r32, (dd * 16 + hi * 8) * 2);
#pragma unroll
    for (int d0 = 0; d0 < 8; ++d0) { const char* a = kb[d0 & 3] + (d0 >> 2) * 128;
        bf16x8 b0 = *reinterpret_cast<const bf16x8*>(a);
        bf16x8 b1 = *reinterpret_cast<const bf16x8*>(a + 32 * 256);
        p0 = __builtin_amdgcn_mfma_f32_32x32x16_bf16(b0, qr[d0], p0, 0, 0, 0);
        p1 = __builtin_amdgcn_mfma_f32_32x32x16_bf16(b1, qr[d0], p1, 0, 0, 0); }
}
template <int VB>
__device__ __forceinline__ void pv_tile(f32x16* o, int vb0, bf16x8 pa0, bf16x8 pa1, bf16x8 pa2, bf16x8 pa3) {
#define TRRD(dst, off) asm volatile("ds_read_b64_tr_b16 %0, %1 offset:%2" : "=&v"(dst) : "v"(vb0), "i"(off) : "memory")
#define PV_D0(d0) do { constexpr int b_ = VB * SHM_V + v_rd_off(d0, 0, 0); s16x4 l3, h3; \
        { s16x4 l0, l1, l2, h0, h1, h2; TRRD(l0, b_); TRRD(h0, b_ + 2048); TRRD(l1, b_ + 4096); TRRD(h1, b_ + 6144); TRRD(l2, b_ + 8192); TRRD(h2, b_ + 10240); \
          asm volatile("s_waitcnt lgkmcnt(0)" ::: "memory"); SBAR();   \
          TRRD(l3, b_ + 12288); TRRD(h3, b_ + 14336); SBAR();            \
          o[d0] = __builtin_amdgcn_mfma_f32_32x32x16_bf16(pa0, (bf16x8){l0[0], l0[1], l0[2], l0[3], h0[0], h0[1], h0[2], h0[3]}, o[d0], 0, 0, 0);   \
          o[d0] = __builtin_amdgcn_mfma_f32_32x32x16_bf16(pa1, (bf16x8){l1[0], l1[1], l1[2], l1[3], h1[0], h1[1], h1[2], h1[3]}, o[d0], 0, 0, 0);   \
          o[d0] = __builtin_amdgcn_mfma_f32_32x32x16_bf16(pa2, (bf16x8){l2[0], l2[1], l2[2], l2[3], h2[0], h2[1], h2[2], h2[3]}, o[d0], 0, 0, 0); }   \
        asm volatile("s_waitcnt lgkmcnt(0)" ::: "memory"); SBAR();   \
        o[d0] = __builtin_amdgcn_mfma_f32_32x32x16_bf16(pa3, (bf16x8){l3[0], l3[1], l3[2], l3[3], h3[0], h3[1], h3[2], h3[3]}, o[d0], 0, 0, 0); } while (0)
    PV_D0(0); PV_D0(1); PV_D0(2); PV_D0(3);
#undef PV_D0
#undef TRRD
}
struct BlockRef { const bf16_t* Q; const bf16_t* K; const bf16_t* V; const float* KBp; unsigned char* O  ; int P0, jlo; };
struct Seam { bf16x8 qr[8]; bf16x8 st_v0, st_v1, st_k0, st_k1; float sb; };
#define GLD16(base, boff) (*reinterpret_cast<const bf16x8*>((const char*)(base) + (boff)))
#define VMW() asm volatile("s_waitcnt vmcnt(0)" ::: "memory")
#define VMWN(n) asm volatile("s_waitcnt vmcnt(%0)" :: "i"(n) : "memory")
#define SLOAD_H(Kp, Vp, Bp, k0) do { const char* kq_ = (const char*)(Kp) + (size_t)(k0) * (D * 2); const char* vq_ = (const char*)(Vp) + (size_t)(k0) * (D * 2); \
                         S.st_v0 = GLD16(vq_, kvoff); S.st_v1 = GLD16(vq_ + 32 * D * 2, kvoff); S.st_k0 = GLD16(kq_, kvoff); S.st_k1 = GLD16(kq_ + 32 * D * 2, kvoff); \
                         S.sb = *reinterpret_cast<const float*>((const char*)(Bp) + (size_t)(k0) * 4 + lane4); } while (0)
#define SWRITE_HK(bf) do { *(bf16x8*)(K_lds + (bf) * SHM_K + kws) = S.st_k0; *(bf16x8*)(K_lds + (bf) * SHM_K + kws + 32 * 256) = S.st_k1; \
                           if (wid == 0) *(float*)(B_lds + (bf) * 256 + lane * 4) = S.sb; } while (0)
#define SWRITE_HV(bf) do { *(bf16x8*)(V_lds + (bf) * SHM_V + vst0) = S.st_v0; *(bf16x8*)(V_lds + (bf) * SHM_V + vst1) = S.st_v1; } while (0)
#define SWRITE_H(bf) do { SWRITE_HV(bf); SWRITE_HK(bf); } while (0)
__device__ __forceinline__ void prime(const BlockRef& cur, char* lds, Seam& S) {
    const int tid = tidx(), wid = __builtin_amdgcn_readfirstlane(tid >> 6), lane = tid & 63, r32 = lane & 31, hi = lane >> 5;
    const int sr = tid >> 4, sc = (tid & 15) * 8, kws = KSWZ(sr, sc * 2); char* K_lds = lds + 2 * SHM_V; char* B_lds = lds + OFF_BIAS;
    const unsigned kvoff = (unsigned)(sr * D + sc) * 2u, lane4 = (unsigned)lane * 4u, qoff = (unsigned)((wid * QBLK + r32) * QS + hi * 8) * 2u;
#pragma unroll
    for (int d0 = 0; d0 < 8; ++d0) S.qr[d0] = GLD16(cur.Q, qoff + d0 * 32);
    SLOAD_H(cur.K, cur.V, cur.KBp, cur.jlo * KVBLK); VMW(); SWRITE_HK(0);
    __syncthreads();
}
__device__ __forceinline__ void block(const BlockRef& cur, const BlockRef& nxt, char* lds, Seam& S) {
    const int tid = tidx(), wid = __builtin_amdgcn_readfirstlane(tid >> 6), lane = tid & 63, r32 = lane & 31, hi = lane >> 5;
    const int j_lo = cur.jlo, NT = (cur.P0 + QB - 1) / KVBLK + 1 - j_lo;
    const int tl = NT - 4 + (wid >> 1);
    const int qlo = cur.P0 + wid * QBLK, qm = qlo + r32 - 4 * hi;
    char* V_lds = lds; char* K_lds = lds + 2 * SHM_V; char* B_lds = lds + OFF_BIAS;
    float* ws = (float*)(lds + OFF_WS) + wid * 64; float* li_l = ws; float* al_l = ws + 32;
    float m_reg = -1e30f, l_reg = 0; f32x16 o[4] = {};
    const int sr = tid >> 4, sc = (tid & 15) * 8, vst0 = v_st(sr, sc), vst1 = v_st(32 + sr, sc), kws = KSWZ(sr, sc * 2);
    const unsigned kvoff = (unsigned)(sr * D + sc) * 2u, lane4 = (unsigned)lane * 4u, qoff = (unsigned)((wid * QBLK + r32) * QS + hi * 8) * 2u;
    const int vb0 = (int)(uintptr_t)V_lds + v_rd_base(lane);
    const bf16_t* Kh = cur.K; const bf16_t* Vh = cur.V; const float* Bh = cur.KBp;
#define RESC(a) do { if (__any((a) < 1.f)) { if (hi == 0) al_l[r32] = (a); asm volatile("s_waitcnt lgkmcnt(0)" ::: "memory");              \
                     for (int d_ = 0; d_ < 4; ++d_) for (int r = 0; r < 16; ++r) o[d_][r] *= al_l[crow(r, hi)]; } } while (0)
#define KBASE(t) ((j_lo + (t)) * KVBLK)
#define MASKT(P0_, P1_, t) do { const int kb_ = KBASE(t); if (kb_ + KVBLK - 1 > qlo) mask_tile(P0_, P1_, qm - kb_, 0x7fffffffu); } while (0)
    f32x16 pA0, pA1, pB0, pB1; float mnA, mnB, alA, alB; bf16x8 pa0, pa1, pa2, pa3;
    SWRITE_HV(0); SBAR();
    if (NT > 1) SLOAD_H(Kh, Vh, Bh, KBASE(1));
    SBAR(); qkt<0>(pA0, pA1, K_lds, B_lds, r32, hi, S.qr);
    MASKT(pA0, pA1, 0); partialSM(pA0, pA1, m_reg, mnA, alA);
    if (NT > 1) { VMW(); SWRITE_H(1); SBAR(); if (NT > 2) SLOAD_H(Kh, Vh, Bh, KBASE(2)); }
    __syncthreads();
#define HALF_STEP(PX0, PX1, mnX, alX, PY0, PY1, alY, t, KB, VB, SB) do {                                                      \
        const bool doX_ = (t) <= tl, doY_ = (t) - 1 <= tl;                       \
        SBAR(); if (doX_) qkt<KB>(PX0, PX1, K_lds, B_lds, r32, hi, S.qr);                                                     \
        if (doY_) finishSM(PY0, PY1, alY, l_reg, pa0, pa1, pa2, pa3); SBAR();                                                 \
        if (doY_) pv_tile<VB>(o, vb0, pa0, pa1, pa2, pa3);                                                                    \
        if (doX_) { MASKT(PX0, PX1, (t)); partialSM(PX0, PX1, m_reg, mnX, alX); } else alX = 1.f;                             \
        __syncthreads();                                                                                                      \
        if ((t) + 1 < NT) { VMW(); SWRITE_H(SB); SBAR(); if ((t) + 2 < NT) { SLOAD_H(Kh, Vh, Bh, KBASE((t) + 2)); SBAR(); } }   \
        RESC(alX); __syncthreads(); } while (0)
    for (int t = 1; t + 1 < NT; t += 2) {
        HALF_STEP(pB0, pB1, mnB, alB, pA0, pA1, alA, t, 1, 0, 0);
        HALF_STEP(pA0, pA1, mnA, alA, pB0, pB1, alB, t + 1, 0, 1, 1);
    }
    const bool even = (NT & 1) == 0;
    const bool doA = (even ? NT - 2 : NT - 1) <= tl, doB = even && (NT - 1 <= tl);
    if (doB) { SBAR(); qkt<1>(pB0, pB1, K_lds, B_lds, r32, hi, S.qr); SBAR(); }
    SLOAD_H(nxt.K, nxt.V, nxt.KBp, nxt.jlo * KVBLK); SBAR();
#pragma unroll
    for (int d0 = 0; d0 < 8; ++d0) S.qr[d0] = GLD16(nxt.Q, qoff + d0 * 32);
    SBAR();
    if (doA) { finishSM(pA0, pA1, alA, l_reg, pa0, pa1, pa2, pa3); SBAR();
        pv_tile<0>(o, vb0, pa0, pa1, pa2, pa3); }
    if (even) { if (doB) { MASKT(pB0, pB1, NT - 1); partialSM(pB0, pB1, m_reg, mnB, alB); } else alB = 1.f;
        __syncthreads(); RESC(alB);
        if (doB) { finishSM(pB0, pB1, alB, l_reg, pa0, pa1, pa2, pa3); SBAR(); pv_tile<1>(o, vb0, pa0, pa1, pa2, pa3); } }
    SBAR(); VMWN(8); SWRITE_HK(0); SBAR();
    if (hi == 0) li_l[r32] = l_reg; asm volatile("s_waitcnt lgkmcnt(0)" ::: "memory");
    float rli[16];
#pragma unroll
    for (int r = 0; r < 16; ++r) rli[r] = __builtin_amdgcn_rcpf(li_l[crow(r, hi)]);
    unsigned char* Ow = cur.O; const unsigned ooff = (unsigned)((wid * QBLK + 4 * hi) * QS + r32);
#pragma unroll
    for (int r = 0; r < 16; ++r) { const int orow = (r & 3) + 8 * (r >> 2);
#pragma unroll
        for (int d0 = 0; d0 < 4; ++d0) { const float v = o[d0][r] * rli[r]; const float v1 = dpp_xor1(v), v2 = dpp_xor2(v), v3 = DPPF(v, 0x1B, 0xF, false);
            if ((r32 & 3) == 0) *(unsigned*)(Ow + (size_t)(orow * QS + d0 * 32) + ooff) = pack4_fp8(v, v1, v2, v3); } }
    __syncthreads();
#undef RESC
#undef KBASE
#undef MASKT
#undef HALF_STEP
}
#undef GLD16
#undef VMW
#undef VMWN
#undef SLOAD_H
#undef SWRITE_HK
#undef SWRITE_HV
#undef SWRITE_H
__device__ __forceinline__ BlockRef ref(const Ctx& c, int bh, int qb, float thr, int lane) {
    unsigned char* ws = wsl(c); const int b = bh >> 3, h = bh & 7; BlockRef r;
    const size_t qo = ((size_t)(b * SEQ + qb * QB)) * QS + h * DH;
    r.Q = (const bf16_t*)(ws + WS_FQ) + qo; r.O = ws + WS_OB + qo;
    r.K = (const bf16_t*)(ws + WS_FK) + (size_t)bh * SEQ * DH; r.V = (const bf16_t*)(ws + WS_FV) + (size_t)bh * SEQ * DH;
    r.KBp = (const float*)(ws + WS_KBIAS) + (size_t)bh * SEQ; r.P0 = qb * QB;
    const int nbefore = r.P0 / KVBLK; const float kq = r.KBp[r.P0];
    const bool k0 = (lane >= nbefore) || ((kq - r.KBp[64 * lane + 63]) * (1.f / SQRT_DH) <= thr);
    const bool k1 = (64 + lane >= nbefore) || ((kq - r.KBp[64 * (64 + lane) + 63]) * (1.f / SQRT_DH) <= thr);
    const unsigned long long m0 = __ballot(k0), m1 = __ballot(k1);
    r.jlo = __builtin_amdgcn_readfirstlane(m0 ? (int)__builtin_ctzll(m0) : 64 + (int)__builtin_ctzll(m1));
    return r;
}
constexpr int CW_ATTQ = 2048;
__device__ __forceinline__ void phase(const Ctx& c, int layer, char* lds, int qid = -1) {
    constexpr int NQB = SEQ / QB, TOTAL = NQB * NB * NH;
    const int tid = tidx(), lane = tid & 63;
    unsigned* qhead = (unsigned*)(wsl(c) + WS_CTL) + CW_ATTQ + (qid < 0 ? layer : qid) * 64;
    volatile int* qslot = (volatile int*)(lds + OFF_BIAS + 512);
    float thr;
    { const float* gq = c.in[I_GQ] + layer * DH; const float* gk = c.in[I_GK] + layer * DH;
      float mq = fmaxf(fabsf(gq[lane]), fabsf(gq[lane + 64])), mk = fmaxf(fabsf(gk[lane]), fabsf(gk[lane + 64]));
#pragma unroll
      for (int o = 1; o < 64; o <<= 1) { mq = fmaxf(mq, bperm(mq, lane ^ o)); mk = fmaxf(mk, bperm(mk, lane ^ o)); }
      thr = 2.f * SQRT_DH * mq * mk + 17.f; thr = __builtin_bit_cast(float, __builtin_amdgcn_readfirstlane(__builtin_bit_cast(int, thr))); }
    if (tid == 0) { qslot[0] = (int)__hip_atomic_fetch_add(qhead, 1u, __ATOMIC_RELAXED, __HIP_MEMORY_SCOPE_AGENT); qslot[1] = (int)__hip_atomic_fetch_add(qhead, 1u, __ATOMIC_RELAXED, __HIP_MEMORY_SCOPE_AGENT); }
    __syncthreads();
    int ic = __builtin_amdgcn_readfirstlane(qslot[0]), in_ = __builtin_amdgcn_readfirstlane(qslot[1]), par = 0;
    if (ic >= TOTAL) return;
#define ITEM_REF(i) ref(c, (i) & 31, NQB - 1 - ((i) >> 5), thr, lane)
    BlockRef cur = ITEM_REF(ic);
    Seam S;
    prime(cur, lds, S);
    for (;;) {
        const bool last = in_ >= TOTAL;
        if (tid == 0 && !last) qslot[par] = (int)__hip_atomic_fetch_add(qhead, 1u, __ATOMIC_RELAXED, __HIP_MEMORY_SCOPE_AGENT);
        const BlockRef nxt = last ? cur : ITEM_REF(in_);
        block(cur, nxt, lds, S);
        if (last) break;
        cur = nxt; in_ = __builtin_amdgcn_readfirstlane(qslot[par]); par ^= 1;
    }
#undef ITEM_REF
}
#undef KSWZ
#undef SBAR
}


namespace hg {
typedef short bf16x8 __attribute__((ext_vector_type(8)));
typedef short s16x4 __attribute__((ext_vector_type(4)));
typedef float f32x16 __attribute__((ext_vector_type(16)));
constexpr int C = 64, NCH = SEQ / C, NUNIT = NB * NH * NCH;
constexpr size_t US_BYTES = (size_t)128 * 128 * 2;
constexpr size_t WS_US_LO = WS_USLO, WS_US_HI = 968 * MiB, WS_G = 1032 * MiB, WS_HG_END = 1034 * MiB;
__device__ __forceinline__ bf16_t* us_tile(unsigned char* ws, int unit) { return (bf16_t*)(ws + (unit < NUNIT / 2 ? WS_US_LO + (size_t)unit * US_BYTES : WS_US_HI + (size_t)(unit - NUNIT / 2) * US_BYTES)); }
#define KSWZ(row, colB) ((row) * 256 + ((colB) ^ (((row) & 7) << 4)))
__device__ __forceinline__ int v_st(int k, int c) { const int kk = (k & ~0xC) | ((k & 4) << 1) | ((k & 8) >> 1); return ((kk >> 3) * 4 + (c >> 5)) * 512 + ((kk & 7) * 32 + (c & 31)) * 2; }
__device__ __forceinline__ int v_rd_base(int lane) { return ((lane & 3) << 3) | (((lane >> 2) & 3) << 6) | (((lane >> 4) & 1) << 5) | (((lane >> 5) & 1) << 8); }
__device__ __forceinline__ int crow(int r, int hi) { return (r & 3) + 8 * (r >> 2) + 4 * hi; }
#define LBAR() do { asm volatile("s_waitcnt lgkmcnt(0)" ::: "memory"); __builtin_amdgcn_s_barrier(); asm volatile("" ::: "memory"); } while (0)
#define TRRD(dst, addr, off) asm volatile("ds_read_b64_tr_b16 %0, %1 offset:%2" : "=&v"(dst) : "v"(addr), "i"(off) : "memory")
#define FRAG4(F0, F1, F2, F3, vaddr, d0) do { s16x4 l0, l1, l2, l3, h0, h1, h2, h3; constexpr int b_ = (d0) * 512; \
        TRRD(l0, vaddr, b_); TRRD(h0, vaddr, b_ + 2048); TRRD(l1, vaddr, b_ + 4096); TRRD(h1, vaddr, b_ + 6144); TRRD(l2, vaddr, b_ + 8192); TRRD(h2, vaddr, b_ + 10240); TRRD(l3, vaddr, b_ + 12288); TRRD(h3, vaddr, b_ + 14336); \
        asm volatile("s_waitcnt lgkmcnt(0)" ::: "memory"); __builtin_amdgcn_sched_barrier(0); \
        F0 = (bf16x8){l0[0], l0[1], l0[2], l0[3], h0[0], h0[1], h0[2], h0[3]}; F1 = (bf16x8){l1[0], l1[1], l1[2], l1[3], h1[0], h1[1], h1[2], h1[3]}; \
        F2 = (bf16x8){l2[0], l2[1], l2[2], l2[3], h2[0], h2[1], h2[2], h2[3]}; F3 = (bf16x8){l3[0], l3[1], l3[2], l3[3], h3[0], h3[1], h3[2], h3[3]}; } while (0)
struct Strip { float cum[8][2]; float tot[2]; };
__device__ __forceinline__ void strip_load(const bf16_t* lf_chunk  , int kp, int rg, unsigned (&lr)[8]) {
#pragma unroll
    for (int i = 0; i < 8; ++i) lr[i] = *reinterpret_cast<const unsigned*>(lf_chunk + (size_t)(8 * rg + i) * DM + 2 * kp);
}
__device__ __forceinline__ void strip_unpack(const unsigned (&lr)[8], float (&l)[8][2]) {
#pragma unroll
    for (int i = 0; i < 8; ++i) unpack_f16x2(lr[i], l[i][0], l[i][1]);
}
__device__ __forceinline__ void strip_scan(int lane, const float (&l)[8][2], Strip& st) {
    float run0 = 0.f, run1 = 0.f;
#pragma unroll
    for (int i = 0; i < 8; ++i) { run0 += l[i][0]; run1 += l[i][1]; st.cum[i][0] = run0; st.cum[i][1] = run1; }
    float in0 = run0, in1 = run1;
#pragma unroll
    for (int o = 1; o < 8; o <<= 1) { const float a = dpp_shr(in0, o), b = dpp_shr(in1, o); if ((lane & 7) >= o) { in0 += a; in1 += b; } }
    const float ex0 = in0 - run0, ex1 = in1 - run1;
#pragma unroll
    for (int i = 0; i < 8; ++i) { st.cum[i][0] += ex0; st.cum[i][1] += ex1; }
    st.tot[0] = bperm(in0, (lane & ~7) | 7); st.tot[1] = bperm(in1, (lane & ~7) | 7);
}
constexpr int A_TK = 0, A_TV = 16384, A_LDS = 32768;
__device__ __forceinline__ void pass_a(const Ctx& c, char* lds) {
    const int tid = tidx(), wid = __builtin_amdgcn_readfirstlane(tid >> 6), lane = tid & 63, r32 = lane & 31, hi = lane >> 5;
    const int kp = tid >> 3, rg = tid & 7, sr = tid >> 4, sc = (tid & 15) * 8;
    unsigned char* ws = wsl(c); const bf16_t* LF = (const bf16_t*)(ws + WS_LF); const unsigned char* VA = ws + WS_VA; float* G = (float*)(ws + WS_G);
    const int vaddr_k = (int)(uintptr_t)(lds + A_TK) + v_rd_base(lane), vaddr_v = (int)(uintptr_t)(lds + A_TV) + v_rd_base(lane);
    unsigned lr[8]; u32x2 pv0, pv1;
#define V8_TO_BF16(r) (bf16x8)__builtin_bit_cast(bf16x8, (u32x4){cvt_pk_bf16(unpack4_fp8((r).x)[0], unpack4_fp8((r).x)[1]), cvt_pk_bf16(unpack4_fp8((r).x)[2], unpack4_fp8((r).x)[3]), cvt_pk_bf16(unpack4_fp8((r).y)[0], unpack4_fp8((r).y)[1]), cvt_pk_bf16(unpack4_fp8((r).y)[2], unpack4_fp8((r).y)[3])})
#define A_LOAD(u) do { const int bh_ = (u) >> 7, ch_ = (u) & (NCH - 1); const size_t r0_ = (size_t)((bh_ >> 3) * SEQ + ch_ * C); const int h_ = bh_ & 7; \
        strip_load(LF + r0_ * DM + h_ * DH, kp, rg, lr); const unsigned char* vp_ = VA + (r0_ + sr) * DM + h_ * DH + sc; pv0 = *(const u32x2*)vp_; pv1 = *(const u32x2*)(vp_ + (size_t)32 * DM); } while (0)
    int unit = bidx(); if (unit < NUNIT) A_LOAD(unit);
    for (; unit < NUNIT; unit += gridDim.x) {
        float l[8][2]; strip_unpack(lr, l); Strip st; strip_scan(lane, l, st);
#pragma unroll
        for (int i = 0; i < 8; ++i) { const float k0 = (1.f - __expf(l[i][0])) * __expf(st.tot[0] - st.cum[i][0]), k1 = (1.f - __expf(l[i][1])) * __expf(st.tot[1] - st.cum[i][1]);
            *(unsigned*)(lds + A_TK + v_st(8 * rg + i, 2 * kp)) = cvt_pk_bf16(k0, k1); }
        if (rg == 7) *reinterpret_cast<float2*>(G + (size_t)unit * DH + 2 * kp) = make_float2(__expf(st.tot[0]), __expf(st.tot[1]));
        *(bf16x8*)(lds + A_TV + v_st(sr, sc)) = V8_TO_BF16(pv0); *(bf16x8*)(lds + A_TV + v_st(32 + sr, sc)) = V8_TO_BF16(pv1);
        if (unit + (int)gridDim.x < NUNIT) A_LOAD(unit + (int)gridDim.x);
        LBAR();
        const int kb = wid >> 1; bf16x8 a0, a1, a2, a3;
        if (kb == 0) FRAG4(a0, a1, a2, a3, vaddr_k, 0); else if (kb == 1) FRAG4(a0, a1, a2, a3, vaddr_k, 1); else if (kb == 2) FRAG4(a0, a1, a2, a3, vaddr_k, 2); else FRAG4(a0, a1, a2, a3, vaddr_k, 3);
        bf16_t* U = us_tile(ws, unit);
#pragma unroll
        for (int j = 0; j < 2; ++j) { bf16x8 b0, b1, b2, b3; const int vb = 2 * (wid & 1) + j;
            if (wid & 1) { if (j == 0) FRAG4(b0, b1, b2, b3, vaddr_v, 2); else FRAG4(b0, b1, b2, b3, vaddr_v, 3); } else { if (j == 0) FRAG4(b0, b1, b2, b3, vaddr_v, 0); else FRAG4(b0, b1, b2, b3, vaddr_v, 1); }
            f32x16 acc = {};
            acc = __builtin_amdgcn_mfma_f32_32x32x16_bf16(a0, b0, acc, 0, 0, 0); acc = __builtin_amdgcn_mfma_f32_32x32x16_bf16(a1, b1, acc, 0, 0, 0);
            acc = __builtin_amdgcn_mfma_f32_32x32x16_bf16(a2, b2, acc, 0, 0, 0); acc = __builtin_amdgcn_mfma_f32_32x32x16_bf16(a3, b3, acc, 0, 0, 0);
#pragma unroll
            for (int r = 0; r < 16; ++r) { const float v = acc[r], vn = dpp_xor1(v);
                if ((r32 & 1) == 0) *(unsigned*)(U + (size_t)(32 * kb + crow(r, hi)) * DH + 32 * vb + r32) = cvt_pk_bf16(v, vn); } }
        LBAR();
    }
}
__device__ __forceinline__ void pass_b(const Ctx& c) {
    unsigned char* ws = wsl(c); const float* G = (const float*)(ws + WS_G);
    const int tid = tidx();
    for (int job = bidx(); job < NB * NH * 4; job += gridDim.x) { const int bh = job >> 2, q = job & 3;
        const int e = (q * NTHR + tid) * 8, k = e >> 7, v = e & 127;
        float s[8];
#pragma unroll
        for (int i = 0; i < 8; ++i) s[i] = 0.f;
#define PB_LOAD(U, Gv, c0_) do { _Pragma("unroll") for (int j = 0; j < 8; ++j) { const int unit = bh * NCH + (c0_) + j; U[j] = *(const u32x4*)(us_tile(ws, unit) + k * DH + v); Gv[j] = G[(size_t)unit * DH + k]; } \
        __builtin_amdgcn_sched_barrier(0); } while (0)
#define PB_SCAN(U, Gv, c0_) do { _Pragma("unroll") for (int j = 0; j < 8; ++j) { const int unit = bh * NCH + (c0_) + j;                                              \
            u32x4 o; o.x = cvt_pk_bf16(s[0], s[1]); o.y = cvt_pk_bf16(s[2], s[3]); o.z = cvt_pk_bf16(s[4], s[5]); o.w = cvt_pk_bf16(s[6], s[7]);                 \
            *(u32x4*)(us_tile(ws, unit) + k * DH + v) = o;                                                                                                         \
            s[0] = Gv[j] * s[0] + __uint_as_float(U[j].x << 16); s[1] = Gv[j] * s[1] + __uint_as_float(U[j].x & 0xffff0000u); s[2] = Gv[j] * s[2] + __uint_as_float(U[j].y << 16); s[3] = Gv[j] * s[3] + __uint_as_float(U[j].y & 0xffff0000u); \
            s[4] = Gv[j] * s[4] + __uint_as_float(U[j].z << 16); s[5] = Gv[j] * s[5] + __uint_as_float(U[j].z & 0xffff0000u); s[6] = Gv[j] * s[6] + __uint_as_float(U[j].w << 16); s[7] = Gv[j] * s[7] + __uint_as_float(U[j].w & 0xffff0000u); } \
        __builtin_amdgcn_sched_barrier(0); } while (0)
        static_assert(NCH % 16 == 0, "pass_b: two batches per step");
        u32x4 ua[8], ub[8]; float ga[8], gb[8];
        PB_LOAD(ua, ga, 0);
#pragma unroll 1
        for (int c0 = 0; c0 < NCH; c0 += 16) {
            PB_LOAD(ub, gb, c0 + 8);
            PB_SCAN(ua, ga, c0);
            if (c0 + 16 < NCH) PB_LOAD(ua, ga, c0 + 16);
            PB_SCAN(ub, gb, c0 + 8);
        }
#undef PB_LOAD
#undef PB_SCAN
    }
}
constexpr int C_TQ = 0, C_TKD = 16384, C_TV = 32768, C_TS = 49152, C_ER = 81920, C_PS = 82432, C_LDS = 83456;
__device__ __forceinline__ void pass_c(const Ctx& c, int layer, char* lds, bool dummy = false) {
    const int tid = tidx(), wid = __builtin_amdgcn_readfirstlane(tid >> 6), lane = tid & 63, r32 = lane & 31, hi = lane >> 5;
    const int kp = tid >> 3, rg = tid & 7, sr = tid >> 4, sc = (tid & 15) * 8, rh = wid >> 2, vq = wid & 3;
    unsigned char* ws = wsl(c); const bf16_t* LF = (const bf16_t*)(ws + WS_LF); const unsigned char* VA = ws + WS_VA; const unsigned char* QA = ws + WS_QA; const unsigned char* GA = ws + WS_GA; unsigned char* OA = ws + WS_OA;
    const int vaddr_v = (int)(uintptr_t)(lds + C_TV) + v_rd_base(lane), vaddr_s0 = (int)(uintptr_t)(lds + C_TS) + v_rd_base(lane), vaddr_s1 = vaddr_s0 + 16384;
    float* ER = (float*)(lds + C_ER); float* PS = (float*)(lds + C_PS);
    const float gain = c.in[I_HGN][layer * DH + 32 * vq + r32];
    unsigned lr[8]; unsigned short qraw[8]; u32x2 pv0, pv1; u32x4 sraw[4]; unsigned char garaw[16];
#define C_LOAD(u) do { const int bh_ = (u) >> 7, ch_ = (u) & (NCH - 1); const size_t r0_ = (size_t)((bh_ >> 3) * SEQ + ch_ * C); const int h_ = bh_ & 7; \
        strip_load(LF + r0_ * DM + h_ * DH, kp, rg, lr); \
        _Pragma("unroll") for (int i_ = 0; i_ < 8; ++i_) qraw[i_] = *(const unsigned short*)(QA + (r0_ + 8 * rg + i_) * DM + h_ * DH + 2 * kp); \
        const unsigned char* vp_ = VA + (r0_ + sr) * DM + h_ * DH + sc; pv0 = *(const u32x2*)vp_; pv1 = *(const u32x2*)(vp_ + (size_t)32 * DM); \
        const bf16_t* Sg_ = us_tile(ws, (u)); _Pragma("unroll") for (int j_ = 0; j_ < 4; ++j_) sraw[j_] = *(const u32x4*)(Sg_ + (size_t)(sr + 32 * j_) * DH + sc); } while (0)
    int unit = bidx(); if (unit < NUNIT) C_LOAD(unit);
    for (; unit < NUNIT; unit += gridDim.x) {
        const int bh = unit >> 7, ch = unit & (NCH - 1), b = bh >> 3, h = bh & 7; const size_t row0 = (size_t)(b * SEQ + ch * C);
        float l[8][2]; strip_unpack(lr, l); Strip st; strip_scan(lane, l, st);
        const float ref0 = bperm(st.cum[7][0], (lane & ~7) | 3), ref1 = bperm(st.cum[7][1], (lane & ~7) | 3);
#pragma unroll
        for (int i = 0; i < 8; ++i) { const int row = 8 * rg + i;
            const f32v2u_t qf = __builtin_amdgcn_cvt_pk_f32_fp8((int)qraw[i], false); const float q0 = qf[0], q1 = qf[1];
            const float d0 = st.cum[i][0] - ref0, d1 = st.cum[i][1] - ref1;
            *(unsigned*)(lds + C_TQ + KSWZ(row, 4 * kp)) = cvt_pk_bf16(q0 * __expf(d0), q1 * __expf(d1));
            *(unsigned*)(lds + C_TKD + KSWZ(row, 4 * kp)) = cvt_pk_bf16((1.f - __expf(l[i][0])) * __expf(-d0), (1.f - __expf(l[i][1])) * __expf(-d1)); }
        if (rg == 0) { ER[2 * kp] = __expf(ref0); ER[2 * kp + 1] = __expf(ref1); }
        *(bf16x8*)(lds + C_TV + v_st(sr, sc)) = V8_TO_BF16(pv0); *(bf16x8*)(lds + C_TV + v_st(32 + sr, sc)) = V8_TO_BF16(pv1);
        LBAR();
#pragma unroll
        for (int j = 0; j < 4; ++j) { const int k = sr + 32 * j; const float e = ER[k]; const u32x4 x = sraw[j]; u32x4 o;
            o.x = cvt_pk_bf16(__uint_as_float(x.x << 16) * e, __uint_as_float(x.x & 0xffff0000u) * e); o.y = cvt_pk_bf16(__uint_as_float(x.y << 16) * e, __uint_as_float(x.y & 0xffff0000u) * e);
            o.z = cvt_pk_bf16(__uint_as_float(x.z << 16) * e, __uint_as_float(x.z & 0xffff0000u) * e); o.w = cvt_pk_bf16(__uint_as_float(x.w << 16) * e, __uint_as_float(x.w & 0xffff0000u) * e);
            *(u32x4*)(lds + C_TS + (k >> 6) * 16384 + v_st(k & 63, sc)) = o; }
        if (unit + (int)gridDim.x < NUNIT) C_LOAD(unit + (int)gridDim.x);
        LBAR();
        bf16x8 qr[8];
#pragma unroll
        for (int d0 = 0; d0 < 8; ++d0) qr[d0] = *(const bf16x8*)(lds + C_TQ + KSWZ(32 * rh + r32, (d0 * 16 + hi * 8) * 2));
        f32x16 p0 = {}, p1 = {};
#pragma unroll
        for (int d0 = 0; d0 < 8; ++d0) { const bf16x8 k0 = *(const bf16x8*)(lds + C_TKD + KSWZ(r32, (d0 * 16 + hi * 8) * 2)), k1 = *(const bf16x8*)(lds + C_TKD + KSWZ(32 + r32, (d0 * 16 + hi * 8) * 2));
            p0 = __builtin_amdgcn_mfma_f32_32x32x16_bf16(k0, qr[d0], p0, 0, 0, 0); p1 = __builtin_amdgcn_mfma_f32_32x32x16_bf16(k1, qr[d0], p1, 0, 0, 0); }
        { const int t = 32 * rh + r32;
#pragma unroll
          for (int r = 0; r < 16; ++r) { const int key = crow(r, hi); if (key > t) p0[r] = 0.f; if (key + 32 > t) p1[r] = 0.f; } }
        bf16x8 pa0, pa1, pa2, pa3;
#define PK4(P, B_, OUT) do { unsigned a0 = cvt_pk_bf16(P[B_+0], P[B_+1]), a1 = cvt_pk_bf16(P[B_+2], P[B_+3]);                          \
        unsigned b0 = cvt_pk_bf16(P[B_+4], P[B_+5]), b1 = cvt_pk_bf16(P[B_+6], P[B_+7]);                                             \
        auto r0 = __builtin_amdgcn_permlane32_swap(a0, b0, false, false); auto r1 = __builtin_amdgcn_permlane32_swap(a1, b1, false, false); \
        u32x4 w = {r0[0], r1[0], r0[1], r1[1]}; OUT = *reinterpret_cast<bf16x8*>(&w); } while (0)
        PK4(p0, 0, pa0); PK4(p0, 8, pa1); PK4(p1, 0, pa2); PK4(p1, 8, pa3);
#undef PK4
        f32x16 o = {};
#define ACC_TILE(vaddr, A0, A1, A2, A3) do { bf16x8 b0, b1, b2, b3; \
        if (vq == 0) FRAG4(b0, b1, b2, b3, vaddr, 0); else if (vq == 1) FRAG4(b0, b1, b2, b3, vaddr, 1); else if (vq == 2) FRAG4(b0, b1, b2, b3, vaddr, 2); else FRAG4(b0, b1, b2, b3, vaddr, 3); \
        o = __builtin_amdgcn_mfma_f32_32x32x16_bf16(A0, b0, o, 0, 0, 0); o = __builtin_amdgcn_mfma_f32_32x32x16_bf16(A1, b1, o, 0, 0, 0); \
        o = __builtin_amdgcn_mfma_f32_32x32x16_bf16(A2, b2, o, 0, 0, 0); o = __builtin_amdgcn_mfma_f32_32x32x16_bf16(A3, b3, o, 0, 0, 0); } while (0)
        ACC_TILE(vaddr_v, pa0, pa1, pa2, pa3);
        ACC_TILE(vaddr_s0, qr[0], qr[1], qr[2], qr[3]);
        ACC_TILE(vaddr_s1, qr[4], qr[5], qr[6], qr[7]);
#undef ACC_TILE
#pragma unroll
        for (int r = 0; r < 16; ++r) garaw[r] = GA[(row0 + 32 * rh + crow(r, hi)) * DM + h * DH + 32 * vq + r32];
#pragma unroll
        for (int r = 0; r < 16; ++r) { float ss = o[r] * o[r];
            ss = row_sum16(ss); ss += DPPF(ss, 0x142, 0xA, false);
            if (r32 == 31) PS[(32 * rh + crow(r, hi)) * 4 + vq] = ss; }
        LBAR();
#pragma unroll
        for (int r = 0; r < 16; ++r) { const int t = 32 * rh + crow(r, hi); const f32x4 ps = *(const f32x4*)(PS + t * 4);
            const float rstd = rsqrtf(((ps[0] + ps[1]) + (ps[2] + ps[3])) * (1.f / DH) + NORM_EPS);
            const size_t gi = (row0 + t) * DM + h * DH + 32 * vq + r32;
            const float val = o[r] * rstd * gain * __builtin_amdgcn_cvt_f32_fp8((int)garaw[r], 0); const float v1 = dpp_xor1(val), v2 = dpp_xor2(val), v3 = DPPF(val, 0x1B, 0xF, false);
            if ((r32 & 3) == 0) *(unsigned*)((dummy ? ws + WS_G + 2 * MiB : OA) + (dummy ? (gi & 0xffffff) : gi)) = pack4_fp8(val, v1, v2, v3); }
        LBAR();
    }
}
#undef C_LOAD
#undef A_LOAD
#undef V8_TO_BF16
#undef LBAR
#undef KSWZ
#undef TRRD
#undef FRAG4
}

static_assert(LDS_STAGE_BYTES == pg8::STAGE_BYTES, "stage region");
__device__ __forceinline__ void moe_tables(const Ctx& c, int layer, LAS int* tab) {
    const unsigned* gc = (const unsigned*)(wsl(c) + WS_CTL) + CW_CNT + layer * 64;
    if (threadIdx.x < NE) tab[80 + threadIdx.x] = (int)__hip_atomic_load(gc + threadIdx.x, __ATOMIC_RELAXED, __HIP_MEMORY_SCOPE_AGENT);
    __syncthreads();
    if (threadIdx.x == 0) { int s = 0, t = 0;
        for (int e = 0; e < NE; ++e) { const int n = tab[80 + e]; tab[e] = t; tab[40 + e] = s; s += (n + 255) & ~255; t += (n + 255) >> 8; }
        tab[NE] = t; tab[40 + NE] = s; }
    __syncthreads();
}
__device__ __forceinline__ void moe_tail_convert(const Ctx& c, int next_layer, LAS unsigned char* lds, int it_lo, int it_hi) {
    const LAS int* tab = (const LAS int*)(lds + LDS_MISC + 1024);
    const int rem = (tab[NE] * 4) & 255, cid = bidx();
    if (cid < rem) return;
    const int wave = __builtin_amdgcn_readfirstlane(tidx() >> 6);
    ph_convert(c, next_layer, lds, it_lo, it_hi, (cid - rem) * NWAVE + wave, (256 - rem) * NWAVE, false);
}
constexpr int CW_CVQ = 4096;
__device__ __forceinline__ void attn_tail_convert(const Ctx& c, int layer, LAS unsigned char* lds, int it_lo) {
    unsigned* chead = (unsigned*)(wsl(c) + WS_CTL) + CW_CVQ + layer * 64;
    volatile LAS int* slot = (volatile LAS int*)(lds + LDS_MISC + 2048);
    const int tid = tidx(), wave = __builtin_amdgcn_readfirstlane(tid >> 6), lane = tid & 63;
    LAS float* scr = (LAS float*)(lds + wave * 16640);
    static_assert((CV_ALL - CV_A_END) % (2 * NWAVE) == 0 && (CV_ALL - CV_B_END) % (2 * NWAVE) == 0, "whole batches");
    for (;;) {
        __syncthreads();
        if (tid == 0) slot[0] = (int)__hip_atomic_fetch_add(chead, (unsigned)(2 * NWAVE), __ATOMIC_RELAXED, __HIP_MEMORY_SCOPE_AGENT);
        __syncthreads();
        const int base = __builtin_amdgcn_readfirstlane(slot[0]);
        if (base >= CV_ALL - it_lo) break;
        const CvItem da = cv_item(c, layer, it_lo + base + wave), db = cv_item(c, layer, it_lo + base + NWAVE + wave);
        f32x4 va[16], vb[16];
        cv_load(va, da, lane); cv_load(vb, db, lane);
        __builtin_amdgcn_sched_barrier(0);
        cv_store(va, da, scr, lane); cv_store(vb, db, scr, lane);
    }
}
template <int GP> __device__ __forceinline__ void ph_gemm(const Ctx& c, int layer, LAS unsigned char* lds) {
    unsigned char* ws = wsl(c); const int G = gridDim.x, cid = bidx();
    if (GP == 0) { pg8::StaticOrder S; S.init(ws + WS_XB8, ws + WS_WIN, T, INP, DM, G, cid, 1); pg8::EpiInProj E{make_ipo(c), 1.f / WIN_SCALE, c.in[I_GQ] + layer * DH, c.in[I_GK] + layer * DH, (LAS float*)(lds + LDS_STAGE_BYTES), (int)(tidx() & 63)}; pg8::gemm_phase<DM, pg8::EpiInProj, pg8::StaticOrder, true>(lds, S, E); }
    if (GP == 1) { pg8::MergeOrder S; S.base.init(ws + WS_OA, ws + WS_WA, T, DM, DM, G, cid, 1); S.A2 = (const char*)(ws + WS_OB); S.B2 = (const char*)(ws + WS_WB);
        pg8::EpiMergeChain E{(const unsigned char*)(ws + WS_SGA), (const unsigned char*)(ws + WS_SGB), ws + WS_VA, MG_SCALE / WIN_SCALE}; pg8::gemm_phase<DM, pg8::EpiMergeChain, pg8::MergeOrder, true>(lds, S, E); }
    if (GP == 3) { pg8::StaticOrder S; S.init(ws + WS_VA, ws + WS_WO, T, DM, DM, G, cid, 1); pg8::EpiOut E{(const bf16_t*)(ws + WS_XBF), (bf16_t*)(ws + WS_YX), 1.f / (WIN_SCALE * MG_SCALE)}; pg8::gemm_phase<DM, pg8::EpiOut, pg8::StaticOrder, true>(lds, S, E); }
    if (GP == 4 || GP == 5) { LAS int* tab = (LAS int*)(lds + LDS_MISC + 1024); moe_tables(c, layer, tab);
        if (GP == 4) { pg8::MoeOrder<true> S{(const char*)(ws + WS_X18), (const char*)(ws + WS_WGU), (const int*)(ws + WS_STE), tab, tab + 40, tab + 80, G, cid}; pg8::EpiMoeUp E{(unsigned char*)(ws + WS_HB), 1.f / WIN_SCALE}; pg8::gemm_phase<DM, pg8::EpiMoeUp, pg8::MoeOrder<true>, true>(lds, S, E); }
        else { pg8::MoeOrder<false> S{(const char*)(ws + WS_HB), (const char*)(ws + WS_WD), (const int*)(ws + WS_STE), tab, tab + 40, tab + 80, G, cid}; pg8::EpiMoeDn E{(bf16_t*)(ws + WS_YB), 1.f / WIN_SCALE}; pg8::gemm_phase<DE, pg8::EpiMoeDn, pg8::MoeOrder<false>, true>(lds, S, E); } }
}


#define XB_TMO      128
#define XB_XCNT(j)  (256  + 64 * (j))
#define XB_XSUB(j)  (1280 + 64 * (j))
#define XB_XGEN(j)  (2304 + 64 * (j))
#define XB_TOP      3328
#define XB_TOPGEN   3392
#define XCD_BAR_WORDS 3456
#define XB_SPIN_CAP (1u << 18)
__device__ __forceinline__ unsigned xb_ld(unsigned* p)              { return __hip_atomic_load(p, __ATOMIC_RELAXED, __HIP_MEMORY_SCOPE_AGENT); }
__device__ __forceinline__ unsigned xb_add(unsigned* p, unsigned v) { return __hip_atomic_fetch_add(p, v, __ATOMIC_RELAXED, __HIP_MEMORY_SCOPE_AGENT); }
__device__ __forceinline__ unsigned xb_xcc_id() { return (unsigned)__builtin_amdgcn_s_getreg((3 << 11) | 20) & 0xFu; }
#define XB_SPIN(cond, bar) do { unsigned _sp = 0; while (cond) { __builtin_amdgcn_s_sleep(1); \
    if ((++_sp & 255u) == 0u) { if (xb_ld(&(bar)[XB_TMO])) break; if (_sp > XB_SPIN_CAP) { atomicAdd(&(bar)[XB_TMO], 1u); break; } } } } while (0)
struct XcdBarrier { unsigned* bar; unsigned x; volatile LAS unsigned* st; };
__device__ __forceinline__ XcdBarrier xcd_barrier_post(unsigned* bar, volatile LAS unsigned* st) {
    XcdBarrier b; b.bar = bar; b.x = xb_xcc_id(); b.st = st;
    if (threadIdx.x == 0) (void)xb_add(&bar[XB_XCNT(b.x)], 1u);
    return b;
}
__device__ __forceinline__ void xcd_barrier_complete(unsigned* bar, unsigned x, unsigned& nloc, unsigned& nx) {
    const unsigned G = gridDim.x * gridDim.y * gridDim.z;
    unsigned sum, cnt, mine, sp = 0u;
    for (;;) {
        sum = 0u; cnt = 0u; mine = 0u;
#pragma unroll
        for (unsigned j = 0; j < 16; ++j) { const unsigned c = xb_ld(&bar[XB_XCNT(j)]); sum += c; cnt += (c > 0u) ? 1u : 0u; mine = (j == x) ? c : mine; }
        if (sum == G) break;
        __builtin_amdgcn_s_sleep(1);
        if ((++sp & 255u) == 0u) { if (xb_ld(&bar[XB_TMO])) break; if (sp > XB_SPIN_CAP) { atomicAdd(&bar[XB_TMO], 1u); break; } }
    }
    nloc = mine > 0u ? mine : 1u; nx = cnt > 0u ? cnt : 1u;
}
__device__ __forceinline__ void xcd_barrier(const XcdBarrier& b) {
    asm volatile("s_waitcnt vmcnt(0)" ::: "memory");
    __syncthreads();
    if (threadIdx.x == 0) {
        unsigned* bar = b.bar; asm volatile("" : "+s"(bar));
        bar = (unsigned*)(__attribute__((address_space(1))) unsigned*)(uintptr_t)bar;
        const unsigned bx = (unsigned)__builtin_amdgcn_readfirstlane((int)xb_xcc_id());
        __builtin_amdgcn_s_waitcnt(0);
        unsigned nloc = b.st[0], nx = b.st[1];
        if (nloc == 0u) { xcd_barrier_complete(bar, bx, nloc, nx); b.st[0] = nloc; b.st[1] = nx; }
        const unsigned old = xb_add(&bar[XB_XSUB(bx)], 1u);
        const unsigned gen = old / nloc;
        if (old + 1u == (gen + 1u) * nloc) {
            __builtin_amdgcn_fence(__ATOMIC_RELEASE, "agent");
            asm volatile("s_waitcnt vmcnt(0)" ::: "memory");
            const unsigned og = xb_add(&bar[XB_TOP], 1u);
            const unsigned tg = og / nx;
            if (og + 1u == (tg + 1u) * nx) xb_add(&bar[XB_TOPGEN], 1u);
            else XB_SPIN(xb_ld(&bar[XB_TOPGEN]) == tg, bar);
            __builtin_amdgcn_fence(__ATOMIC_ACQUIRE, "agent");
            xb_add(&bar[XB_XGEN(bx)], 1u);
            asm volatile("s_waitcnt vmcnt(0)" ::: "memory");
        } else {
            XB_SPIN(xb_ld(&bar[XB_XGEN(bx)]) == gen, bar);
            __builtin_amdgcn_fence(__ATOMIC_ACQUIRE, "agent");
            asm volatile("s_waitcnt vmcnt(0)" ::: "memory");
        }
    }
    __syncthreads();
}

constexpr int CW_BAR = 8192;
static_assert((CW_BAR + XCD_BAR_WORDS) * 4 <= (int)CTL_BYTES, "ctl");
__global__ void __launch_bounds__(NTHR, 2) k_mega(KArgs a) {
    LAS unsigned char* lds = (LAS unsigned char*)g_lds; char* ldsg = (char*)g_lds;
    if (threadIdx.x < 4) ((LAS unsigned*)(lds + LDS_MISC))[threadIdx.x] = 0u;
    __syncthreads();
    const Ctx c{};
    const XcdBarrier bar = xcd_barrier_post((unsigned*)(wsl(c) + WS_CTL) + CW_BAR, (volatile LAS unsigned*)(lds + LDS_MISC));
#ifndef PROBE_PH
#define PROBE_PH (-1)
#endif
#ifndef DUP_C
#define DUP_C 0
#endif
#ifndef DUP_PH
#define DUP_PH (-1)
#endif
    unsigned long long tacc = 0ull, t0 = 0ull;
#define PB_S(p) do { if (PROBE_PH == (p)) t0 = __builtin_amdgcn_s_memrealtime(); } while (0)
#define PB_E(p) do { if (PROBE_PH == (p)) tacc += __builtin_amdgcn_s_memrealtime() - t0; } while (0)
#define GBAR() xcd_barrier(bar)
    PB_S(0); ph_xprep(c, lds); ph_convert(c, 0, lds, 0, CV_A_END); GBAR(); PB_E(0);
#define LAYER(l) do { \
        PB_S(1); if (DUP_PH == 1) { ph_gemm<0>(c, l, lds); GBAR(); } ph_gemm<0>(c, l, lds);          GBAR(); PB_E(1); \
        PB_S(2); if (DUP_PH == 2) { hg::pass_a(c, ldsg); GBAR(); } ph_foxprep(c, l, lds); __syncthreads(); hg::pass_a(c, ldsg);     GBAR(); PB_E(2); \
        PB_S(5); hg::pass_b(c); __syncthreads(); fa::phase(c, l, ldsg); attn_tail_convert(c, l, lds, CV_A_END);                GBAR(); if (DUP_PH == 5) { fa::phase(c, l, ldsg, l + 4); GBAR(); } PB_E(5);     \
        PB_S(4); if (DUP_C) { hg::pass_c(c, l, ldsg, true); GBAR(); } hg::pass_c(c, l, ldsg);         GBAR(); PB_E(4); \
        PB_S(6); if (DUP_PH == 6) { ph_gemm<1>(c, l, lds); GBAR(); } ph_gemm<1>(c, l, lds);                     GBAR(); PB_E(6); \
        PB_S(7); if (DUP_PH == 7) { ph_gemm<3>(c, l, lds); GBAR(); } ph_gemm<3>(c, l, lds);          GBAR(); PB_E(7); \
        PB_S(8); ph_ln1_router(c, l, lds);       GBAR(); PB_E(8); \
        PB_S(9); if (DUP_PH == 9) { ph_gemm<4>(c, l, lds); GBAR(); } ph_gemm<4>(c, l, lds); if (l + 1 < DEPTH) moe_tail_convert(c, l + 1, lds, 0, CV_A_END);         GBAR(); PB_E(9); \
        PB_S(10); if (DUP_PH == 10) { ph_gemm<5>(c, l, lds); GBAR(); } ph_gemm<5>(c, l, lds); \
        if (PROBE_PH >= 0 && l == DEPTH - 1) { PB_E(10); if (bidx() == 0 && threadIdx.x == 0) { const float tq = exp2f(rintf(4.f * log2f((float)tacc * 1e-7f)) * 0.25f); *(float*)(wsl(c) + WS_CTL + 256) = 1.f + sqrtf(tq); } } \
        GBAR(); if (l < DEPTH - 1) PB_E(10); \
        float oscale = 1.f; if (PROBE_PH >= 0 && l == DEPTH - 1) oscale = __hip_atomic_load((float*)(wsl(c) + WS_CTL + 256), __ATOMIC_RELAXED, __HIP_MEMORY_SCOPE_AGENT); \
        PB_S(11); if (DUP_PH == 11) { ph_ln2(c, l, lds, oscale); __syncthreads(); } if (DUP_PH == 12 && l + 1 < DEPTH) { ph_convert(c, l + 1, lds); __syncthreads(); } ph_ln2(c, l, lds, oscale); \
        if (l + 1 < DEPTH) { __syncthreads(); ph_convert(c, l + 1, lds, CV_ALL, CV_ALL); GBAR(); PB_E(11); } } while (0)
    LAYER(0); LAYER(1); LAYER(2); LAYER(3);
}
#ifdef PHASE_REGS
#define PK(name, body) __global__ void __launch_bounds__(NTHR, 2) name(KArgs a, int l) { LAS unsigned char* lds = (LAS unsigned char*)g_lds; char* ldsg = (char*)g_lds; const Ctx c{}; body; }
PK(t_xprep, ph_xprep(c, lds)) PK(t_convert, ph_convert(c, l, lds)) PK(t_inproj, ph_gemm<0>(c, l, lds)) PK(t_foxprep, ph_foxprep(c, l, lds)) PK(t_hga, hg::pass_a(c, ldsg)) PK(t_hgb, hg::pass_b(c))
PK(t_hgc, hg::pass_c(c, l, ldsg)) PK(t_attn, fa::phase(c, l, ldsg)) PK(t_merge1, ph_gemm<1>(c, l, lds)) PK(t_out, ph_gemm<3>(c, l, lds)) PK(t_ln1, ph_ln1_router(c, l, lds))
PK(t_moeup, ph_gemm<4>(c, l, lds)) PK(t_moedn, ph_gemm<5>(c, l, lds)) PK(t_ln2, ph_ln2(c, l, lds))
#endif
extern "C" void kernel_launch(void* const* d_in, const int* in_sizes, int n_in, void* d_out, int out_size, void* d_ws, size_t ws_size, hipStream_t stream) {
    static int ok = 0;
    if (ok == 0) {
        if (n_in != 21 || in_sizes[0] != T * DM || out_size != T * DM || ws_size < hg::WS_HG_END) { fprintf(stderr, "kernel_launch: unexpected shapes (n_in %d in0 %d out %d ws %zu, need ws >= %zu)\n", n_in, n_in > 0 ? in_sizes[0] : -1, out_size, ws_size, (size_t)hg::WS_HG_END); ok = -1; return; }
        if (hipFuncSetAttribute((const void*)k_mega, hipFuncAttributeMaxDynamicSharedMemorySize, LDS_TOTAL) != hipSuccess) { fprintf(stderr, "kernel_launch: hipFuncSetAttribute failed\n"); ok = -1; return; }
        int dev = 0, cus = 0, per_cu = 0;
        if (hipGetDevice(&dev) != hipSuccess || hipDeviceGetAttribute(&cus, hipDeviceAttributeMultiprocessorCount, dev) != hipSuccess || cus < 256) { fprintf(stderr, "kernel_launch: needs a device with >= 256 CUs (found %d); nothing launched\n", cus); ok = -1; return; }
        if (hipOccupancyMaxActiveBlocksPerMultiprocessor(&per_cu, (const void*)k_mega, NTHR, LDS_TOTAL) != hipSuccess || per_cu < 1) { fprintf(stderr, "kernel_launch: the occupancy query reports %d workgroups per CU (need 1); nothing launched\n", per_cu); (void)hipGetLastError(); ok = -1; return; }
        ok = 1;
    }
    if (ok < 0) return;
    (void)hipMemsetAsync((char*)d_ws + WS_CTL, 0, CTL_BYTES, stream);
    KArgs a{};
    for (int i = 0; i < 21; ++i) a.in[i] = (const float*)d_in[i];
    a.out = (float*)d_out; a.ws = (unsigned char*)d_ws;
    hipLaunchKernelGGL(k_mega, dim3(256), dim3(NTHR), LDS_TOTAL, stream, a);
}
```

```cpp
#include <hip/hip_runtime.h>
#include <stdint.h>
#include <stdio.h>

typedef unsigned short bf16_t;
typedef float f32x4 __attribute__((ext_vector_type(4)));
typedef unsigned u32x4 __attribute__((ext_vector_type(4)));
typedef unsigned u32x2 __attribute__((ext_vector_type(2)));
#define LAS __attribute__((address_space(3)))

constexpr int DM = 1024, NB = 4, SEQ = 8192, T = NB * SEQ, DEPTH = 4;
constexpr int NH = 8, DH = 128;
constexpr int IN_COLS = 9224, INP = 9216, FF_COL = 7168;
constexpr int NG = 4, EPG = 8, NE = 32, DE = 512;
constexpr float ALPHA = 1.6817928305074292f;
constexpr float LN_EPS = 1e-5f, NORM_EPS = 1e-6f;
constexpr float SQRT_DH = 11.313708498984761f;
constexpr float ATT_SCALE = 0.08838834764831845f;
constexpr int NSLOT = 2 * T + NE * 256;

constexpr size_t MiB = 1u << 20;
constexpr size_t WS_CTL = 0, CTL_BYTES = 1 * MiB;
constexpr size_t WS_LB = 1 * MiB;
constexpr size_t WS_RWT = 1 * MiB + 65536;
constexpr size_t WS_FFL = 2 * MiB;
constexpr size_t WS_KBIAS = 3 * MiB;
constexpr size_t WS_TOPE = 4 * MiB;
constexpr size_t WS_TOPW = 4 * MiB + 262144;
constexpr size_t WS_TPOS = 4 * MiB + 524288;
constexpr size_t WS_STE = 5 * MiB;
constexpr size_t WS_WIN = 16 * MiB;
constexpr float WIN_SCALE = 32.f;
constexpr size_t WS_WA = 34 * MiB, WS_WB = 36 * MiB, WS_WO = 38 * MiB;
constexpr float MG_SCALE = 8.f;
constexpr size_t WS_WGU = 40 * MiB;
constexpr size_t WS_WD = 104 * MiB;
constexpr size_t WS_USLO = 136 * MiB;
constexpr size_t WS_X18 = 232 * MiB;
constexpr size_t WS_XB8 = 200 * MiB;
constexpr size_t WS_XBF = 264 * MiB;
constexpr size_t WS_QA = 328 * MiB;
constexpr size_t WS_OA = 456 * MiB;
constexpr size_t WS_OB = 488 * MiB;
constexpr size_t WS_LF = 392 * MiB;
constexpr size_t WS_YX = 392 * MiB;
constexpr size_t WS_VA = 520 * MiB;
constexpr size_t WS_GA = 584 * MiB;
constexpr size_t WS_FQ = 648 * MiB;
constexpr size_t WS_FK = 712 * MiB;
constexpr size_t WS_FV = 776 * MiB;
constexpr size_t WS_SGA = 840 * MiB, WS_SGB = 904 * MiB;
constexpr size_t WS_HB = 520 * MiB;
constexpr size_t WS_YB = 592 * MiB;
constexpr size_t WS_END = 968 * MiB;
static_assert(WS_HB + (size_t)NSLOT * 512 * 2 <= WS_YB && WS_YB + (size_t)NSLOT * 1024 * 2 <= 840 * MiB, "moe overlay");
constexpr int CW_CNT = 1024;

struct KArgs { const float* in[21]; float* out; unsigned char* ws; };
extern __shared__ __attribute__((aligned(16))) unsigned char g_lds[];
constexpr int LDS_STAGE_BYTES = 131072, LDS_TOTAL = 163840, LDS_MISC = LDS_TOTAL - 4096;
typedef __attribute__((address_space(4))) const unsigned long long cu64_t;
__device__ __forceinline__ void* ctx_ptr(int i) {
    const uintptr_t k = (uintptr_t)__builtin_amdgcn_kernarg_segment_ptr();
    unsigned lo = (unsigned)k, hi = (unsigned)(k >> 32); asm volatile("" : "+s"(lo), "+s"(hi));
    cu64_t* t = (cu64_t*)(((uintptr_t)hi << 32) | lo);
    return (void*)(__attribute__((address_space(1))) void*)(uintptr_t)t[i];
}
struct Ctx {
    struct In { __device__ __forceinline__ const float* operator[](int i) const { return (const float*)ctx_ptr(i); } } in;
    __device__ __forceinline__ float* outp() const { return (float*)ctx_ptr(21); }
};
__device__ __forceinline__ unsigned char* wsl(const Ctx&) { return (unsigned char*)ctx_ptr(22); }
enum { I_X = 0, I_WIN, I_BFF, I_GQ, I_GK, I_LBL, I_HGN, I_WA, I_WB, I_WO, I_L1G, I_L1B, I_RGW, I_RGB, I_REW, I_REB, I_WG, I_WU, I_WD, I_L2G, I_L2B };

typedef __bf16 bf16v2_t __attribute__((ext_vector_type(2)));
typedef float f32v2_t __attribute__((ext_vector_type(2)));
typedef _Float16 f16v4_t __attribute__((ext_vector_type(4)));
typedef _Float16 f16v8_t __attribute__((ext_vector_type(8)));
__device__ __forceinline__ unsigned cvt_pk_bf16(float lo, float hi) { f32v2_t v = {lo, hi}; bf16v2_t b = __builtin_convertvector(v, bf16v2_t); return __builtin_bit_cast(unsigned, b); }
__device__ __forceinline__ int bidx() { int b = blockIdx.x; asm volatile("" : "+s"(b)); return b; }
__device__ __forceinline__ int tidx() { int t = threadIdx.x; asm volatile("" : "+v"(t)); return t; }
__device__ __forceinline__ float bf2f(bf16_t b) { return __uint_as_float(((unsigned)b) << 16); }
__device__ __forceinline__ unsigned f2bf(float f) { unsigned u = __float_as_uint(f); return (u + 0x7fffu + ((u >> 16) & 1u)) >> 16; }
__device__ __forceinline__ unsigned pk2(float lo, float hi) { return f2bf(lo) | (f2bf(hi) << 16); }
__device__ __forceinline__ float sigm(float x) { return 1.f / (1.f + __expf(-x)); }
__device__ __forceinline__ float silu(float x) { return x / (1.f + __expf(-x)); }
typedef _Float16 f16v2_t __attribute__((ext_vector_type(2)));
__device__ __forceinline__ unsigned cvt_pk_f16(float lo, float hi) { f32v2_t v = {lo, hi}; f16v2_t h = __builtin_convertvector(v, f16v2_t); return __builtin_bit_cast(unsigned, h); }
__device__ __forceinline__ void unpack_f16x2(unsigned u, float& lo, float& hi) { const f16v2_t h = __builtin_bit_cast(f16v2_t, u); lo = (float)h[0]; hi = (float)h[1]; }
__device__ __forceinline__ f32x4 unpack_f16x4(unsigned a, unsigned b) { const f16v2_t h0 = __builtin_bit_cast(f16v2_t, a), h1 = __builtin_bit_cast(f16v2_t, b); return (f32x4){(float)h0[0], (float)h0[1], (float)h1[0], (float)h1[1]}; }
__device__ __forceinline__ unsigned pack4_fp8(float a, float b, float c, float d) { int v = __builtin_amdgcn_cvt_pk_fp8_f32(a, b, 0, false); v = __builtin_amdgcn_cvt_pk_fp8_f32(c, d, v, true); return (unsigned)v; }
typedef float f32v2u_t __attribute__((ext_vector_type(2)));
__device__ __forceinline__ f32x4 unpack4_fp8(unsigned u) { const f32v2u_t a = __builtin_amdgcn_cvt_pk_f32_fp8((int)u, false), b = __builtin_amdgcn_cvt_pk_f32_fp8((int)u, true); return (f32x4){a[0], a[1], b[0], b[1]}; }
#define DPPF(v, ctrl, rmask, bc) __builtin_bit_cast(float, __builtin_amdgcn_update_dpp(0, __builtin_bit_cast(int, (float)(v)), ctrl, rmask, 0xF, bc))
__device__ __forceinline__ float dpp_xor1(float v) { return DPPF(v, 0xB1, 0xF, false); }
__device__ __forceinline__ float dpp_xor2(float v) { return DPPF(v, 0x4E, 0xF, false); }
__device__ __forceinline__ float row_sum16(float v) { v += DPPF(v, 0xB1, 0xF, false); v += DPPF(v, 0x4E, 0xF, false); v += DPPF(v, 0x141, 0xF, false); v += DPPF(v, 0x140, 0xF, false); return v; }
__device__ __forceinline__ float dpp_sum64(float v) { v = row_sum16(v); v += DPPF(v, 0x142, 0xA, false); v += DPPF(v, 0x143, 0xC, false); return v; }
__device__ __forceinline__ float wave_sum(float v) { return __builtin_bit_cast(float, __builtin_amdgcn_readlane(__builtin_bit_cast(int, dpp_sum64(v)), 63)); }
__device__ __forceinline__ float dpp_shr(float v, int n) {
    return n == 1 ? DPPF(v, 0x111, 0xF, true) : (n == 2 ? DPPF(v, 0x112, 0xF, true) : (n == 4 ? DPPF(v, 0x114, 0xF, true) : DPPF(v, 0x118, 0xF, true)));
}
__device__ __forceinline__ float bperm(float v, int src_lane) { return __builtin_bit_cast(float, __builtin_amdgcn_ds_bpermute(src_lane << 2, __builtin_bit_cast(int, v))); }
struct InProjOut { unsigned char *QA, *VA, *GA, *SGA, *SGB  ; bf16_t *FQ, *FK, *FV; bf16_t* LF  ; const float* lb; };
__device__ __forceinline__ InProjOut make_ipo(const Ctx& c) {
    InProjOut o; unsigned char* ws = wsl(c);
    o.QA = ws + WS_QA; o.VA = ws + WS_VA; o.GA = ws + WS_GA; o.FQ = (bf16_t*)(ws + WS_FQ); o.FK = (bf16_t*)(ws + WS_FK); o.FV = (bf16_t*)(ws + WS_FV);
    o.SGA = ws + WS_SGA; o.SGB = ws + WS_SGB; o.LF = (bf16_t*)(ws + WS_LF); o.lb = (const float*)(ws + WS_LB); return o;
}
__device__ __forceinline__ size_t headmajor(int m, int c) { const int b = m >> 13, s = m & (SEQ - 1), h = c >> 7, d = c & 127; return ((size_t)((b * NH + h) * SEQ + s)) * DH + d; }
constexpr int NTHR = 512, NWAVE = 8;
struct Wv { int tid, lane, wave, gw, ngw; };
__device__ __forceinline__ Wv make_wv() { Wv w; w.tid = tidx(); w.lane = w.tid & 63; w.wave = __builtin_amdgcn_readfirstlane(w.tid >> 6); w.gw = bidx() * NWAVE + w.wave; w.ngw = gridDim.x * NWAVE; return w; }

template <bool F8>
__device__ __forceinline__ void transpose_item(const float* src, int ld, int k0, int c0, void* dst_row0, int K, LAS float* scr, int lane) {
    f32x4 v[16];
#pragma unroll
    for (int i = 0; i < 16; ++i) v[i] = *(const f32x4*)(src + (size_t)(k0 + 4 * i + (lane >> 4)) * ld + c0 + (lane & 15) * 4);
#pragma unroll
    for (int i = 0; i < 16; ++i) { LAS float* p = scr + (4 * i + (lane >> 4)) * 65 + (lane & 15) * 4; p[0] = v[i][0]; p[1] = v[i][1]; p[2] = v[i][2]; p[3] = v[i][3]; }
    asm volatile("s_waitcnt lgkmcnt(0)" ::: "memory");
    const int kc = (lane & 7) * 8;
#pragma unroll
    for (int i = 0; i < 8; ++i) { const int n = 8 * i + (lane >> 3); const LAS float* q = scr + kc * 65 + n;
        if (F8) { u32x2 o; o.x = pack4_fp8(q[0 * 65] * WIN_SCALE, q[1 * 65] * WIN_SCALE, q[2 * 65] * WIN_SCALE, q[3 * 65] * WIN_SCALE); o.y = pack4_fp8(q[4 * 65] * WIN_SCALE, q[5 * 65] * WIN_SCALE, q[6 * 65] * WIN_SCALE, q[7 * 65] * WIN_SCALE);
            *(u32x2*)((unsigned char*)dst_row0 + (size_t)n * K + k0 + kc) = o; }
        else { u32x4 o; o.x = cvt_pk_bf16(q[0 * 65], q[1 * 65]); o.y = cvt_pk_bf16(q[2 * 65], q[3 * 65]); o.z = cvt_pk_bf16(q[4 * 65], q[5 * 65]); o.w = cvt_pk_bf16(q[6 * 65], q[7 * 65]);
            *(u32x4*)((bf16_t*)dst_row0 + (size_t)n * K + k0 + kc) = o; } }
    asm volatile("s_waitcnt lgkmcnt(0)" ::: "memory");
}
constexpr int CV_IN = 16 * 144, CV_SQ = 16 * 16, CV_GU = 16 * 8, CV_DN = 8 * 16;
constexpr int CV_A_END = CV_IN + 3 * CV_SQ, CV_B_END = CV_A_END + (NE / 2) * 2 * CV_GU, CV_ALL = CV_IN + 3 * CV_SQ + NE * 2 * CV_GU + NE * CV_DN;
struct CvItem { const float* src; int ld, k0, c0; unsigned char* dst; int K; };
__device__ __forceinline__ CvItem cv_item(const Ctx& c, int layer, int it) {
    unsigned char* ws = wsl(c); CvItem d; int r = it;
    if (r < CV_IN) { const int kb = r / 144, nb = r % 144, n0 = nb * 64;
        d.src = c.in[I_WIN] + (size_t)layer * DM * IN_COLS; d.ld = IN_COLS; d.k0 = kb * 64; d.c0 = n0 + (n0 >= FF_COL ? 8 : 0); d.dst = (unsigned char*)(ws + WS_WIN) + (size_t)n0 * DM; d.K = DM; return d; }
    r -= CV_IN;
    if (r < 3 * CV_SQ) { const int which = r / CV_SQ, q = r % CV_SQ, kb = q / 16, nb = q % 16;
        d.src = c.in[which == 0 ? I_WA : (which == 1 ? I_WB : I_WO)] + (size_t)layer * DM * DM; d.ld = DM; d.k0 = kb * 64; d.c0 = nb * 64;
        d.dst = ws + (which == 0 ? WS_WA : (which == 1 ? WS_WB : WS_WO)) + (size_t)(nb * 64) * DM; d.K = DM; return d; }
    r -= 3 * CV_SQ;
    if (r < NE * 2 * CV_GU) { const int e = r / (2 * CV_GU), q = r % (2 * CV_GU), up = q / CV_GU, q2 = q % CV_GU, kb = q2 / 8, nb = q2 % 8, j0 = nb * 64;
        d.src = c.in[up ? I_WU : I_WG] + ((size_t)layer * NE + e) * DM * DE; d.ld = DE; d.k0 = kb * 64; d.c0 = j0;
        d.dst = (unsigned char*)(ws + WS_WGU) + ((size_t)e * 1024 + (j0 >> 7) * 256 + (j0 & 127) + up * 128) * DM; d.K = DM; return d; }
    r -= NE * 2 * CV_GU;
    { const int e = r / CV_DN, q = r % CV_DN, kb = q / 16, nb = q % 16;
        d.src = c.in[I_WD] + ((size_t)layer * NE + e) * DE * DM; d.ld = DM; d.k0 = kb * 64; d.c0 = nb * 64; d.dst = (unsigned char*)(ws + WS_WD) + ((size_t)e * 1024 + nb * 64) * DE; d.K = DE; return d; }
}
__device__ __forceinline__ void cv_load(f32x4 (&v)[16], const CvItem& d, int lane) {
#pragma unroll
    for (int i = 0; i < 16; ++i) v[i] = *(const f32x4*)(d.src + (size_t)(d.k0 + 4 * i + (lane >> 4)) * d.ld + d.c0 + (lane & 15) * 4);
}
__device__ __forceinline__ void cv_store(const f32x4 (&v)[16], const CvItem& d, LAS float* scr, int lane) {
#pragma unroll
    for (int i = 0; i < 16; ++i) { LAS float* p = scr + (4 * i + (lane >> 4)) * 65 + (lane & 15) * 4; p[0] = v[i][0]; p[1] = v[i][1]; p[2] = v[i][2]; p[3] = v[i][3]; }
    asm volatile("s_waitcnt lgkmcnt(0)" ::: "memory");
    const int kc = (lane & 7) * 8;
#pragma unroll
    for (int i = 0; i < 8; ++i) { const int n = 8 * i + (lane >> 3); const LAS float* q = scr + kc * 65 + n; u32x2 o;
        o.x = pack4_fp8(q[0 * 65] * WIN_SCALE, q[1 * 65] * WIN_SCALE, q[2 * 65] * WIN_SCALE, q[3 * 65] * WIN_SCALE); o.y = pack4_fp8(q[4 * 65] * WIN_SCALE, q[5 * 65] * WIN_SCALE, q[6 * 65] * WIN_SCALE, q[7 * 65] * WIN_SCALE);
        *(u32x2*)(d.dst + (size_t)n * d.K + d.k0 + kc) = o; }
    asm volatile("s_waitcnt lgkmcnt(0)" ::: "memory");
}
__device__ __forceinline__ void ph_convert(const Ctx& c, int layer, LAS unsigned char* lds, int it_lo = 0, int it_hi = CV_ALL, int gw = -1, int ngw = 1, bool tail = true) {
    const Wv w = make_wv(); LAS float* scr = (LAS float*)(lds + w.wave * 16640);
    unsigned char* ws = wsl(c);
    constexpr int I_IN = CV_IN, I_SQ = CV_SQ, I_GU = CV_GU, I_DN = CV_DN;
    if (gw < 0) { gw = w.gw; ngw = w.ngw; }
    for (int it = it_lo + gw; it < it_hi; it += ngw) {
        int r = it;
        if (r < I_IN) { const int kb = r / 144, nb = r % 144, n0 = nb * 64; const int c0 = n0 + (n0 >= FF_COL ? 8 : 0);
            transpose_item<true>(c.in[I_WIN] + (size_t)layer * DM * IN_COLS, IN_COLS, kb * 64, c0, (unsigned char*)(ws + WS_WIN) + (size_t)n0 * DM, DM, scr, w.lane); continue; }
        r -= I_IN;
        if (r < 3 * I_SQ) { const int which = r / I_SQ, q = r % I_SQ, kb = q / 16, nb = q % 16;
            const float* src = c.in[which == 0 ? I_WA : (which == 1 ? I_WB : I_WO)] + (size_t)layer * DM * DM;
            unsigned char* dst = ws + (which == 0 ? WS_WA : (which == 1 ? WS_WB : WS_WO));
            transpose_item<true>(src, DM, kb * 64, nb * 64, dst + (size_t)(nb * 64) * DM, DM, scr, w.lane); continue; }
        r -= 3 * I_SQ;
        if (r < NE * 2 * I_GU) { const int e = r / (2 * I_GU), q = r % (2 * I_GU), up = q / I_GU, q2 = q % I_GU, kb = q2 / 8, nb = q2 % 8, j0 = nb * 64;
            const float* src = c.in[up ? I_WU : I_WG] + ((size_t)layer * NE + e) * DM * DE;
            const int drow = (j0 >> 7) * 256 + (j0 & 127) + up * 128;
            transpose_item<true>(src, DE, kb * 64, j0, (unsigned char*)(ws + WS_WGU) + ((size_t)e * 1024 + drow) * DM, DM, scr, w.lane); continue; }
        r -= NE * 2 * I_GU;
        { const int e = r / I_DN, q = r % I_DN, kb = q / 16, nb = q % 16;
            const float* src = c.in[I_WD] + ((size_t)layer * NE + e) * DE * DM;
            transpose_item<true>(src, DM, kb * 64, nb * 64, (unsigned char*)(ws + WS_WD) + ((size_t)e * 1024 + nb * 64) * DE, DE, scr, w.lane); }
    }
    if (!tail) return;
    const int gt = bidx() * NTHR + w.tid, ngt = gridDim.x * NTHR;
    float* rwt = (float*)(ws + WS_RWT);
    for (int i = gt; i < 36 * DM; i += ngt) { const int j = i / DM, k = i % DM;
        rwt[i] = j < 4 ? c.in[I_RGW][((size_t)layer * DM + k) * NG + j] : c.in[I_REW][((size_t)layer * DM + k) * NE + (j - 4)]; }
    float* lb = (float*)(ws + WS_LB);
    for (int i = gt; i < DM; i += ngt) { float l[DEPTH], mx = -1e30f;
#pragma unroll
        for (int q = 0; q < DEPTH; ++q) { l[q] = c.in[I_LBL][q * DM + i]; mx = fmaxf(mx, l[q]); }
        float s = 0.f, p[DEPTH];
#pragma unroll
        for (int q = 0; q < DEPTH; ++q) { p[q] = expf(l[q] - mx); s += p[q]; }
        float acc = 0.f;
#pragma unroll
        for (int q = 1; q < DEPTH; ++q) if (q <= layer) acc += p[q] / s;
        lb[i] = acc; }
}

__device__ __forceinline__ void stage_ffw(const Ctx& c, int nl, LAS float* ffw, int tid) {
    const float* wbase = c.in[I_WIN] + (size_t)nl * DM * IN_COLS + FF_COL;
#pragma unroll
    for (int q = 0; q < 2; ++q) { const int k = tid + q * NTHR; const float* wr = wbase + (size_t)k * IN_COLS; const f32x4 w0 = *(const f32x4*)wr, w1 = *(const f32x4*)(wr + 4);
        ffw[0 * DM + k] = w0[0]; ffw[1 * DM + k] = w0[1]; ffw[2 * DM + k] = w0[2]; ffw[3 * DM + k] = w0[3]; ffw[4 * DM + k] = w1[0]; ffw[5 * DM + k] = w1[1]; ffw[6 * DM + k] = w1[2]; ffw[7 * DM + k] = w1[3]; }
    __syncthreads();
}
__device__ __forceinline__ void emit_xb_ffl(const Ctx& c, int nl, int row, const f32x4 (&v)[4], int lane, const LAS float* ffw) {
    unsigned char* wsb = wsl(c); bf16_t* xb = (bf16_t*)(wsb + WS_XBF) + (size_t)row * DM;
#pragma unroll
    for (int j = 0; j < 4; ++j) { u32x2 o; o.x = cvt_pk_f16(v[j][0], v[j][1]); o.y = cvt_pk_f16(v[j][2], v[j][3]); *(u32x2*)(xb + 256 * j + 4 * lane) = o;
        *(unsigned*)(wsb + WS_XB8 + (size_t)row * DM + 256 * j + 4 * lane) = pack4_fp8(v[j][0], v[j][1], v[j][2], v[j][3]); }
    float zz = 0.f;
#pragma unroll
    for (int h = 0; h < 8; ++h) { float z = 0.f;
#pragma unroll
        for (int j = 0; j < 4; ++j) { const f32x4 wv = *(const LAS f32x4*)(ffw + h * DM + 256 * j + 4 * lane); z += (v[j][0] * wv[0] + v[j][1] * wv[1]) + (v[j][2] * wv[2] + v[j][3] * wv[3]); }
        const float s = wave_sum(z); zz = (lane == h) ? s : zz; }
    if (lane < 8) { zz += c.in[I_BFF][nl * NH + lane]; ((float*)(wsb + WS_FFL))[(size_t)row * 8 + lane] = fminf(zz, 0.f) - log1pf(expf(-fabsf(zz))); }
}
__device__ __forceinline__ void ph_xprep(const Ctx& c, LAS unsigned char* lds) {
    const Wv w = make_wv(); LAS float* ffw = (LAS float*)(lds + 1024);
    stage_ffw(c, 0, ffw, w.tid);
    static_assert(T == 16 * NWAVE * 256, "ph_xprep: 16 rows per wave at the 256-workgroup grid");
    const float* X = c.in[I_X];
#define XP_LOAD(V, i) do { const f32x4* xr_ = (const f32x4*)(X + (size_t)(w.gw + (i) * w.ngw) * DM) + w.lane; _Pragma("unroll") for (int j = 0; j < 4; ++j) V[j] = xr_[64 * j]; __builtin_amdgcn_sched_barrier(0); } while (0)
    f32x4 va[4], vb[4];
    XP_LOAD(va, 0);
#pragma unroll 1
    for (int i = 0; i < 16; i += 2) {
        XP_LOAD(vb, i + 1);
        emit_xb_ffl(c, 0, w.gw + i * w.ngw, va, w.lane, ffw); __builtin_amdgcn_sched_barrier(0);
        if (i + 2 < 16) XP_LOAD(va, i + 2);
        emit_xb_ffl(c, 0, w.gw + (i + 1) * w.ngw, vb, w.lane, ffw); __builtin_amdgcn_sched_barrier(0);
    }
#undef XP_LOAD
    __syncthreads();
}

__device__ __forceinline__ void ph_foxprep(const Ctx& c, int layer, LAS unsigned char* lds) {
    const Wv w = make_wv(); unsigned char* ws = wsl(c);
    LAS float* wtot = (LAS float*)lds;
    const float* ffl = (const float*)(ws + WS_FFL); float* kb = (float*)(ws + WS_KBIAS);
    for (int seq = bidx(); seq < NB * NH; seq += gridDim.x) { const int b = seq >> 3, h = seq & 7;
        float loc[16], run = 0.f;
#pragma unroll
        for (int i = 0; i < 16; ++i) { run += ffl[((size_t)(b * SEQ + w.tid * 16 + i)) * 8 + h]; loc[i] = run; }
        float incl = run;
#pragma unroll
        for (int o = 1; o < 16; o <<= 1) incl += dpp_shr(incl, o);
        incl += DPPF(incl, 0x142, 0xA, false); incl += DPPF(incl, 0x143, 0xC, false);
        __syncthreads();
        if (w.lane == 63) wtot[w.wave] = incl;
        __syncthreads();
        float pre = incl - run;
        for (int q = 0; q < w.wave; ++q) pre += wtot[q];
#pragma unroll
        for (int i = 0; i < 16; ++i) kb[(size_t)seq * SEQ + w.tid * 16 + i] = -(pre + loc[i]) * SQRT_DH;
    }
}

constexpr int RW_PITCH = DM + 8;
constexpr int L1_W = 0, L1_WL = 36 * RW_PITCH * 2, L1_C = 2 * L1_WL, L1_CP = L1_C + 384, L1_ST = L1_CP + 4608, L1_CNT = L1_ST + 1024;
static_assert(L1_CNT + 256 <= LDS_MISC, "ln1 LDS map");
__device__ __forceinline__ void ph_ln1_router(const Ctx& c, int layer, LAS unsigned char* lds) {
    const Wv w = make_wv(); unsigned char* ws = wsl(c);
    LAS _Float16* Wh = (LAS _Float16*)(lds + L1_W); LAS _Float16* Wl = (LAS _Float16*)(lds + L1_WL); LAS float* c1 = (LAS float*)(lds + L1_C); LAS float* c2 = c1 + 48; LAS float* cp = (LAS float*)(lds + L1_CP);
    LAS float* st = (LAS float*)(lds + L1_ST); LAS unsigned* lcnt = (LAS unsigned*)(lds + L1_CNT); LAS unsigned* lbase = lcnt + 32;
    const float* g1 = c.in[I_L1G] + layer * DM; const float* b1 = c.in[I_L1B] + layer * DM; const float* rwt = (const float*)(ws + WS_RWT);
    const float* rgb = c.in[I_RGB] + layer * NG; const float* reb = c.in[I_REB] + layer * NE;
    for (int p = w.tid; p < 36 * 16; p += NTHR) { const int n = p >> 4, ch = p & 15; float s1 = 0.f, s2 = 0.f;
#pragma unroll 4
        for (int i = 0; i < 16; ++i) { const int k = ch * 64 + 4 * i; const f32x4 wv = *(const f32x4*)(rwt + n * DM + k), g = *(const f32x4*)(g1 + k), bb = *(const f32x4*)(b1 + k);
            const f32x4 wg = wv * g, wb = wv * bb; s1 += (wg[0] + wg[1]) + (wg[2] + wg[3]); s2 += (wb[0] + wb[1]) + (wb[2] + wb[3]);
            const f16v4_t hi = __builtin_convertvector(wg, f16v4_t); const f32x4 res = (wg - __builtin_convertvector(hi, f32x4)) * 2048.f; const f16v4_t lo = __builtin_convertvector(res, f16v4_t);
            *(LAS f16v4_t*)(Wh + n * RW_PITCH + k) = hi; *(LAS f16v4_t*)(Wl + n * RW_PITCH + k) = lo; }
        cp[(n * 16 + ch) * 2] = s1; cp[(n * 16 + ch) * 2 + 1] = s2; }
    if (w.tid < 64) lcnt[w.tid] = 0u;
    __syncthreads();
    if (w.tid < 36) { float s1 = 0.f, s2 = 0.f;
        for (int ch = 0; ch < 16; ++ch) { s1 += cp[(w.tid * 16 + ch) * 2]; s2 += cp[(w.tid * 16 + ch) * 2 + 1]; }
        c1[w.tid] = s1; c2[w.tid] = s2 + (w.tid < 4 ? rgb[w.tid] : reb[w.tid - 4]); }
    __syncthreads();
    const int x = w.lane & 15, kq = w.lane >> 4, row0 = w.gw * 16;
    bf16_t* Y = (bf16_t*)(ws + WS_YX);
    const bf16_t* yrow = Y + (size_t)(row0 + x) * DM + 8 * kq;
    const int wo0 = x * RW_PITCH + 8 * kq, wo1 = (16 + x) * RW_PITCH + 8 * kq, wo2 = (32 + x < 36 ? 32 + x : 35) * RW_PITCH + 8 * kq;
    f32x4 acc0 = {0.f, 0.f, 0.f, 0.f}, acc1 = acc0, acc2 = acc0, lo0 = acc0, lo1 = acc0, lo2 = acc0; float s1 = 0.f, s2 = 0.f;
    u32x4 ybuf[4];
#pragma unroll
    for (int u = 0; u < 4; ++u) ybuf[u] = *(const u32x4*)(yrow + 32 * u);
    for (int s0 = 0; s0 < 32; s0 += 4) {
#pragma unroll
        for (int u = 0; u < 4; ++u) { const int s = s0 + u; const u32x4 yr = ybuf[u];
            if (s + 4 < 32) ybuf[u] = *(const u32x4*)(yrow + 32 * (s + 4));
            const f32x4 ya = unpack_f16x4(yr.x, yr.y), yb = unpack_f16x4(yr.z, yr.w);
            s1 += ((ya[0] + ya[1]) + (ya[2] + ya[3])) + ((yb[0] + yb[1]) + (yb[2] + yb[3]));
            s2 += ((ya[0] * ya[0] + ya[1] * ya[1]) + (ya[2] * ya[2] + ya[3] * ya[3])) + ((yb[0] * yb[0] + yb[1] * yb[1]) + (yb[2] * yb[2] + yb[3] * yb[3]));
            const f16v8_t ay = __builtin_bit_cast(f16v8_t, yr);
            const f16v8_t h0 = *(const LAS f16v8_t*)(Wh + wo0 + 32 * s), h1 = *(const LAS f16v8_t*)(Wh + wo1 + 32 * s), h2 = *(const LAS f16v8_t*)(Wh + wo2 + 32 * s);
            const f16v8_t l0 = *(const LAS f16v8_t*)(Wl + wo0 + 32 * s), l1 = *(const LAS f16v8_t*)(Wl + wo1 + 32 * s), l2 = *(const LAS f16v8_t*)(Wl + wo2 + 32 * s);
            acc0 = __builtin_amdgcn_mfma_f32_16x16x32_f16(ay, h0, acc0, 0, 0, 0); acc1 = __builtin_amdgcn_mfma_f32_16x16x32_f16(ay, h1, acc1, 0, 0, 0); acc2 = __builtin_amdgcn_mfma_f32_16x16x32_f16(ay, h2, acc2, 0, 0, 0);
            lo0 = __builtin_amdgcn_mfma_f32_16x16x32_f16(ay, l0, lo0, 0, 0, 0); lo1 = __builtin_amdgcn_mfma_f32_16x16x32_f16(ay, l1, lo1, 0, 0, 0); lo2 = __builtin_amdgcn_mfma_f32_16x16x32_f16(ay, l2, lo2, 0, 0, 0); } }
    acc0 += lo0 * (1.f / 2048.f); acc1 += lo1 * (1.f / 2048.f); acc2 += lo2 * (1.f / 2048.f);
    s1 += bperm(s1, w.lane ^ 16); s1 += bperm(s1, w.lane ^ 32); s2 += bperm(s2, w.lane ^ 16); s2 += bperm(s2, w.lane ^ 32);
    { const float mean = s1 * (1.f / DM), var = fmaxf(s2 * (1.f / DM) - mean * mean, 0.f);
      if (kq == 0) { st[(w.wave * 16 + x) * 2] = mean; st[(w.wave * 16 + x) * 2 + 1] = rsqrtf(var + LN_EPS); } }
    __syncthreads();
    LAS float* Lw = (LAS float*)lds + w.wave * 640;
#pragma unroll
    for (int r = 0; r < 4; ++r) { const int row = 4 * kq + r; const float mean = st[(w.wave * 16 + row) * 2], rstd = st[(w.wave * 16 + row) * 2 + 1];
        Lw[row * 40 + x] = rstd * (acc0[r] - mean * c1[x]) + c2[x]; Lw[row * 40 + 16 + x] = rstd * (acc1[r] - mean * c1[16 + x]) + c2[16 + x];
        if (x < 4) Lw[row * 40 + 32 + x] = rstd * (acc2[r] - mean * c1[32 + x]) + c2[32 + x]; }
    asm volatile("s_waitcnt lgkmcnt(0)" ::: "memory");
    int* tope = (int*)(ws + WS_TOPE); float* topw = (float*)(ws + WS_TOPW); int* tpos = (int*)(ws + WS_TPOS); int* ste = (int*)(ws + WS_STE);
    if (w.lane < 16) { const int m = row0 + w.lane; const LAS float* L = Lw + w.lane * 40;
        float gl[4];
#pragma unroll
        for (int q = 0; q < 4; ++q) gl[q] = L[q];
        int grp = 0; float gm = gl[0];
#pragma unroll
        for (int q = 1; q < 4; ++q) if (gl[q] > gm) { gm = gl[q]; grp = q; }
        float gs = 0.f;
#pragma unroll
        for (int q = 0; q < 4; ++q) gs += expf(gl[q] - gm);
        const float pg = 1.f / gs;
        float el[8];
#pragma unroll
        for (int i = 0; i < 8; ++i) el[i] = L[4 + grp * EPG + i];
        int i0 = 0; float v0 = el[0];
#pragma unroll
        for (int i = 1; i < 8; ++i) if (el[i] > v0) { v0 = el[i]; i0 = i; }
        int i1 = -1; float v1 = -3.0e38f;
#pragma unroll
        for (int i = 0; i < 8; ++i) if (i != i0 && el[i] > v1) { v1 = el[i]; i1 = i; }
        const float w0 = 1.f / (1.f + expf(v1 - v0));
        const int e0 = grp * EPG + i0, e1 = grp * EPG + i1;
        tope[2 * m] = e0; tope[2 * m + 1] = e1; topw[2 * m] = w0 * pg; topw[2 * m + 1] = (1.f - w0) * pg;
        tpos[2 * m] = (int)atomicAdd((unsigned*)&lcnt[e0], 1u); tpos[2 * m + 1] = (int)atomicAdd((unsigned*)&lcnt[e1], 1u); }
    f32x4 gg[4], bb[4];
#pragma unroll
    for (int j = 0; j < 4; ++j) { gg[j] = *(const f32x4*)(g1 + 256 * j + 4 * w.lane); bb[j] = *(const f32x4*)(b1 + 256 * j + 4 * w.lane); }
#define L1_LOAD(R, g) do { _Pragma("unroll") for (int r = 0; r < 4; ++r) _Pragma("unroll") for (int j = 0; j < 4; ++j) R[r][j] = *(const u32x2*)(Y + (size_t)(row0 + 4 * (g) + r) * DM + 256 * j + 4 * w.lane); \
        __builtin_amdgcn_sched_barrier(0); } while (0)
#define L1_APPLY(R, g) do { const int m0 = row0 + 4 * (g);                                                                                                       \
        _Pragma("unroll") for (int r = 0; r < 4; ++r) { const float mean = st[(w.wave * 16 + 4 * (g) + r) * 2], rstd = st[(w.wave * 16 + 4 * (g) + r) * 2 + 1];   \
            _Pragma("unroll") for (int j = 0; j < 4; ++j) { const f32x4 v = (unpack_f16x4(R[r][j].x, R[r][j].y) - mean) * rstd * gg[j] + bb[j];                   \
                u32x2 o; o.x = cvt_pk_f16(v[0], v[1]); o.y = cvt_pk_f16(v[2], v[3]); *(u32x2*)(Y + (size_t)(m0 + r) * DM + 256 * j + 4 * w.lane) = o;            \
                *(unsigned*)(ws + WS_X18 + (size_t)(m0 + r) * DM + 256 * j + 4 * w.lane) = pack4_fp8(v[0], v[1], v[2], v[3]); } }                                 \
        __builtin_amdgcn_sched_barrier(0); } while (0)
    { u32x2 ra[4][4], rb[4][4];
      L1_LOAD(ra, 0); L1_LOAD(rb, 1); L1_APPLY(ra, 0); L1_LOAD(ra, 2); L1_APPLY(rb, 1); L1_LOAD(rb, 3); L1_APPLY(ra, 2); L1_APPLY(rb, 3); }
#undef L1_LOAD
#undef L1_APPLY
    __syncthreads();
    if (w.tid < NE) lbase[w.tid] = atomicAdd((unsigned*)(ws + WS_CTL) + CW_CNT + layer * 64 + w.tid, lcnt[w.tid]);
    __syncthreads();
    if (w.lane < 32) { const int m = row0 + (w.lane >> 1), k = w.lane & 1; const int e = tope[2 * m + k]; const int p = tpos[2 * m + k] + (int)lbase[e]; tpos[2 * m + k] = p; ste[(size_t)e * T + p] = m; }
}

__device__ __forceinline__ void moe_starts(const Ctx& c, int layer, LAS int* start  , LAS int* cnt  ) {
    const unsigned* gc = (const unsigned*)(wsl(c) + WS_CTL) + CW_CNT + layer * 64;
    if (threadIdx.x < NE) cnt[threadIdx.x] = (int)__hip_atomic_load(gc + threadIdx.x, __ATOMIC_RELAXED, __HIP_MEMORY_SCOPE_AGENT);
    __syncthreads();
    if (threadIdx.x == 0) { int s = 0;
        for (int e = 0; e < NE; ++e) { const int n = cnt[e]; start[e] = s; s += (n + 255) & ~255; }
        start[NE] = s; }
    __syncthreads();
}

__device__ __forceinline__ void ph_ln2(const Ctx& c, int layer, LAS unsigned char* lds, float oscale = 1.f) {
    const Wv w = make_wv(); unsigned char* ws = wsl(c);
    LAS int* start = (LAS int*)lds; LAS int* cnt = start + 40; LAS float* ffw = (LAS float*)(lds + 1024);
    if (layer + 1 < DEPTH) stage_ffw(c, layer + 1, ffw, w.tid);
    moe_starts(c, layer, start, cnt);
    const bf16_t* X1 = (const bf16_t*)(ws + WS_YX); const bf16_t* YB = (const bf16_t*)(ws + WS_YB);
    const int* tope = (const int*)(ws + WS_TOPE); const float* topw = (const float*)(ws + WS_TOPW); const int* tpos = (const int*)(ws + WS_TPOS);
    const float* g2 = c.in[I_L2G] + layer * DM; const float* b2 = c.in[I_L2B] + layer * DM;
    float* dst = c.outp();
    for (int mA = w.gw; mA < T; mA += 2 * w.ngw) { const int mB = mA + w.ngw;
        int mm[2] = {mA, mB}; size_t s0[2], s1[2]; float w0[2], w1[2];
#pragma unroll
        for (int q = 0; q < 2; ++q) { const int m = mm[q]; const int e0 = tope[2 * m], e1 = tope[2 * m + 1]; w0[q] = topw[2 * m]; w1[q] = topw[2 * m + 1];
            s0[q] = (size_t)(start[e0] + tpos[2 * m]); s1[q] = (size_t)(start[e1] + tpos[2 * m + 1]); }
        u32x2 xr[2][4], ar[2][4], br[2][4];
#pragma unroll
        for (int q = 0; q < 2; ++q)
#pragma unroll
            for (int j = 0; j < 4; ++j) { xr[q][j] = *(const u32x2*)(X1 + (size_t)mm[q] * DM + 256 * j + 4 * w.lane);
                ar[q][j] = *(const u32x2*)(YB + s0[q] * DM + 256 * j + 4 * w.lane); br[q][j] = *(const u32x2*)(YB + s1[q] * DM + 256 * j + 4 * w.lane); }
#pragma unroll
        for (int q = 0; q < 2; ++q) { const int m = mm[q]; f32x4 v[4]; float s = 0.f;
#pragma unroll
            for (int j = 0; j < 4; ++j) { const f32x4 x = unpack_f16x4(xr[q][j].x, xr[q][j].y); const u32x2 a = ar[q][j], b = br[q][j];
                f32x4 ya, yb; ya[0] = __uint_as_float(a.x << 16); ya[1] = __uint_as_float(a.x & 0xffff0000u); ya[2] = __uint_as_float(a.y << 16); ya[3] = __uint_as_float(a.y & 0xffff0000u);
                yb[0] = __uint_as_float(b.x << 16); yb[1] = __uint_as_float(b.x & 0xffff0000u); yb[2] = __uint_as_float(b.y << 16); yb[3] = __uint_as_float(b.y & 0xffff0000u);
                v[j] = x * ALPHA + (ya * w0[q] + yb * w1[q]); s += (v[j][0] + v[j][1]) + (v[j][2] + v[j][3]); }
            const float mean = wave_sum(s) * (1.f / DM); float s2 = 0.f;
#pragma unroll
            for (int j = 0; j < 4; ++j) { v[j] = v[j] - mean; s2 += (v[j][0] * v[j][0] + v[j][1] * v[j][1]) + (v[j][2] * v[j][2] + v[j][3] * v[j][3]); }
            const float rstd = rsqrtf(wave_sum(s2) * (1.f / DM) + LN_EPS);
#pragma unroll
            for (int j = 0; j < 4; ++j) { const f32x4 g = *(const f32x4*)(g2 + 256 * j + 4 * w.lane), bb = *(const f32x4*)(b2 + 256 * j + 4 * w.lane);
                v[j] = v[j] * rstd * g + bb; if (layer == DEPTH - 1) *((f32x4*)(dst + (size_t)m * DM) + w.lane + 64 * j) = v[j] * oscale; }
            if (layer + 1 < DEPTH) emit_xb_ffl(c, layer + 1, m, v, w.lane, ffw); }
    }
}


namespace pg8 {
typedef short bf16x8 __attribute__((ext_vector_type(8)));
typedef int v8i_t __attribute__((ext_vector_type(8)));
typedef int i32x4_t __attribute__((ext_vector_type(4)));
constexpr int BM = 256, BK = 64, HALF = 128, HTB = HALF * BK * 2, STAGE_BYTES = 8 * HTB, NXCD = 8, WGM = 8;
__host__ __device__ __forceinline__ int lds_byte(int r, int c) { const int st = (r >> 4) * 2 + (c >> 5), rr = r & 15, cc = c & 31, ob = rr * 64 + cc * 2; return st * 1024 + (ob ^ (((ob >> 9) & 1) << 5)); }
__host__ __device__ __forceinline__ void stage_rc(int b, int& R, int& C) { const int st = b / 1024, sb = b % 1024, swz = sb ^ (((sb >> 9) & 1) << 5); R = (st >> 1) * 16 + swz / 64; C = (st & 1) * 32 + (swz % 64) / 2; }
__host__ __device__ __forceinline__ int perm32(int rho) { const int n = rho >> 4, i = rho & 15; return 8 * (i >> 2) + 4 * n + (i & 3); }
struct Unit { int pm, pn, e, rt; };
using ::cvt_pk_bf16;

struct StaticOrder {
    static constexpr bool GATHER = false;
    const char* A; const char* Bt; int nM, nN, nwg, G, c; size_t a_tstep, b_tstep;
    __device__ void init(const void* A_, const void* Bt_, int M, int N, int K, int G_, int c_, int elt_bytes = 2) { A = (const char*)A_; Bt = (const char*)Bt_; nM = M / BM; nN = N / BM; nwg = nM * nN; G = G_; c = c_; a_tstep = (size_t)BM * K * elt_bytes; b_tstep = a_tstep; }
    __device__ bool next(int i, Unit& u) const {
        const long L = (long)i * G + c; if (L >= nwg) return false;
        int wgid = (int)L; { const int q = nwg / NXCD, r = nwg % NXCD, xcd = wgid % NXCD, off = wgid / NXCD; wgid = (xcd < r ? xcd * (q + 1) : r * (q + 1) + (xcd - r) * q) + off; }
        const int nig = WGM * nN, gid = wgid / nig, fm = gid * WGM, gsz = (nM - fm) < WGM ? (nM - fm) : WGM;
        u.pm = fm + ((wgid % nig) % gsz); u.pn = (wgid % nig) / gsz; u.e = 0; u.rt = 0; return true;
    }
    __device__ __forceinline__ const char* a_base(const Unit& u) const { return A + (size_t)u.pm * a_tstep; }
    __device__ __forceinline__ const char* b_base(const Unit& u) const { return Bt + (size_t)u.pn * b_tstep; }
    __device__ __forceinline__ int tok(const Unit&, int) const { return 0; }
};
template <bool UP> struct MoeOrder {
    static constexpr bool GATHER = UP;
    const char* A; const char* Bt; const int* ste; LAS const int* tp; LAS const int* start; LAS const int* cnt; int G, c;
    __device__ bool next(int i, Unit& u) const {
        const int L = i * G + c; if (L >= tp[NE] * 4) return false;
        const int rtg = L >> 2; int e = 0;
        for (int q = 1; q < NE; ++q) if (rtg >= tp[q]) e = q;
        u.e = e; u.rt = rtg - tp[e]; u.pm = (start[e] >> 8) + u.rt; u.pn = L & 3; return true;
    }
    __device__ __forceinline__ const char* a_base(const Unit& u) const { return UP ? A : A + (size_t)u.pm * (BM * DE); }
    __device__ __forceinline__ const char* b_base(const Unit& u) const { return Bt + ((size_t)u.e * 1024 + u.pn * 256) * (UP ? DM : DE); }
    __device__ __forceinline__ int tok(const Unit& u, int r) const { const int i = u.rt * 256 + r; return i < cnt[u.e] ? ste[(size_t)u.e * T + i] : 0; }
};

template <int ACT> __device__ __forceinline__ float actf(float x) {
    if (ACT == 1) return x * __builtin_amdgcn_rcpf(1.f + __expf(-x));
    if (ACT == 2) return __builtin_amdgcn_rcpf(1.f + __expf(-x));
    return x;
}
template <int ACT> __device__ __forceinline__ f32x4 act4(const f32x4 x) {
    if (ACT == 0) return x;
    const f32x4 t = x * -1.4426950408889634f;
    const f32x4 e = {__builtin_amdgcn_exp2f(t[0]), __builtin_amdgcn_exp2f(t[1]), __builtin_amdgcn_exp2f(t[2]), __builtin_amdgcn_exp2f(t[3])};
    const f32x4 d = e + 1.f;
    const f32x4 r = {__builtin_amdgcn_rcpf(d[0]), __builtin_amdgcn_rcpf(d[1]), __builtin_amdgcn_rcpf(d[2]), __builtin_amdgcn_rcpf(d[3])};
    return ACT == 1 ? x * r : r;
}
template <int ACT> __device__ __forceinline__ u32x4 pack8_act(const f32x4 a, const f32x4 b) {
    u32x4 w; w.x = cvt_pk_bf16(actf<ACT>(a[0]), actf<ACT>(a[1])); w.y = cvt_pk_bf16(actf<ACT>(a[2]), actf<ACT>(a[3])); w.z = cvt_pk_bf16(actf<ACT>(b[0]), actf<ACT>(b[1])); w.w = cvt_pk_bf16(actf<ACT>(b[2]), actf<ACT>(b[3])); return w;
}
__device__ __forceinline__ void unpack8(const u32x4 r, f32x4& a, f32x4& b) {
    a[0] = __uint_as_float(r.x << 16); a[1] = __uint_as_float(r.x & 0xffff0000u); a[2] = __uint_as_float(r.y << 16); a[3] = __uint_as_float(r.y & 0xffff0000u);
    b[0] = __uint_as_float(r.z << 16); b[1] = __uint_as_float(r.z & 0xffff0000u); b[2] = __uint_as_float(r.w << 16); b[3] = __uint_as_float(r.w & 0xffff0000u);
}
struct EpiInProj {
    static constexpr bool PERM = true;
    InProjOut o; float sc;
    const float* gq; const float* gk; LAS float* xch; int lane;
    template <int ACT, bool HM> __device__ __forceinline__ void st16(bf16_t* base, const f32x4 (&acc)[2][2][4][2], int row0, int ctile, int wc, int fq) const {
#pragma unroll
        for (int ai = 0; ai < 2; ++ai)
#pragma unroll
            for (int m = 0; m < 4; ++m) { const int row = row0 + ai * HALF + m * 16;
                const size_t ro = HM ? ((size_t)((row >> 13) * (NH * SEQ) + (row & (SEQ - 1)))) * DH : (size_t)row * DM;
#pragma unroll
                for (int bj = 0; bj < 2; ++bj) { const int c0 = ctile + 128 * bj + 32 * wc + 8 * fq;
                    const size_t co = HM ? (size_t)(c0 >> 7) * SEQ * DH + (c0 & 127) : (size_t)c0;
                    *(u32x4*)(base + ro + co) = pack8_act<ACT>(acc[ai][bj][m][0] * sc, acc[ai][bj][m][1] * sc); } }
    }
    template <int ACT> __device__ __forceinline__ void st8(unsigned char* base, const f32x4 (&acc)[2][2][4][2], int row0, int ctile, int wc, int fq) const {
#pragma unroll
        for (int ai = 0; ai < 2; ++ai)
#pragma unroll
            for (int m = 0; m < 4; ++m)
#pragma unroll
                for (int bj = 0; bj < 2; ++bj) { const f32x4 a = act4<ACT>(acc[ai][bj][m][0] * sc), b = act4<ACT>(acc[ai][bj][m][1] * sc); u32x2 w;
                    w.x = pack4_fp8(a[0], a[1], a[2], a[3]); w.y = pack4_fp8(b[0], b[1], b[2], b[3]);
                    *(u32x2*)(base + (size_t)(row0 + ai * HALF + m * 16) * DM + ctile + 128 * bj + 32 * wc + 8 * fq) = w; }
    }
    template <bool HM> __device__ __forceinline__ void st_norm(bf16_t* base, const float* gain, const f32x4 (&acc)[2][2][4][2], int row0, int ctile, int wr, int wc, int fr, int fq, int par) const {
        LAS float* tb = xch + par * 2048;
#pragma unroll
        for (int ai = 0; ai < 2; ++ai)
#pragma unroll
            for (int m = 0; m < 4; ++m)
#pragma unroll
                for (int bj = 0; bj < 2; ++bj) { const f32x4 a = acc[ai][bj][m][0], b = acc[ai][bj][m][1];
                    float ss = ((a[0] * a[0] + a[1] * a[1]) + (a[2] * a[2] + a[3] * a[3])) + ((b[0] * b[0] + b[1] * b[1]) + (b[2] * b[2] + b[3] * b[3]));
                    ss += bperm(ss, lane ^ 16); ss += bperm(ss, lane ^ 32);
                    if (fq == 0) tb[((ai * HALF + wr * 64 + m * 16 + fr) * 2 + bj) * 4 + wc] = ss; }
        asm volatile("s_waitcnt lgkmcnt(0)" ::: "memory"); __builtin_amdgcn_s_barrier(); asm volatile("" ::: "memory");
#pragma unroll
        for (int bj = 0; bj < 2; ++bj) { const int c0 = ctile + 128 * bj + 32 * wc + 8 * fq; const f32x4 g0 = *(const f32x4*)(gain + (c0 & 127)), g1 = *(const f32x4*)(gain + (c0 & 127) + 4);
            const size_t co = HM ? (size_t)(c0 >> 7) * SEQ * DH + (c0 & 127) : (size_t)c0;
#pragma unroll
            for (int ai = 0; ai < 2; ++ai)
#pragma unroll
                for (int m = 0; m < 4; ++m) { const int row = row0 + ai * HALF + m * 16;
                    const f32x4 ps = *(const LAS f32x4*)(tb + ((ai * HALF + wr * 64 + m * 16 + fr) * 2 + bj) * 4);
                    const float r = rsqrtf(((ps[0] + ps[1]) + (ps[2] + ps[3])) * (sc * sc * (1.f / DH)) + NORM_EPS) * sc;
                    const size_t ro = HM ? ((size_t)((row >> 13) * (NH * SEQ) + (row & (SEQ - 1)))) * DH : (size_t)row * DM;
                    *(u32x4*)(base + ro + co) = pack8_act<0>(acc[ai][bj][m][0] * r * g0, acc[ai][bj][m][1] * r * g1); } }
    }
    __device__ __forceinline__ bool operator()(const f32x4 (&acc)[2][2][4][2], const Unit& u, int wr, int wc, int fr, int fq) const {
        const int region = u.pn >> 2, ctile = (u.pn & 3) * 256, row0 = u.pm * BM + wr * 64 + fr;
        if (region == 0) st8<1>(o.QA, acc, row0, ctile, wc, fq);
        else if (region == 2) st8<0>(o.VA, acc, row0, ctile, wc, fq);
        else if (region == 3) st8<1>(o.GA, acc, row0, ctile, wc, fq);
        else if (region == 4) st_norm<false>(o.FQ, gq, acc, row0, ctile, wr, wc, fr, fq, 0);
        else if (region == 5) st_norm<true>(o.FK, gk, acc, row0, ctile, wr, wc, fr, fq, 1);
        else if (region == 6) st16<0, true>(o.FV, acc, row0, ctile, wc, fq);
        else if (region == 7) st8<2>(o.SGA, acc, row0, ctile, wc, fq);
        else if (region == 8) st8<2>(o.SGB, acc, row0, ctile, wc, fq);
        else {
#pragma unroll
            for (int bj = 0; bj < 2; ++bj) { const int c0 = ctile + 128 * bj + 32 * wc + 8 * fq;
                const f32x4 l0 = *(const f32x4*)(o.lb + c0), l1 = *(const f32x4*)(o.lb + c0 + 4);
#pragma unroll
                for (int ai = 0; ai < 2; ++ai)
#pragma unroll
                    for (int m = 0; m < 4; ++m) { const int row = row0 + ai * HALF + m * 16; bf16_t* p = o.LF + (size_t)row * DM + c0;
                        f32x4 r0, r1;
#pragma unroll
                        for (int j = 0; j < 4; ++j) { r0[j] = __logf(l0[j] + (1.f - l0[j]) * actf<2>(acc[ai][bj][m][0][j] * sc)); r1[j] = __logf(l1[j] + (1.f - l1[j]) * actf<2>(acc[ai][bj][m][1][j] * sc)); }
                        u32x4 w; w.x = cvt_pk_f16(r0[0], r0[1]); w.y = cvt_pk_f16(r0[2], r0[3]); w.z = cvt_pk_f16(r1[0], r1[1]); w.w = cvt_pk_f16(r1[2], r1[3]); *(u32x4*)p = w; } }
        }
        return false;
    }
};
struct EpiMergeChain {
    static constexpr bool PERM = true;
    const unsigned char* sga; const unsigned char* sgb; unsigned char* MG; float sc;
    __device__ __forceinline__ bool operator()(f32x4 (&acc)[2][2][4][2], const Unit& u, int wr, int wc, int fr, int fq) const {
        const int row0 = u.pm * BM + wr * 64 + fr, cb = u.pn * BM + 32 * wc + 8 * fq;
#pragma unroll
        for (int ai = 0; ai < 2; ++ai) { u32x2 gb[4][2], ga[4][2];
#pragma unroll
            for (int m = 0; m < 4; ++m)
#pragma unroll
                for (int bj = 0; bj < 2; ++bj) { const size_t i = (size_t)(row0 + ai * HALF + m * 16) * DM + cb + 128 * bj; gb[m][bj] = *(const u32x2*)(sgb + i); if (u.e == 0) ga[m][bj] = *(const u32x2*)(sga + i); }
#pragma unroll
            for (int m = 0; m < 4; ++m)
#pragma unroll
                for (int bj = 0; bj < 2; ++bj) { const size_t i = (size_t)(row0 + ai * HALF + m * 16) * DM + cb + 128 * bj; const f32x4 b0 = unpack4_fp8(gb[m][bj].x), b1 = unpack4_fp8(gb[m][bj].y);
                    if (u.e == 0) { const f32x4 a0 = unpack4_fp8(ga[m][bj].x), a1 = unpack4_fp8(ga[m][bj].y);
#pragma unroll
                        for (int j = 0; j < 4; ++j) { acc[ai][bj][m][0][j] *= a0[j] * __builtin_amdgcn_rcpf(fmaxf(b0[j], 1e-30f)); acc[ai][bj][m][1][j] *= a1[j] * __builtin_amdgcn_rcpf(fmaxf(b1[j], 1e-30f)); } }
                    else { const f32x4 y0 = acc[ai][bj][m][0] * b0 * sc, y1 = acc[ai][bj][m][1] * b1 * sc; u32x2 w; w.x = pack4_fp8(y0[0], y0[1], y0[2], y0[3]); w.y = pack4_fp8(y1[0], y1[1], y1[2], y1[3]); *(u32x2*)(MG + i) = w; } }
            asm volatile("" ::: "memory"); }
        return u.e == 0;
    }
};
struct MergeOrder {
    static constexpr bool GATHER = false;
    StaticOrder base; const char* A2; const char* B2;
    __device__ bool next(int i, Unit& u) const { if (!base.next(i >> 1, u)) return false; u.e = i & 1; return true; }
    __device__ __forceinline__ const char* a_base(const Unit& u) const { return (u.e ? A2 : base.A) + (size_t)u.pm * base.a_tstep; }
    __device__ __forceinline__ const char* b_base(const Unit& u) const { return (u.e ? B2 : base.Bt) + (size_t)u.pn * base.b_tstep; }
    __device__ __forceinline__ int tok(const Unit&, int) const { return 0; }
};
struct EpiOut {
    static constexpr bool PERM = true;
    const bf16_t* x; bf16_t* Y; float sc;
    __device__ __forceinline__ bool operator()(const f32x4 (&acc)[2][2][4][2], const Unit& u, int wr, int wc, int fr, int fq) const {
        const int row0 = u.pm * BM + wr * 64 + fr, cb = u.pn * BM + 32 * wc + 8 * fq;
#pragma unroll
        for (int ai = 0; ai < 2; ++ai) { u32x4 xv[4][2];
#pragma unroll
            for (int m = 0; m < 4; ++m)
#pragma unroll
                for (int bj = 0; bj < 2; ++bj) xv[m][bj] = *(const u32x4*)(x + (size_t)(row0 + ai * HALF + m * 16) * DM + cb + 128 * bj);
#pragma unroll
            for (int m = 0; m < 4; ++m)
#pragma unroll
                for (int bj = 0; bj < 2; ++bj) { f32x4 x0, x1; const u32x4 r = xv[m][bj];
                    x0 = unpack_f16x4(r.x, r.y); x1 = unpack_f16x4(r.z, r.w);
                    const f32x4 y0 = x0 * ALPHA + acc[ai][bj][m][0] * sc, y1 = x1 * ALPHA + acc[ai][bj][m][1] * sc;
                    u32x4 w; w.x = cvt_pk_f16(y0[0], y0[1]); w.y = cvt_pk_f16(y0[2], y0[3]); w.z = cvt_pk_f16(y1[0], y1[1]); w.w = cvt_pk_f16(y1[2], y1[3]);
                    *(u32x4*)(Y + (size_t)(row0 + ai * HALF + m * 16) * DM + cb + 128 * bj) = w; }
            asm volatile("" ::: "memory"); }
        return false;
    }
};
struct EpiMoeUp {
    static constexpr bool PERM = true;
    unsigned char* HB; float sc;
    __device__ __forceinline__ bool operator()(const f32x4 (&acc)[2][2][4][2], const Unit& u, int wr, int wc, int fr, int fq) const {
        const int row0 = u.pm * BM + wr * 64 + fr, j0 = u.pn * 128 + 32 * wc + 8 * fq;
#pragma unroll
        for (int ai = 0; ai < 2; ++ai)
#pragma unroll
            for (int m = 0; m < 4; ++m) { f32x4 h0, h1;
                h0 = act4<1>(acc[ai][0][m][0] * sc) * (acc[ai][1][m][0] * sc); h1 = act4<1>(acc[ai][0][m][1] * sc) * (acc[ai][1][m][1] * sc);
                u32x2 w; w.x = pack4_fp8(h0[0], h0[1], h0[2], h0[3]); w.y = pack4_fp8(h1[0], h1[1], h1[2], h1[3]);
                *(u32x2*)(HB + (size_t)(row0 + ai * HALF + m * 16) * DE + j0) = w; }
        return false;
    }
};
struct EpiMoeDn {
    static constexpr bool PERM = true;
    bf16_t* YB; float sc;
    __device__ __forceinline__ bool operator()(const f32x4 (&acc)[2][2][4][2], const Unit& u, int wr, int wc, int fr, int fq) const {
        const int row0 = u.pm * BM + wr * 64 + fr, cb = u.pn * BM + 32 * wc + 8 * fq;
#pragma unroll
        for (int ai = 0; ai < 2; ++ai)
#pragma unroll
            for (int m = 0; m < 4; ++m)
#pragma unroll
                for (int bj = 0; bj < 2; ++bj) *(u32x4*)(YB + (size_t)(row0 + ai * HALF + m * 16) * DM + cb + 128 * bj) = pack8_act<0>(acc[ai][bj][m][0] * sc, acc[ai][bj][m][1] * sc);
        return false;
    }
};

template <int K, class Epi, class Sched, bool F8 = false>
__device__ __forceinline__ void gemm_phase(LAS unsigned char* lds, const Sched& S, const Epi& E) {
    const int tid = tidx(), wid = __builtin_amdgcn_readfirstlane(tid >> 6), lane = tid & 63, wr = wid >> 2, wc = wid & 3, fr = lane & 15, fq = lane >> 4;
    constexpr int RB = F8 ? K : K * 2, nt = RB / 128;
    int RA[2]; unsigned CA2[2], voffB[2], voffA[2][2], voffN[2][2];
#pragma unroll
    for (int i = 0; i < 2; ++i) { int R, C2;
        if (F8) { const int q = tid + 512 * i; R = 16 * (q >> 7) + (q & 15); C2 = (2 * ((q >> 4) & 3) + ((q >> 6) & 1)) * 16; }
        else { int C; stage_rc(tid * 16 + i * 8192, R, C); C2 = 2 * C; }
        const int Rb = Epi::PERM ? ((R & ~31) + perm32(R & 31)) : R;
        RA[i] = R; CA2[i] = (unsigned)C2; voffB[i] = (unsigned)(Rb * RB + C2); }
    const size_t kstep = (size_t)128, hstepB = (size_t)HALF * RB;
    const unsigned ldsw = (unsigned)wid * 1024u;
    const int aoff = F8 ? (4 * wr) * 2048 + lane * 16 : lds_byte(wr * 64 + fr, fq * 8), boff = F8 ? (2 * wc) * 2048 + lane * 16 : lds_byte(wc * 32 + fr, fq * 8);
#define PG8_SA(b, h) (((b) * 2 + (h)) * HTB)
#define PG8_SB(b, h) ((4 + (b) * 2 + (h)) * HTB)
#define PG8_STAGE(bufoff, gbase, voff) do { _Pragma("unroll") for (int _i = 0; _i < 2; ++_i) \
        __builtin_amdgcn_global_load_lds((const unsigned*)((const char*)(gbase) + (voff)[_i]), (LAS unsigned*)(lds + (bufoff) + ldsw + _i * 8192), 16, 0, 0); } while (0)
#define PG8_LDA(dst, b, h) do { if (F8) { unsigned ab_ = (unsigned)aoff; asm volatile("" : "+v"(ab_)); const LAS unsigned char* ap_ = lds + ab_ + PG8_SA(b, h); \
            _Pragma("unroll") for (int m = 0; m < 4; ++m) dst##8[m] = __builtin_shufflevector(*(const LAS i32x4_t*)(ap_ + m * 2048), *(const LAS i32x4_t*)(ap_ + m * 2048 + 1024), 0, 1, 2, 3, 4, 5, 6, 7); } \
        else { _Pragma("unroll") for (int m = 0; m < 4; ++m) _Pragma("unroll") for (int k = 0; k < 2; ++k) dst[m][k] = *(const LAS bf16x8*)(lds + PG8_SA(b, h) + aoff + m * 2048 + k * 1024); } } while (0)
#define PG8_LDB(dst, b, h) do { if (F8) { unsigned bb_ = (unsigned)boff; asm volatile("" : "+v"(bb_)); const LAS unsigned char* bp_ = lds + bb_ + PG8_SB(b, h); \
            _Pragma("unroll") for (int n = 0; n < 2; ++n) dst##8[n] = __builtin_shufflevector(*(const LAS i32x4_t*)(bp_ + n * 2048), *(const LAS i32x4_t*)(bp_ + n * 2048 + 1024), 0, 1, 2, 3, 4, 5, 6, 7); } \
        else { _Pragma("unroll") for (int n = 0; n < 2; ++n) _Pragma("unroll") for (int k = 0; k < 2; ++k) dst[n][k] = *(const LAS bf16x8*)(lds + PG8_SB(b, h) + boff + n * 2048 + k * 1024); } } while (0)
#define PG8_MMA(ai, bj, At, Bt) do { __builtin_amdgcn_s_setprio(1); \
        if (F8) { _Pragma("unroll") for (int m = 0; m < 4; ++m) _Pragma("unroll") for (int n = 0; n < 2; ++n) \
            asm volatile("v_mfma_f32_16x16x128_f8f6f4 %0, %1, %2, %0" : "+v"(acc[ai][bj][m][n]) : "v"(Bt##8[n]), "v"(At##8[m])); } \
        else { _Pragma("unroll") for (int m = 0; m < 4; ++m) _Pragma("unroll") for (int n = 0; n < 2; ++n) _Pragma("unroll") for (int k = 0; k < 2; ++k) \
            acc[ai][bj][m][n] = __builtin_amdgcn_mfma_f32_16x16x32_bf16(Bt[n][k], At[m][k], acc[ai][bj][m][n], 0, 0, 0); } \
        __builtin_amdgcn_s_setprio(0); } while (0)
#define PG8_WAIT_V(n) asm volatile("s_waitcnt vmcnt(" #n ")" ::: "memory")
#define PG8_WAIT_L(n) asm volatile("s_waitcnt lgkmcnt(" #n ")" ::: "memory")
#define PG8_BAR __builtin_amdgcn_s_barrier()
#define PG8_SCHED __builtin_amdgcn_sched_barrier(0)
#define PG8_SETOFF(dst, u) do { _Pragma("unroll") for (int _h = 0; _h < 2; ++_h) _Pragma("unroll") for (int _i = 0; _i < 2; ++_i) \
        dst[_h][_i] = Sched::GATHER ? (unsigned)S.tok(u, RA[_i] + HALF * _h) * (unsigned)RB + CA2[_i] : (unsigned)((RA[_i] + HALF * _h) * RB) + CA2[_i]; } while (0)
    Unit cur, nxt; int ui = 0;
    if (!S.next(0, cur)) return;
    f32x4 acc[2][2][4][2];
#pragma unroll
    for (int a = 0; a < 2; ++a)
#pragma unroll
        for (int b = 0; b < 2; ++b)
#pragma unroll
            for (int m = 0; m < 4; ++m)
#pragma unroll
                for (int n = 0; n < 2; ++n) acc[a][b][m][n] = (f32x4){0.f, 0.f, 0.f, 0.f};
    bf16x8 At[4][2], B0[2][2], B1[2][2]; v8i_t At8[4], B08[2], B18[2];
    PG8_SETOFF(voffA, cur);
    const char* cA = S.a_base(cur); const char* cB = S.b_base(cur);
    PG8_STAGE(PG8_SB(0, 0), cB, voffB); PG8_STAGE(PG8_SA(0, 0), cA, voffA[0]); PG8_STAGE(PG8_SB(0, 1), cB + hstepB, voffB); PG8_STAGE(PG8_SA(0, 1), cA, voffA[1]);
    if (wr == 1) PG8_BAR;
    PG8_WAIT_V(4); PG8_BAR;
    PG8_STAGE(PG8_SB(1, 0), cB + kstep, voffB); PG8_STAGE(PG8_SA(1, 0), cA + kstep, voffA[0]); PG8_STAGE(PG8_SB(1, 1), cB + hstepB + kstep, voffB);
    PG8_WAIT_V(6); PG8_BAR;
    for (;;) {
        const bool has_next = S.next(ui + 1, nxt);
        const char* nA = has_next ? S.a_base(nxt) : cA; const char* nB = has_next ? S.b_base(nxt) : cB;
        if (Sched::GATHER) { if (has_next) { PG8_SETOFF(voffN, nxt); } else {
#pragma unroll
            for (int h = 0; h < 2; ++h)
#pragma unroll
                for (int i = 0; i < 2; ++i) voffN[h][i] = voffA[h][i]; } }
        if (Sched::GATHER) asm volatile("" : "+v"(voffN[0][0]), "+v"(voffN[0][1]), "+v"(voffN[1][0]), "+v"(voffN[1][1]));
#pragma unroll 1
        for (int t = 0; t < nt; t += 2) {
            const bool last = (t == nt - 2);
            const char* a1 = cA + (size_t)(t + 1) * kstep;
            const char* a2 = last ? nA : cA + (size_t)(t + 2) * kstep; const char* b2 = last ? nB : cB + (size_t)(t + 2) * kstep;
            const char* a3 = a2 + kstep; const char* b3 = b2 + kstep;
            unsigned v2[2][2];
#pragma unroll
            for (int h = 0; h < 2; ++h)
#pragma unroll
                for (int i = 0; i < 2; ++i) v2[h][i] = (Sched::GATHER && last) ? voffN[h][i] : voffA[h][i];
            PG8_LDB(B0, 0, 0); PG8_SCHED; PG8_LDA(At, 0, 0); PG8_STAGE(PG8_SA(1, 1), a1, voffA[1]);
            PG8_WAIT_L(8); PG8_BAR; PG8_WAIT_L(0); PG8_MMA(0, 0, At, B0); PG8_BAR; PG8_SCHED;
            PG8_LDB(B1, 0, 1); PG8_STAGE(PG8_SB(0, 0), b2, voffB);
            PG8_BAR; PG8_WAIT_L(0); PG8_MMA(0, 1, At, B1); PG8_BAR;
            PG8_LDA(At, 0, 1); PG8_STAGE(PG8_SA(0, 0), a2, v2[0]);
            PG8_BAR; PG8_WAIT_L(0); PG8_MMA(1, 0, At, B0); PG8_BAR; PG8_SCHED;
            PG8_STAGE(PG8_SB(0, 1), b2 + hstepB, voffB);
            PG8_WAIT_V(6); PG8_BAR; PG8_MMA(1, 1, At, B1); PG8_BAR;
            PG8_LDB(B0, 1, 0); PG8_SCHED; PG8_LDA(At, 1, 0); PG8_STAGE(PG8_SA(0, 1), a2, v2[1]);
            PG8_WAIT_L(8); PG8_BAR; PG8_WAIT_L(0); PG8_MMA(0, 0, At, B0); PG8_BAR; PG8_SCHED;
            PG8_LDB(B1, 1, 1); PG8_STAGE(PG8_SB(1, 0), b3, voffB);
            PG8_BAR; PG8_WAIT_L(0); PG8_MMA(0, 1, At, B1); PG8_BAR;
            PG8_LDA(At, 1, 1); PG8_STAGE(PG8_SA(1, 0), a3, v2[0]);
            PG8_BAR; PG8_WAIT_L(0); PG8_MMA(1, 0, At, B0); PG8_BAR; PG8_SCHED;
            PG8_STAGE(PG8_SB(1, 1), b3 + hstepB, voffB);
            PG8_WAIT_V(6); PG8_BAR; PG8_MMA(1, 1, At, B1); PG8_BAR;
        }
        if (F8) asm volatile("s_nop 15\n\ts_nop 15" ::: "memory");
        const bool keep = E(acc, cur, wr, wc, fr, fq);
        if (!has_next) break;
        if (!keep) {
#pragma unroll
        for (int a = 0; a < 2; ++a)
#pragma unroll
            for (int b = 0; b < 2; ++b)
#pragma unroll
                for (int m = 0; m < 4; ++m)
#pragma unroll
                    for (int n = 0; n < 2; ++n) acc[a][b][m][n] = (f32x4){0.f, 0.f, 0.f, 0.f}; }
        cur = nxt; cA = nA; cB = nB; ++ui;
        if (Sched::GATHER) {
#pragma unroll
        for (int h = 0; h < 2; ++h)
#pragma unroll
            for (int i = 0; i < 2; ++i) voffA[h][i] = voffN[h][i]; }
    }
    PG8_WAIT_V(0);
    if (wr == 0) PG8_BAR;
    PG8_BAR;
#undef PG8_SA
#undef PG8_SB
#undef PG8_STAGE
#undef PG8_LDA
#undef PG8_LDB
#undef PG8_MMA
#undef PG8_WAIT_V
#undef PG8_WAIT_L
#undef PG8_BAR
#undef PG8_SCHED
#undef PG8_SETOFF
}
}


namespace fa {
typedef short bf16x8 __attribute__((ext_vector_type(8)));
typedef short s16x4 __attribute__((ext_vector_type(4)));
typedef float f32x16 __attribute__((ext_vector_type(16)));
constexpr int D = 128, NW = 8, QBLK = 32, KVBLK = 64, QB = NW * QBLK, QS = DM;
constexpr int SHM_V = KVBLK * D * 2, SHM_K = KVBLK * D * 2;
constexpr int OFF_WS = 2 * SHM_V + 2 * SHM_K, OFF_BIAS = OFF_WS + NW * 64 * 4, LDS_BYTES = OFF_BIAS + 2 * 256 + 16;
constexpr float SCALE = ATT_SCALE, THR = 8.f;
#define KSWZ(row, colB) ((row) * 256 + ((colB) ^ (((row) & 7) << 4)))
#define SBAR() __builtin_amdgcn_sched_barrier(0)
__device__ __forceinline__ int v_st(int k, int c) { const int kk = (k & ~0xC) | ((k & 4) << 1) | ((k & 8) >> 1); return ((kk >> 3) * 4 + (c >> 5)) * 512 + ((kk & 7) * 32 + (c & 31)) * 2; }
__device__ __forceinline__ int v_rd_base(int lane) { return ((lane & 3) << 3) | (((lane >> 2) & 3) << 6) | (((lane >> 4) & 1) << 5) | (((lane >> 5) & 1) << 8); }
constexpr int v_rd_off(int d0, int ks, int half) { return d0 * 512 + ks * 4096 + half * 2048; }
__device__ __forceinline__ int crow(int r, int hi) { return (r & 3) + 8 * (r >> 2) + 4 * hi; }
__device__ __forceinline__ bf16x8 load8(const bf16_t* p) { return *reinterpret_cast<const bf16x8*>(p); }
__device__ __forceinline__ void mask_tile(f32x16& p0, f32x16& p1, int dq, unsigned W) {
    const float NEG = -__builtin_inff();
#pragma unroll
    for (int r = 0; r < 16; ++r) { const int c = (r & 3) + 8 * (r >> 2);
        if ((unsigned)(dq - c) >= W) p0[r] = NEG;
        if ((unsigned)(dq - c - 32) >= W) p1[r] = NEG; }
}
__device__ __forceinline__ void partialSM(f32x16& p0, f32x16& p1, float& m_reg, float& mn, float& alpha) {
    float pmax = p0[0];
#pragma unroll
    for (int r = 1; r < 16; ++r) pmax = fmaxf(pmax, p0[r]);
#pragma unroll
    for (int r = 0; r < 16; ++r) pmax = fmaxf(pmax, p1[r]);
    { auto rr = __builtin_amdgcn_permlane32_swap(__float_as_uint(pmax), __float_as_uint(pmax), false, false);
      pmax = fmaxf(__uint_as_float(rr[0]), __uint_as_float(rr[1])); }
    constexpr float C2 = 1.4426950408889634f * SCALE;
    if (__builtin_expect(__all((pmax - m_reg) * SCALE <= THR), 1)) { mn = m_reg; alpha = 1.f; }
    else { mn = fmaxf(m_reg, pmax); alpha = __builtin_amdgcn_exp2f((m_reg - mn) * C2); m_reg = mn; }
    const float mnL = -mn * C2;
#pragma unroll
    for (int r = 0; r < 16; ++r) p0[r] = fmaf(p0[r], C2, mnL);
#pragma unroll
    for (int r = 0; r < 16; ++r) p1[r] = fmaf(p1[r], C2, mnL);
#pragma unroll
    for (int r = 0; r < 16; ++r) p0[r] = __builtin_amdgcn_exp2f(p0[r]);
}
__device__ __forceinline__ void finishSM(f32x16& p0, f32x16& p1, float alpha, float& l_reg, bf16x8& pa0, bf16x8& pa1, bf16x8& pa2, bf16x8& pa3) {
#pragma unroll
    for (int r = 0; r < 16; ++r) p1[r] = __builtin_amdgcn_exp2f(p1[r]);
    float ps = 0;
#pragma unroll
    for (int r = 0; r < 16; ++r) ps += p0[r];
#pragma unroll
    for (int r = 0; r < 16; ++r) ps += p1[r];
    { auto rr = __builtin_amdgcn_permlane32_swap(__float_as_uint(ps), __float_as_uint(ps), false, false);
      ps = __uint_as_float(rr[0]) + __uint_as_float(rr[1]); }
    l_reg = l_reg * alpha + ps;
#define PK4(P, B_, OUT) do { unsigned a0 = cvt_pk_bf16(P[B_+0], P[B_+1]), a1 = cvt_pk_bf16(P[B_+2], P[B_+3]);                          \
        unsigned b0 = cvt_pk_bf16(P[B_+4], P[B_+5]), b1 = cvt_pk_bf16(P[B_+6], P[B_+7]);                                             \
        auto r0 = __builtin_amdgcn_permlane32_swap(a0, b0, false, false); auto r1 = __builtin_amdgcn_permlane32_swap(a1, b1, false, false); \
        u32x4 w = {r0[0], r1[0], r0[1], r1[1]}; OUT = *reinterpret_cast<bf16x8*>(&w); } while (0)
    PK4(p0, 0, pa0); PK4(p0, 8, pa1); PK4(p1, 0, pa2); PK4(p1, 8, pa3);
#undef PK4
}
template <int KB>
__device__ __forceinline__ void qkt(f32x16& p0, f32x16& p1, const char* K_lds, const char* B_lds, int r32, int hi, const bf16x8* qr) {
    { const f32x4* bb = reinterpret_cast<const f32x4*>(B_lds + KB * 256 + hi * 16);
      const f32x4 a0 = bb[0], a1 = bb[2], a2 = bb[4], a3 = bb[6], c0 = bb[8], c1 = bb[10], c2 = bb[12], c3 = bb[14];
      p0 = (f32x16){a0[0], a0[1], a0[2], a0[3], a1[0], a1[1], a1[2], a1[3], a2[0], a2[1], a2[2], a2[3], a3[0], a3[1], a3[2], a3[3]};
      p1 = (f32x16){c0[0], c0[1], c0[2], c0[3], c1[0], c1[1], c1[2], c1[3], c2[0], c2[1], c2[2], c2[3], c3[0], c3[1], c3[2], c3[3]}; }
    const char* kb[4];
#pragma unroll
    for (int dd = 0; dd < 4; ++dd) kb[dd] = K_lds + KB * SHM_K + KSWZ(r32, (dd * 16 + hi * 8) * 2);
#pragma unroll
    for (int d0 = 0; d0 < 8; ++d0) { const char* a = kb[d0 & 3] + (d0 >> 2) * 128;
        bf16x8 b0 = *reinterpret_cast<const bf16x8*>(a);
        bf16x8 b1 = *reinterpret_cast<const bf16x8*>(a + 32 * 256);
        p0 = __builtin_amdgcn_mfma_f32_32x32x16_bf16(b0, qr[d0], p0, 0, 0, 0);
        p1 = __builtin_amdgcn_mfma_f32_32x32x16_bf16(b1, qr[d0], p1, 0, 0, 0); }
}
template <int VB>
__device__ __forceinline__ void pv_tile(f32x16* o, int vb0, bf16x8 pa0, bf16x8 pa1, bf16x8 pa2, bf16x8 pa3) {
#define TRRD(dst, off) asm volatile("ds_read_b64_tr_b16 %0, %1 offset:%2" : "=&v"(dst) : "v"(vb0), "i"(off) : "memory")
#define PV_D0(d0) do { constexpr int b_ = VB * SHM_V + v_rd_off(d0, 0, 0); s16x4 l3, h3; \
        { s16x4 l0, l1, l2, h0, h1, h2; TRRD(l0, b_); TRRD(h0, b_ + 2048); TRRD(l1, b_ + 4096); TRRD(h1, b_ + 6144); TRRD(l2, b_ + 8192); TRRD(h2, b_ + 10240); \
          asm volatile("s_waitcnt lgkmcnt(0)" ::: "memory"); SBAR();   \
          TRRD(l3, b_ + 12288); TRRD(h3, b_ + 14336); SBAR();            \
          o[d0] = __builtin_amdgcn_mfma_f32_32x32x16_bf16(pa0, (bf16x8){l0[0], l0[1], l0[2], l0[3], h0[0], h0[1], h0[2], h0[3]}, o[d0], 0, 0, 0);   \
          o[d0] = __builtin_amdgcn_mfma_f32_32x32x16_bf16(pa1, (bf16x8){l1[0], l1[1], l1[2], l1[3], h1[0], h1[1], h1[2], h1[3]}, o[d0], 0, 0, 0);   \
          o[d0] = __builtin_amdgcn_mfma_f32_32x32x16_bf16(pa2, (bf16x8){l2[0], l2[1], l2[2], l2[3], h2[0], h2[1], h2[2], h2[3]}, o[d0], 0, 0, 0); }   \
        asm volatile("s_waitcnt lgkmcnt(0)" ::: "memory"); SBAR();   \
        o[d0] = __builtin_amdgcn_mfma_f32_32x32x16_bf16(pa3, (bf16x8){l3[0], l3[1], l3[2], l3[3], h3[0], h3[1], h3[2], h3[3]}, o[d0], 0, 0, 0); } while (0)
    PV_D0(0); PV_D0(1); PV_D0(2); PV_D0(3);
#undef PV_D0
#undef TRRD
}
struct BlockRef { const bf16_t* Q; const bf16_t* K; const bf16_t* V; const float* KBp; unsigned char* O  ; int P0, jlo; };
struct Seam { bf16x8 qr[8]; bf16x8 st_v0, st_v1, st_k0, st_k1; float sb; };
#define GLD16(base, boff) (*reinterpret_cast<const bf16x8*>((const char*)(base) + (boff)))
#define VMW() asm volatile("s_waitcnt vmcnt(0)" ::: "memory")
#define VMWN(n) asm volatile("s_waitcnt vmcnt(%0)" :: "i"(n) : "memory")
#define SLOAD_H(Kp, Vp, Bp, k0) do { const char* kq_ = (const char*)(Kp) + (size_t)(k0) * (D * 2); const char* vq_ = (const char*)(Vp) + (size_t)(k0) * (D * 2); \
                         S.st_v0 = GLD16(vq_, kvoff); S.st_v1 = GLD16(vq_ + 32 * D * 2, kvoff); S.st_k0 = GLD16(kq_, kvoff); S.st_k1 = GLD16(kq_ + 32 * D * 2, kvoff); \
                         S.sb = *reinterpret_cast<const float*>((const char*)(Bp) + (size_t)(k0) * 4 + lane4); } while (0)
#define SWRITE_HK(bf) do { *(bf16x8*)(K_lds + (bf) * SHM_K + kws) = S.st_k0; *(bf16x8*)(K_lds + (bf) * SHM_K + kws + 32 * 256) = S.st_k1; \
                           if (wid == 0) *(float*)(B_lds + (bf) * 256 + lane * 4) = S.sb; } while (0)
#define SWRITE_HV(bf) do { *(bf16x8*)(V_lds + (bf) * SHM_V + vst0) = S.st_v0; *(bf16x8*)(V_lds + (bf) * SHM_V + vst1) = S.st_v1; } while (0)
#define SWRITE_H(bf) do { SWRITE_HV(bf); SWRITE_HK(bf); } while (0)
__device__ __forceinline__ void prime(const BlockRef& cur, char* lds, Seam& S) {
    const int tid = tidx(), wid = __builtin_amdgcn_readfirstlane(tid >> 6), lane = tid & 63, r32 = lane & 31, hi = lane >> 5;
    const int sr = tid >> 4, sc = (tid & 15) * 8, kws = KSWZ(sr, sc * 2); char* K_lds = lds + 2 * SHM_V; char* B_lds = lds + OFF_BIAS;
    const unsigned kvoff = (unsigned)(sr * D + sc) * 2u, lane4 = (unsigned)lane * 4u, qoff = (unsigned)((wid * QBLK + r32) * QS + hi * 8) * 2u;
#pragma unroll
    for (int d0 = 0; d0 < 8; ++d0) S.qr[d0] = GLD16(cur.Q, qoff + d0 * 32);
    SLOAD_H(cur.K, cur.V, cur.KBp, cur.jlo * KVBLK); VMW(); SWRITE_HK(0);
    __syncthreads();
}
__device__ __forceinline__ void block(const BlockRef& cur, const BlockRef& nxt, char* lds, Seam& S) {
    const int tid = tidx(), wid = __builtin_amdgcn_readfirstlane(tid >> 6), lane = tid & 63, r32 = lane & 31, hi = lane >> 5;
    const int j_lo = cur.jlo, NT = (cur.P0 + QB - 1) / KVBLK + 1 - j_lo;
    const int tl = NT - 4 + (wid >> 1);
    const int qlo = cur.P0 + wid * QBLK, qm = qlo + r32 - 4 * hi;
    char* V_lds = lds; char* K_lds = lds + 2 * SHM_V; char* B_lds = lds + OFF_BIAS;
    float* ws = (float*)(lds + OFF_WS) + wid * 64; float* li_l = ws; float* al_l = ws + 32;
    float m_reg = -1e30f, l_reg = 0; f32x16 o[4] = {};
    const int sr = tid >> 4, sc = (tid & 15) * 8, vst0 = v_st(sr, sc), vst1 = v_st(32 + sr, sc), kws = KSWZ(sr, sc * 2);
    const unsigned kvoff = (unsigned)(sr * D + sc) * 2u, lane4 = (unsigned)lane * 4u, qoff = (unsigned)((wid * QBLK + r32) * QS + hi * 8) * 2u;
    const int vb0 = (int)(uintptr_t)V_lds + v_rd_base(lane);
    const bf16_t* Kh = cur.K; const bf16_t* Vh = cur.V; const float* Bh = cur.KBp;
#define RESC(a) do { if (__any((a) < 1.f)) { if (hi == 0) al_l[r32] = (a); asm volatile("s_waitcnt lgkmcnt(0)" ::: "memory");              \
                     for (int d_ = 0; d_ < 4; ++d_) for (int r = 0; r < 16; ++r) o[d_][r] *= al_l[crow(r, hi)]; } } while (0)
#define KBASE(t) ((j_lo + (t)) * KVBLK)
#define MASKT(P0_, P1_, t) do { const int kb_ = KBASE(t); if (kb_ + KVBLK - 1 > qlo) mask_tile(P0_, P1_, qm - kb_, 0x7fffffffu); } while (0)
    f32x16 pA0, pA1, pB0, pB1; float mnA, mnB, alA, alB; bf16x8 pa0, pa1, pa2, pa3;
    SWRITE_HV(0); SBAR();
    if (NT > 1) SLOAD_H(Kh, Vh, Bh, KBASE(1));
    SBAR(); qkt<0>(pA0, pA1, K_lds, B_lds, r32, hi, S.qr);
    MASKT(pA0, pA1, 0); partialSM(pA0, pA1, m_reg, mnA, alA);
    if (NT > 1) { VMW(); SWRITE_H(1); SBAR(); if (NT > 2) SLOAD_H(Kh, Vh, Bh, KBASE(2)); }
    __syncthreads();
#define HALF_STEP(PX0, PX1, mnX, alX, PY0, PY1, alY, t, KB, VB, SB) do {                                                      \
        const bool doX_ = (t) <= tl, doY_ = (t) - 1 <= tl;                       \
        SBAR(); if (doX_) qkt<KB>(PX0, PX1, K_lds, B_lds, r32, hi, S.qr);                                                     \
        if (doY_) finishSM(PY0, PY1, alY, l_reg, pa0, pa1, pa2, pa3); SBAR();                                                 \
        if (doY_) pv_tile<VB>(o, vb0, pa0, pa1, pa2, pa3);                                                                    \
        if (doX_) { MASKT(PX0, PX1, (t)); partialSM(PX0, PX1, m_reg, mnX, alX); } else alX = 1.f;                             \
        __syncthreads();                                                                                                      \
        if ((t) + 1 < NT) { VMW(); SWRITE_H(SB); SBAR(); if ((t) + 2 < NT) { SLOAD_H(Kh, Vh, Bh, KBASE((t) + 2)); SBAR(); } }   \
        RESC(alX); __syncthreads(); } while (0)
    for (int t = 1; t + 1 < NT; t += 2) {
        HALF_STEP(pB0, pB1, mnB, alB, pA0, pA1, alA, t, 1, 0, 0);
        HALF_STEP(pA0, pA1, mnA, alA, pB0, pB1, alB, t + 1, 0, 1, 1);
    }
    const bool even = (NT & 1) == 0;
    const bool doA = (even ? NT - 2 : NT - 1) <= tl, doB = even && (NT - 1 <= tl);
    if (doB) { SBAR(); qkt<1>(pB0, pB1, K_lds, B_lds, r32, hi, S.qr); SBAR(); }
    SLOAD_H(nxt.K, nxt.V, nxt.KBp, nxt.jlo * KVBLK); SBAR();
#pragma unroll
    for (int d0 = 0; d0 < 8; ++d0) S.qr[d0] = GLD16(nxt.Q, qoff + d0 * 32);
    SBAR();
    if (doA) { finishSM(pA0, pA1, alA, l_reg, pa0, pa1, pa2, pa3); SBAR();
        pv_tile<0>(o, vb0, pa0, pa1, pa2, pa3); }
    if (even) { if (doB) { MASKT(pB0, pB1, NT - 1); partialSM(pB0, pB1, m_reg, mnB, alB); } else alB = 1.f;
        __syncthreads(); RESC(alB);
        if (doB) { finishSM(pB0, pB1, alB, l_reg, pa0, pa1, pa2, pa3); SBAR(); pv_tile<1>(o, vb0, pa0, pa1, pa2, pa3); } }
    SBAR(); VMWN(8); SWRITE_HK(0); SBAR();
    if (hi == 0) li_l[r32] = l_reg; asm volatile("s_waitcnt lgkmcnt(0)" ::: "memory");
    float rli[16];
#pragma unroll
    for (int r = 0; r < 16; ++r) rli[r] = __builtin_amdgcn_rcpf(li_l[crow(r, hi)]);
    unsigned char* Ow = cur.O; const unsigned ooff = (unsigned)((wid * QBLK + 4 * hi) * QS + r32);
#pragma unroll
    for (int r = 0; r < 16; ++r) { const int orow = (r & 3) + 8 * (r >> 2);
#pragma unroll
        for (int d0 = 0; d0 < 4; ++d0) { const float v = o[d0][r] * rli[r]; const float v1 = dpp_xor1(v), v2 = dpp_xor2(v), v3 = DPPF(v, 0x1B, 0xF, false);
            if ((r32 & 3) == 0) *(unsigned*)(Ow + (size_t)(orow * QS + d0 * 32) + ooff) = pack4_fp8(v, v1, v2, v3); } }
    __syncthreads();
#undef RESC
#undef KBASE
#undef MASKT
#undef HALF_STEP
}
#undef GLD16
#undef VMW
#undef VMWN
#undef SLOAD_H
#undef SWRITE_HK
#undef SWRITE_HV
#undef SWRITE_H
__device__ __forceinline__ BlockRef ref(const Ctx& c, int bh, int qb, float thr, int lane) {
    unsigned char* ws = wsl(c); const int b = bh >> 3, h = bh & 7; BlockRef r;
    const size_t qo = ((size_t)(b * SEQ + qb * QB)) * QS + h * DH;
    r.Q = (const bf16_t*)(ws + WS_FQ) + qo; r.O = ws + WS_OB + qo;
    r.K = (const bf16_t*)(ws + WS_FK) + (size_t)bh * SEQ * DH; r.V = (const bf16_t*)(ws + WS_FV) + (size_t)bh * SEQ * DH;
    r.KBp = (const float*)(ws + WS_KBIAS) + (size_t)bh * SEQ; r.P0 = qb * QB;
    const int nbefore = r.P0 / KVBLK; const float kq = r.KBp[r.P0];
    const bool k0 = (lane >= nbefore) || ((kq - r.KBp[64 * lane + 63]) * (1.f / SQRT_DH) <= thr);
    const bool k1 = (64 + lane >= nbefore) || ((kq - r.KBp[64 * (64 + lane) + 63]) * (1.f / SQRT_DH) <= thr);
    const unsigned long long m0 = __ballot(k0), m1 = __ballot(k1);
    r.jlo = __builtin_amdgcn_readfirstlane(m0 ? (int)__builtin_ctzll(m0) : 64 + (int)__builtin_ctzll(m1));
    return r;
}
constexpr int CW_ATTQ = 2048;
__device__ __forceinline__ void phase(const Ctx& c, int layer, char* lds, int qid = -1) {
    constexpr int NQB = SEQ / QB, TOTAL = NQB * NB * NH;
    const int tid = tidx(), lane = tid & 63;
    unsigned* qhead = (unsigned*)(wsl(c) + WS_CTL) + CW_ATTQ + (qid < 0 ? layer : qid) * 64;
    volatile int* qslot = (volatile int*)(lds + OFF_BIAS + 512);
    float thr;
    { const float* gq = c.in[I_GQ] + layer * DH; const float* gk = c.in[I_GK] + layer * DH;
      float mq = fmaxf(fabsf(gq[lane]), fabsf(gq[lane + 64])), mk = fmaxf(fabsf(gk[lane]), fabsf(gk[lane + 64]));
#pragma unroll
      for (int o = 1; o < 64; o <<= 1) { mq = fmaxf(mq, bperm(mq, lane ^ o)); mk = fmaxf(mk, bperm(mk, lane ^ o)); }
      thr = 2.f * SQRT_DH * mq * mk + 17.f; thr = __builtin_bit_cast(float, __builtin_amdgcn_readfirstlane(__builtin_bit_cast(int, thr))); }
    if (tid == 0) { qslot[0] = (int)__hip_atomic_fetch_add(qhead, 1u, __ATOMIC_RELAXED, __HIP_MEMORY_SCOPE_AGENT); qslot[1] = (int)__hip_atomic_fetch_add(qhead, 1u, __ATOMIC_RELAXED, __HIP_MEMORY_SCOPE_AGENT); }
    __syncthreads();
    int ic = __builtin_amdgcn_readfirstlane(qslot[0]), in_ = __builtin_amdgcn_readfirstlane(qslot[1]), par = 0;
    if (ic >= TOTAL) return;
#define ITEM_REF(i) ref(c, (i) & 31, NQB - 1 - ((i) >> 5), thr, lane)
    BlockRef cur = ITEM_REF(ic);
    Seam S;
    prime(cur, lds, S);
    for (;;) {
        const bool last = in_ >= TOTAL;
        if (tid == 0 && !last) qslot[par] = (int)__hip_atomic_fetch_add(qhead, 1u, __ATOMIC_RELAXED, __HIP_MEMORY_SCOPE_AGENT);
        const BlockRef nxt = last ? cur : ITEM_REF(in_);
        block(cur, nxt, lds, S);
        if (last) break;
        cur = nxt; in_ = __builtin_amdgcn_readfirstlane(qslot[par]); par ^= 1;
    }
#undef ITEM_REF
}
#undef KSWZ
#undef SBAR
}


namespace hg {
typedef short bf16x8 __attribute__((ext_vector_type(8)));
typedef short s16x4 __attribute__((ext_vector_type(4)));
typedef float f32x16 __attribute__((ext_vector_type(16)));
constexpr int C = 64, NCH = SEQ / C, NUNIT = NB * NH * NCH;
constexpr size_t US_BYTES = (size_t)128 * 128 * 2;
constexpr size_t WS_US_LO = WS_USLO, WS_US_HI = 968 * MiB, WS_G = 1032 * MiB, WS_HG_END = 1034 * MiB;
__device__ __forceinline__ bf16_t* us_tile(unsigned char* ws, int unit) { return (bf16_t*)(ws + (unit < NUNIT / 2 ? WS_US_LO + (size_t)unit * US_BYTES : WS_US_HI + (size_t)(unit - NUNIT / 2) * US_BYTES)); }
#define KSWZ(row, colB) ((row) * 256 + ((colB) ^ (((row) & 7) << 4)))
__device__ __forceinline__ int v_st(int k, int c) { const int kk = (k & ~0xC) | ((k & 4) << 1) | ((k & 8) >> 1); return ((kk >> 3) * 4 + (c >> 5)) * 512 + ((kk & 7) * 32 + (c & 31)) * 2; }
__device__ __forceinline__ int v_rd_base(int lane) { return ((lane & 3) << 3) | (((lane >> 2) & 3) << 6) | (((lane >> 4) & 1) << 5) | (((lane >> 5) & 1) << 8); }
__device__ __forceinline__ int crow(int r, int hi) { return (r & 3) + 8 * (r >> 2) + 4 * hi; }
#define LBAR() do { asm volatile("s_waitcnt lgkmcnt(0)" ::: "memory"); __builtin_amdgcn_s_barrier(); asm volatile("" ::: "memory"); } while (0)
#define TRRD(dst, addr, off) asm volatile("ds_read_b64_tr_b16 %0, %1 offset:%2" : "=&v"(dst) : "v"(addr), "i"(off) : "memory")
#define FRAG4(F0, F1, F2, F3, vaddr, d0) do { s16x4 l0, l1, l2, l3, h0, h1, h2, h3; constexpr int b_ = (d0) * 512; \
        TRRD(l0, vaddr, b_); TRRD(h0, vaddr, b_ + 2048); TRRD(l1, vaddr, b_ + 4096); TRRD(h1, vaddr, b_ + 6144); TRRD(l2, vaddr, b_ + 8192); TRRD(h2, vaddr, b_ + 10240); TRRD(l3, vaddr, b_ + 12288); TRRD(h3, vaddr, b_ + 14336); \
        asm volatile("s_waitcnt lgkmcnt(0)" ::: "memory"); __builtin_amdgcn_sched_barrier(0); \
        F0 = (bf16x8){l0[0], l0[1], l0[2], l0[3], h0[0], h0[1], h0[2], h0[3]}; F1 = (bf16x8){l1[0], l1[1], l1[2], l1[3], h1[0], h1[1], h1[2], h1[3]}; \
        F2 = (bf16x8){l2[0], l2[1], l2[2], l2[3], h2[0], h2[1], h2[2], h2[3]}; F3 = (bf16x8){l3[0], l3[1], l3[2], l3[3], h3[0], h3[1], h3[2], h3[3]}; } while (0)
struct Strip { float cum[8][2]; float tot[2]; };
__device__ __forceinline__ void strip_load(const bf16_t* lf_chunk  , int kp, int rg, unsigned (&lr)[8]) {
#pragma unroll
    for (int i = 0; i < 8; ++i) lr[i] = *reinterpret_cast<const unsigned*>(lf_chunk + (size_t)(8 * rg + i) * DM + 2 * kp);
}
__device__ __forceinline__ void strip_unpack(const unsigned (&lr)[8], float (&l)[8][2]) {
#pragma unroll
    for (int i = 0; i < 8; ++i) unpack_f16x2(lr[i], l[i][0], l[i][1]);
}
__device__ __forceinline__ void strip_scan(int lane, const float (&l)[8][2], Strip& st) {
    float run0 = 0.f, run1 = 0.f;
#pragma unroll
    for (int i = 0; i < 8; ++i) { run0 += l[i][0]; run1 += l[i][1]; st.cum[i][0] = run0; st.cum[i][1] = run1; }
    float in0 = run0, in1 = run1;
#pragma unroll
    for (int o = 1; o < 8; o <<= 1) { const float a = dpp_shr(in0, o), b = dpp_shr(in1, o); if ((lane & 7) >= o) { in0 += a; in1 += b; } }
    const float ex0 = in0 - run0, ex1 = in1 - run1;
#pragma unroll
    for (int i = 0; i < 8; ++i) { st.cum[i][0] += ex0; st.cum[i][1] += ex1; }
    st.tot[0] = bperm(in0, (lane & ~7) | 7); st.tot[1] = bperm(in1, (lane & ~7) | 7);
}
constexpr int A_TK = 0, A_TV = 16384, A_LDS = 32768;
__device__ __forceinline__ void pass_a(const Ctx& c, char* lds) {
    const int tid = tidx(), wid = __builtin_amdgcn_readfirstlane(tid >> 6), lane = tid & 63, r32 = lane & 31, hi = lane >> 5;
    const int kp = tid >> 3, rg = tid & 7, sr = tid >> 4, sc = (tid & 15) * 8;
    unsigned char* ws = wsl(c); const bf16_t* LF = (const bf16_t*)(ws + WS_LF); const unsigned char* VA = ws + WS_VA; float* G = (float*)(ws + WS_G);
    const int vaddr_k = (int)(uintptr_t)(lds + A_TK) + v_rd_base(lane), vaddr_v = (int)(uintptr_t)(lds + A_TV) + v_rd_base(lane);
    unsigned lr[8]; u32x2 pv0, pv1;
#define V8_TO_BF16(r) (bf16x8)__builtin_bit_cast(bf16x8, (u32x4){cvt_pk_bf16(unpack4_fp8((r).x)[0], unpack4_fp8((r).x)[1]), cvt_pk_bf16(unpack4_fp8((r).x)[2], unpack4_fp8((r).x)[3]), cvt_pk_bf16(unpack4_fp8((r).y)[0], unpack4_fp8((r).y)[1]), cvt_pk_bf16(unpack4_fp8((r).y)[2], unpack4_fp8((r).y)[3])})
#define A_LOAD(u) do { const int bh_ = (u) >> 7, ch_ = (u) & (NCH - 1); const size_t r0_ = (size_t)((bh_ >> 3) * SEQ + ch_ * C); const int h_ = bh_ & 7; \
        strip_load(LF + r0_ * DM + h_ * DH, kp, rg, lr); const unsigned char* vp_ = VA + (r0_ + sr) * DM + h_ * DH + sc; pv0 = *(const u32x2*)vp_; pv1 = *(const u32x2*)(vp_ + (size_t)32 * DM); } while (0)
    int unit = bidx(); if (unit < NUNIT) A_LOAD(unit);
    for (; unit < NUNIT; unit += gridDim.x) {
        float l[8][2]; strip_unpack(lr, l); Strip st; strip_scan(lane, l, st);
#pragma unroll
        for (int i = 0; i < 8; ++i) { const float k0 = (1.f - __expf(l[i][0])) * __expf(st.tot[0] - st.cum[i][0]), k1 = (1.f - __expf(l[i][1])) * __expf(st.tot[1] - st.cum[i][1]);
            *(unsigned*)(lds + A_TK + v_st(8 * rg + i, 2 * kp)) = cvt_pk_bf16(k0, k1); }
        if (rg == 7) *reinterpret_cast<float2*>(G + (size_t)unit * DH + 2 * kp) = make_float2(__expf(st.tot[0]), __expf(st.tot[1]));
        *(bf16x8*)(lds + A_TV + v_st(sr, sc)) = V8_TO_BF16(pv0); *(bf16x8*)(lds + A_TV + v_st(32 + sr, sc)) = V8_TO_BF16(pv1);
        if (unit + (int)gridDim.x < NUNIT) A_LOAD(unit + (int)gridDim.x);
        LBAR();
        const int kb = wid >> 1; bf16x8 a0, a1, a2, a3;
        if (kb == 0) FRAG4(a0, a1, a2, a3, vaddr_k, 0); else if (kb == 1) FRAG4(a0, a1, a2, a3, vaddr_k, 1); else if (kb == 2) FRAG4(a0, a1, a2, a3, vaddr_k, 2); else FRAG4(a0, a1, a2, a3, vaddr_k, 3);
        bf16_t* U = us_tile(ws, unit);
#pragma unroll
        for (int j = 0; j < 2; ++j) { bf16x8 b0, b1, b2, b3; const int vb = 2 * (wid & 1) + j;
            if (wid & 1) { if (j == 0) FRAG4(b0, b1, b2, b3, vaddr_v, 2); else FRAG4(b0, b1, b2, b3, vaddr_v, 3); } else { if (j == 0) FRAG4(b0, b1, b2, b3, vaddr_v, 0); else FRAG4(b0, b1, b2, b3, vaddr_v, 1); }
            f32x16 acc = {};
            acc = __builtin_amdgcn_mfma_f32_32x32x16_bf16(a0, b0, acc, 0, 0, 0); acc = __builtin_amdgcn_mfma_f32_32x32x16_bf16(a1, b1, acc, 0, 0, 0);
            acc = __builtin_amdgcn_mfma_f32_32x32x16_bf16(a2, b2, acc, 0, 0, 0); acc = __builtin_amdgcn_mfma_f32_32x32x16_bf16(a3, b3, acc, 0, 0, 0);
#pragma unroll
            for (int r = 0; r < 16; ++r) { const float v = acc[r], vn = dpp_xor1(v);
                if ((r32 & 1) == 0) *(unsigned*)(U + (size_t)(32 * kb + crow(r, hi)) * DH + 32 * vb + r32) = cvt_pk_bf16(v, vn); } }
        LBAR();
    }
}
__device__ __forceinline__ void pass_b(const Ctx& c) {
    unsigned char* ws = wsl(c); const float* G = (const float*)(ws + WS_G);
    const int tid = tidx();
    for (int job = bidx(); job < NB * NH * 4; job += gridDim.x) { const int bh = job >> 2, q = job & 3;
        const int e = (q * NTHR + tid) * 8, k = e >> 7, v = e & 127;
        float s[8];
#pragma unroll
        for (int i = 0; i < 8; ++i) s[i] = 0.f;
#define PB_LOAD(U, Gv, c0_) do { _Pragma("unroll") for (int j = 0; j < 8; ++j) { const int unit = bh * NCH + (c0_) + j; U[j] = *(const u32x4*)(us_tile(ws, unit) + k * DH + v); Gv[j] = G[(size_t)unit * DH + k]; } \
        __builtin_amdgcn_sched_barrier(0); } while (0)
#define PB_SCAN(U, Gv, c0_) do { _Pragma("unroll") for (int j = 0; j < 8; ++j) { const int unit = bh * NCH + (c0_) + j;                                              \
            u32x4 o; o.x = cvt_pk_bf16(s[0], s[1]); o.y = cvt_pk_bf16(s[2], s[3]); o.z = cvt_pk_bf16(s[4], s[5]); o.w = cvt_pk_bf16(s[6], s[7]);                 \
            *(u32x4*)(us_tile(ws, unit) + k * DH + v) = o;                                                                                                         \
            s[0] = Gv[j] * s[0] + __uint_as_float(U[j].x << 16); s[1] = Gv[j] * s[1] + __uint_as_float(U[j].x & 0xffff0000u); s[2] = Gv[j] * s[2] + __uint_as_float(U[j].y << 16); s[3] = Gv[j] * s[3] + __uint_as_float(U[j].y & 0xffff0000u); \
            s[4] = Gv[j] * s[4] + __uint_as_float(U[j].z << 16); s[5] = Gv[j] * s[5] + __uint_as_float(U[j].z & 0xffff0000u); s[6] = Gv[j] * s[6] + __uint_as_float(U[j].w << 16); s[7] = Gv[j] * s[7] + __uint_as_float(U[j].w & 0xffff0000u); } \
        __builtin_amdgcn_sched_barrier(0); } while (0)
        static_assert(NCH % 16 == 0, "pass_b: two batches per step");
        u32x4 ua[8], ub[8]; float ga[8], gb[8];
        PB_LOAD(ua, ga, 0);
#pragma unroll 1
        for (int c0 = 0; c0 < NCH; c0 += 16) {
            PB_LOAD(ub, gb, c0 + 8);
            PB_SCAN(ua, ga, c0);
            if (c0 + 16 < NCH) PB_LOAD(ua, ga, c0 + 16);
            PB_SCAN(ub, gb, c0 + 8);
        }
#undef PB_LOAD
#undef PB_SCAN
    }
}
constexpr int C_TQ = 0, C_TKD = 16384, C_TV = 32768, C_TS = 49152, C_ER = 81920, C_PS = 82432, C_LDS = 83456;
__device__ __forceinline__ void pass_c(const Ctx& c, int layer, char* lds, bool dummy = false) {
    const int tid = tidx(), wid = __builtin_amdgcn_readfirstlane(tid >> 6), lane = tid & 63, r32 = lane & 31, hi = lane >> 5;
    const int kp = tid >> 3, rg = tid & 7, sr = tid >> 4, sc = (tid & 15) * 8, rh = wid >> 2, vq = wid & 3;
    unsigned char* ws = wsl(c); const bf16_t* LF = (const bf16_t*)(ws + WS_LF); const unsigned char* VA = ws + WS_VA; const unsigned char* QA = ws + WS_QA; const unsigned char* GA = ws + WS_GA; unsigned char* OA = ws + WS_OA;
    const int vaddr_v = (int)(uintptr_t)(lds + C_TV) + v_rd_base(lane), vaddr_s0 = (int)(uintptr_t)(lds + C_TS) + v_rd_base(lane), vaddr_s1 = vaddr_s0 + 16384;
    float* ER = (float*)(lds + C_ER); float* PS = (float*)(lds + C_PS);
    const float gain = c.in[I_HGN][layer * DH + 32 * vq + r32];
    unsigned lr[8]; unsigned short qraw[8]; u32x2 pv0, pv1; u32x4 sraw[4]; unsigned char garaw[16];
#define C_LOAD(u) do { const int bh_ = (u) >> 7, ch_ = (u) & (NCH - 1); const size_t r0_ = (size_t)((bh_ >> 3) * SEQ + ch_ * C); const int h_ = bh_ & 7; \
        strip_load(LF + r0_ * DM + h_ * DH, kp, rg, lr); \
        _Pragma("unroll") for (int i_ = 0; i_ < 8; ++i_) qraw[i_] = *(const unsigned short*)(QA + (r0_ + 8 * rg + i_) * DM + h_ * DH + 2 * kp); \
        const unsigned char* vp_ = VA + (r0_ + sr) * DM + h_ * DH + sc; pv0 = *(const u32x2*)vp_; pv1 = *(const u32x2*)(vp_ + (size_t)32 * DM); \
        const bf16_t* Sg_ = us_tile(ws, (u)); _Pragma("unroll") for (int j_ = 0; j_ < 4; ++j_) sraw[j_] = *(const u32x4*)(Sg_ + (size_t)(sr + 32 * j_) * DH + sc); } while (0)
    int unit = bidx(); if (unit < NUNIT) C_LOAD(unit);
    for (; unit < NUNIT; unit += gridDim.x) {
        const int bh = unit >> 7, ch = unit & (NCH - 1), b = bh >> 3, h = bh & 7; const size_t row0 = (size_t)(b * SEQ + ch * C);
        float l[8][2]; strip_unpack(lr, l); Strip st; strip_scan(lane, l, st);
        const float ref0 = bperm(st.cum[7][0], (lane & ~7) | 3), ref1 = bperm(st.cum[7][1], (lane & ~7) | 3);
#pragma unroll
        for (int i = 0; i < 8; ++i) { const int row = 8 * rg + i;
            const f32v2u_t qf = __builtin_amdgcn_cvt_pk_f32_fp8((int)qraw[i], false); const float q0 = qf[0], q1 = qf[1];
            const float d0 = st.cum[i][0] - ref0, d1 = st.cum[i][1] - ref1;
            *(unsigned*)(lds + C_TQ + KSWZ(row, 4 * kp)) = cvt_pk_bf16(q0 * __expf(d0), q1 * __expf(d1));
            *(unsigned*)(lds + C_TKD + KSWZ(row, 4 * kp)) = cvt_pk_bf16((1.f - __expf(l[i][0])) * __expf(-d0), (1.f - __expf(l[i][1])) * __expf(-d1)); }
        if (rg == 0) { ER[2 * kp] = __expf(ref0); ER[2 * kp + 1] = __expf(ref1); }
        *(bf16x8*)(lds + C_TV + v_st(sr, sc)) = V8_TO_BF16(pv0); *(bf16x8*)(lds + C_TV + v_st(32 + sr, sc)) = V8_TO_BF16(pv1);
        LBAR();
#pragma unroll
        for (int j = 0; j < 4; ++j) { const int k = sr + 32 * j; const float e = ER[k]; const u32x4 x = sraw[j]; u32x4 o;
            o.x = cvt_pk_bf16(__uint_as_float(x.x << 16) * e, __uint_as_float(x.x & 0xffff0000u) * e); o.y = cvt_pk_bf16(__uint_as_float(x.y << 16) * e, __uint_as_float(x.y & 0xffff0000u) * e);
            o.z = cvt_pk_bf16(__uint_as_float(x.z << 16) * e, __uint_as_float(x.z & 0xffff0000u) * e); o.w = cvt_pk_bf16(__uint_as_float(x.w << 16) * e, __uint_as_float(x.w & 0xffff0000u) * e);
            *(u32x4*)(lds + C_TS + (k >> 6) * 16384 + v_st(k & 63, sc)) = o; }
        if (unit + (int)gridDim.x < NUNIT) C_LOAD(unit + (int)gridDim.x);
        LBAR();
        bf16x8 qr[8];
#pragma unroll
        for (int d0 = 0; d0 < 8; ++d0) qr[d0] = *(const bf16x8*)(lds + C_TQ + KSWZ(32 * rh + r32, (d0 * 16 + hi * 8) * 2));
        f32x16 p0 = {}, p1 = {};
#pragma unroll
        for (int d0 = 0; d0 < 8; ++d0) { const bf16x8 k0 = *(const bf16x8*)(lds + C_TKD + KSWZ(r32, (d0 * 16 + hi * 8) * 2)), k1 = *(const bf16x8*)(lds + C_TKD + KSWZ(32 + r32, (d0 * 16 + hi * 8) * 2));
            p0 = __builtin_amdgcn_mfma_f32_32x32x16_bf16(k0, qr[d0], p0, 0, 0, 0); p1 = __builtin_amdgcn_mfma_f32_32x32x16_bf16(k1, qr[d0], p1, 0, 0, 0); }
        { const int t = 32 * rh + r32;
#pragma unroll
          for (int r = 0; r < 16; ++r) { const int key = crow(r, hi); if (key > t) p0[r] = 0.f; if (key + 32 > t) p1[r] = 0.f; } }
        bf16x8 pa0, pa1, pa2, pa3;
#define PK4(P, B_, OUT) do { unsigned a0 = cvt_pk_bf16(P[B_+0], P[B_+1]), a1 = cvt_pk_bf16(P[B_+2], P[B_+3]);                          \
        unsigned b0 = cvt_pk_bf16(P[B_+4], P[B_+5]), b1 = cvt_pk_bf16(P[B_+6], P[B_+7]);                                             \
        auto r0 = __builtin_amdgcn_permlane32_swap(a0, b0, false, false); auto r1 = __builtin_amdgcn_permlane32_swap(a1, b1, false, false); \
        u32x4 w = {r0[0], r1[0], r0[1], r1[1]}; OUT = *reinterpret_cast<bf16x8*>(&w); } while (0)
        PK4(p0, 0, pa0); PK4(p0, 8, pa1); PK4(p1, 0, pa2); PK4(p1, 8, pa3);
#undef PK4
        f32x16 o = {};
#define ACC_TILE(vaddr, A0, A1, A2, A3) do { bf16x8 b0, b1, b2, b3; \
        if (vq == 0) FRAG4(b0, b1, b2, b3, vaddr, 0); else if (vq == 1) FRAG4(b0, b1, b2, b3, vaddr, 1); else if (vq == 2) FRAG4(b0, b1, b2, b3, vaddr, 2); else FRAG4(b0, b1, b2, b3, vaddr, 3); \
        o = __builtin_amdgcn_mfma_f32_32x32x16_bf16(A0, b0, o, 0, 0, 0); o = __builtin_amdgcn_mfma_f32_32x32x16_bf16(A1, b1, o, 0, 0, 0); \
        o = __builtin_amdgcn_mfma_f32_32x32x16_bf16(A2, b2, o, 0, 0, 0); o = __builtin_amdgcn_mfma_f32_32x32x16_bf16(A3, b3, o, 0, 0, 0); } while (0)
        ACC_TILE(vaddr_v, pa0, pa1, pa2, pa3);
        ACC_TILE(vaddr_s0, qr[0], qr[1], qr[2], qr[3]);
        ACC_TILE(vaddr_s1, qr[4], qr[5], qr[6], qr[7]);
#undef ACC_TILE
#pragma unroll
        for (int r = 0; r < 16; ++r) garaw[r] = GA[(row0 + 32 * rh + crow(r, hi)) * DM + h * DH + 32 * vq + r32];
#pragma unroll
        for (int r = 0; r < 16; ++r) { float ss = o[r] * o[r];
            ss = row_sum16(ss); ss += DPPF(ss, 0x142, 0xA, false);
            if (r32 == 31) PS[(32 * rh + crow(r, hi)) * 4 + vq] = ss; }
        LBAR();
#pragma unroll
        for (int r = 0; r < 16; ++r) { const int t = 32 * rh + crow(r, hi); const f32x4 ps = *(const f32x4*)(PS + t * 4);
            const float rstd = rsqrtf(((ps[0] + ps[1]) + (ps[2] + ps[3])) * (1.f / DH) + NORM_EPS);
            const size_t gi = (row0 + t) * DM + h * DH + 32 * vq + r32;
            const float val = o[r] * rstd * gain * __builtin_amdgcn_cvt_f32_fp8((int)garaw[r], 0); const float v1 = dpp_xor1(val), v2 = dpp_xor2(val), v3 = DPPF(val, 0x1B, 0xF, false);
            if ((r32 & 3) == 0) *(unsigned*)((dummy ? ws + WS_G + 2 * MiB : OA) + (dummy ? (gi & 0xffffff) : gi)) = pack4_fp8(val, v1, v2, v3); }
        LBAR();
    }
}
#undef C_LOAD
#undef A_LOAD
#undef V8_TO_BF16
#undef LBAR
#undef KSWZ
#undef TRRD
#undef FRAG4
}

static_assert(LDS_STAGE_BYTES == pg8::STAGE_BYTES, "stage region");
__device__ __forceinline__ void moe_tables(const Ctx& c, int layer, LAS int* tab) {
    const unsigned* gc = (const unsigned*)(wsl(c) + WS_CTL) + CW_CNT + layer * 64;
    if (threadIdx.x < NE) tab[80 + threadIdx.x] = (int)__hip_atomic_load(gc + threadIdx.x, __ATOMIC_RELAXED, __HIP_MEMORY_SCOPE_AGENT);
    __syncthreads();
    if (threadIdx.x == 0) { int s = 0, t = 0;
        for (int e = 0; e < NE; ++e) { const int n = tab[80 + e]; tab[e] = t; tab[40 + e] = s; s += (n + 255) & ~255; t += (n + 255) >> 8; }
        tab[NE] = t; tab[40 + NE] = s; }
    __syncthreads();
}
__device__ __forceinline__ void moe_tail_convert(const Ctx& c, int next_layer, LAS unsigned char* lds, int it_lo, int it_hi) {
    const LAS int* tab = (const LAS int*)(lds + LDS_MISC + 1024);
    const int rem = (tab[NE] * 4) & 255, cid = bidx();
    if (cid < rem) return;
    const int wave = __builtin_amdgcn_readfirstlane(tidx() >> 6);
    ph_convert(c, next_layer, lds, it_lo, it_hi, (cid - rem) * NWAVE + wave, (256 - rem) * NWAVE, false);
}
constexpr int CW_CVQ = 4096;
__device__ __forceinline__ void attn_tail_convert(const Ctx& c, int layer, LAS unsigned char* lds, int it_lo) {
    unsigned* chead = (unsigned*)(wsl(c) + WS_CTL) + CW_CVQ + layer * 64;
    volatile LAS int* slot = (volatile LAS int*)(lds + LDS_MISC + 2048);
    const int tid = tidx(), wave = __builtin_amdgcn_readfirstlane(tid >> 6), lane = tid & 63;
    LAS float* scr = (LAS float*)(lds + wave * 16640);
    static_assert((CV_ALL - CV_A_END) % (2 * NWAVE) == 0 && (CV_ALL - CV_IN) % (2 * NWAVE) == 0, "whole batches");
    for (;;) {
        __syncthreads();
        if (tid == 0) slot[0] = (int)__hip_atomic_fetch_add(chead, (unsigned)(2 * NWAVE), __ATOMIC_RELAXED, __HIP_MEMORY_SCOPE_AGENT);
        __syncthreads();
        const int base = __builtin_amdgcn_readfirstlane(slot[0]);
        if (base >= CV_ALL - it_lo) break;
        const CvItem da = cv_item(c, layer, it_lo + base + wave), db = cv_item(c, layer, it_lo + base + NWAVE + wave);
        f32x4 va[16], vb[16];
        cv_load(va, da, lane); cv_load(vb, db, lane);
        __builtin_amdgcn_sched_barrier(0);
        cv_store(va, da, scr, lane); cv_store(vb, db, scr, lane);
    }
}
template <int GP> __device__ __forceinline__ void ph_gemm(const Ctx& c, int layer, LAS unsigned char* lds) {
    unsigned char* ws = wsl(c); const int G = gridDim.x, cid = bidx();
    if (GP == 0) { pg8::StaticOrder S; S.init(ws + WS_XB8, ws + WS_WIN, T, INP, DM, G, cid, 1); pg8::EpiInProj E{make_ipo(c), 1.f / WIN_SCALE, c.in[I_GQ] + layer * DH, c.in[I_GK] + layer * DH, (LAS float*)(lds + LDS_STAGE_BYTES), (int)(tidx() & 63)}; pg8::gemm_phase<DM, pg8::EpiInProj, pg8::StaticOrder, true>(lds, S, E); }
    if (GP == 1) { pg8::MergeOrder S; S.base.init(ws + WS_OA, ws + WS_WA, T, DM, DM, G, cid, 1); S.A2 = (const char*)(ws + WS_OB); S.B2 = (const char*)(ws + WS_WB);
        pg8::EpiMergeChain E{(const unsigned char*)(ws + WS_SGA), (const unsigned char*)(ws + WS_SGB), ws + WS_VA, MG_SCALE / WIN_SCALE}; pg8::gemm_phase<DM, pg8::EpiMergeChain, pg8::MergeOrder, true>(lds, S, E); }
    if (GP == 3) { pg8::StaticOrder S; S.init(ws + WS_VA, ws + WS_WO, T, DM, DM, G, cid, 1); pg8::EpiOut E{(const bf16_t*)(ws + WS_XBF), (bf16_t*)(ws + WS_YX), 1.f / (WIN_SCALE * MG_SCALE)}; pg8::gemm_phase<DM, pg8::EpiOut, pg8::StaticOrder, true>(lds, S, E); }
    if (GP == 4 || GP == 5) { LAS int* tab = (LAS int*)(lds + LDS_MISC + 1024); moe_tables(c, layer, tab);
        if (GP == 4) { pg8::MoeOrder<true> S{(const char*)(ws + WS_X18), (const char*)(ws + WS_WGU), (const int*)(ws + WS_STE), tab, tab + 40, tab + 80, G, cid}; pg8::EpiMoeUp E{(unsigned char*)(ws + WS_HB), 1.f / WIN_SCALE}; pg8::gemm_phase<DM, pg8::EpiMoeUp, pg8::MoeOrder<true>, true>(lds, S, E); }
        else { pg8::MoeOrder<false> S{(const char*)(ws + WS_HB), (const char*)(ws + WS_WD), (const int*)(ws + WS_STE), tab, tab + 40, tab + 80, G, cid}; pg8::EpiMoeDn E{(bf16_t*)(ws + WS_YB), 1.f / WIN_SCALE}; pg8::gemm_phase<DE, pg8::EpiMoeDn, pg8::MoeOrder<false>, true>(lds, S, E); } }
}


#define XB_TMO      128
#define XB_XCNT(j)  (256  + 64 * (j))
#define XB_XSUB(j)  (1280 + 64 * (j))
#define XB_XGEN(j)  (2304 + 64 * (j))
#define XB_TOP      3328
#define XB_TOPGEN   3392
#define XCD_BAR_WORDS 3456
#define XB_SPIN_CAP (1u << 18)
__device__ __forceinline__ unsigned xb_ld(unsigned* p)              { return __hip_atomic_load(p, __ATOMIC_RELAXED, __HIP_MEMORY_SCOPE_AGENT); }
__device__ __forceinline__ unsigned xb_add(unsigned* p, unsigned v) { return __hip_atomic_fetch_add(p, v, __ATOMIC_RELAXED, __HIP_MEMORY_SCOPE_AGENT); }
__device__ __forceinline__ unsigned xb_xcc_id() { return (unsigned)__builtin_amdgcn_s_getreg((3 << 11) | 20) & 0xFu; }
#define XB_SPIN(cond, bar) do { unsigned _sp = 0; while (cond) { __builtin_amdgcn_s_sleep(1); \
    if ((++_sp & 255u) == 0u) { if (xb_ld(&(bar)[XB_TMO])) break; if (_sp > XB_SPIN_CAP) { atomicAdd(&(bar)[XB_TMO], 1u); break; } } } } while (0)
struct XcdBarrier { unsigned* bar; unsigned x; volatile LAS unsigned* st; };
__device__ __forceinline__ XcdBarrier xcd_barrier_post(unsigned* bar, volatile LAS unsigned* st) {
    XcdBarrier b; b.bar = bar; b.x = xb_xcc_id(); b.st = st;
    if (threadIdx.x == 0) (void)xb_add(&bar[XB_XCNT(b.x)], 1u);
    return b;
}
__device__ __forceinline__ void xcd_barrier_complete(unsigned* bar, unsigned x, unsigned& nloc, unsigned& nx) {
    const unsigned G = gridDim.x * gridDim.y * gridDim.z;
    unsigned sum, cnt, mine, sp = 0u;
    for (;;) {
        sum = 0u; cnt = 0u; mine = 0u;
#pragma unroll
        for (unsigned j = 0; j < 16; ++j) { const unsigned c = xb_ld(&bar[XB_XCNT(j)]); sum += c; cnt += (c > 0u) ? 1u : 0u; mine = (j == x) ? c : mine; }
        if (sum == G) break;
        __builtin_amdgcn_s_sleep(1);
        if ((++sp & 255u) == 0u) { if (xb_ld(&bar[XB_TMO])) break; if (sp > XB_SPIN_CAP) { atomicAdd(&bar[XB_TMO], 1u); break; } }
    }
    nloc = mine > 0u ? mine : 1u; nx = cnt > 0u ? cnt : 1u;
}
__device__ __forceinline__ void xcd_barrier(const XcdBarrier& b) {
    asm volatile("s_waitcnt vmcnt(0)" ::: "memory");
    __syncthreads();
    if (threadIdx.x == 0) {
        unsigned* bar = b.bar; asm volatile("" : "+s"(bar));
        const unsigned bx = (unsigned)__builtin_amdgcn_readfirstlane((int)xb_xcc_id());
        __builtin_amdgcn_s_waitcnt(0);
        unsigned nloc = b.st[0], nx = b.st[1];
        if (nloc == 0u) { xcd_barrier_complete(bar, bx, nloc, nx); b.st[0] = nloc; b.st[1] = nx; }
        const unsigned old = xb_add(&bar[XB_XSUB(bx)], 1u);
        const unsigned gen = old / nloc;
        if (old + 1u == (gen + 1u) * nloc) {
            __builtin_amdgcn_fence(__ATOMIC_RELEASE, "agent");
            asm volatile("s_waitcnt vmcnt(0)" ::: "memory");
            const unsigned og = xb_add(&bar[XB_TOP], 1u);
            const unsigned tg = og / nx;
            if (og + 1u == (tg + 1u) * nx) xb_add(&bar[XB_TOPGEN], 1u);
            else XB_SPIN(xb_ld(&bar[XB_TOPGEN]) == tg, bar);
            __builtin_amdgcn_fence(__ATOMIC_ACQUIRE, "agent");
            xb_add(&bar[XB_XGEN(bx)], 1u);
            asm volatile("s_waitcnt vmcnt(0)" ::: "memory");
        } else {
            XB_SPIN(xb_ld(&bar[XB_XGEN(bx)]) == gen, bar);
            __builtin_amdgcn_fence(__ATOMIC_ACQUIRE, "agent");
            asm volatile("s_waitcnt vmcnt(0)" ::: "memory");
        }
    }
    __syncthreads();
}

constexpr int CW_BAR = 8192;
static_assert((CW_BAR + XCD_BAR_WORDS) * 4 <= (int)CTL_BYTES, "ctl");
__global__ void __launch_bounds__(NTHR, 2) k_mega(KArgs a) {
    LAS unsigned char* lds = (LAS unsigned char*)g_lds; char* ldsg = (char*)g_lds;
    if (threadIdx.x < 4) ((LAS unsigned*)(lds + LDS_MISC))[threadIdx.x] = 0u;
    __syncthreads();
    const Ctx c{};
    const XcdBarrier bar = xcd_barrier_post((unsigned*)(wsl(c) + WS_CTL) + CW_BAR, (volatile LAS unsigned*)(lds + LDS_MISC));
#ifndef PROBE_PH
#define PROBE_PH (-1)
#endif
#ifndef DUP_C
#define DUP_C 0
#endif
#ifndef DUP_PH
#define DUP_PH (-1)
#endif
    unsigned long long tacc = 0ull, t0 = 0ull;
#define PB_S(p) do { if (PROBE_PH == (p)) t0 = __builtin_amdgcn_s_memrealtime(); } while (0)
#define PB_E(p) do { if (PROBE_PH == (p)) tacc += __builtin_amdgcn_s_memrealtime() - t0; } while (0)
#define GBAR() xcd_barrier(bar)
    PB_S(0); ph_xprep(c, lds); ph_convert(c, 0, lds, 0, CV_IN); GBAR(); PB_E(0);
#define LAYER(l) do { \
        PB_S(1); if (DUP_PH == 1) { ph_gemm<0>(c, l, lds); GBAR(); } ph_gemm<0>(c, l, lds);          GBAR(); PB_E(1); \
        PB_S(2); if (DUP_PH == 2) { hg::pass_a(c, ldsg); GBAR(); } ph_foxprep(c, l, lds); __syncthreads(); hg::pass_a(c, ldsg);     GBAR(); PB_E(2); \
        PB_S(5); hg::pass_b(c); __syncthreads(); fa::phase(c, l, ldsg); attn_tail_convert(c, l, lds, (l) == 0 ? CV_IN : CV_A_END);                GBAR(); if (DUP_PH == 5) { fa::phase(c, l, ldsg, l + 4); GBAR(); } PB_E(5);     \
        PB_S(4); if (DUP_C) { hg::pass_c(c, l, ldsg, true); GBAR(); } hg::pass_c(c, l, ldsg);         GBAR(); PB_E(4); \
        PB_S(6); if (DUP_PH == 6) { ph_gemm<1>(c, l, lds); GBAR(); } ph_gemm<1>(c, l, lds);                     GBAR(); PB_E(6); \
        PB_S(7); if (DUP_PH == 7) { ph_gemm<3>(c, l, lds); GBAR(); } ph_gemm<3>(c, l, lds);          GBAR(); PB_E(7); \
        PB_S(8); ph_ln1_router(c, l, lds);       GBAR(); PB_E(8); \
        PB_S(9); if (DUP_PH == 9) { ph_gemm<4>(c, l, lds); GBAR(); } ph_gemm<4>(c, l, lds); if (l + 1 < DEPTH) moe_tail_convert(c, l + 1, lds, 0, CV_A_END);         GBAR(); PB_E(9); \
        PB_S(10); if (DUP_PH == 10) { ph_gemm<5>(c, l, lds); GBAR(); } ph_gemm<5>(c, l, lds); \
        if (PROBE_PH >= 0 && l == DEPTH - 1) { PB_E(10); if (bidx() == 0 && threadIdx.x == 0) { const float tq = exp2f(rintf(4.f * log2f((float)tacc * 1e-7f)) * 0.25f); *(float*)(wsl(c) + WS_CTL + 256) = 1.f + sqrtf(tq); } } \
        GBAR(); if (l < DEPTH - 1) PB_E(10); \
        float oscale = 1.f; if (PROBE_PH >= 0 && l == DEPTH - 1) oscale = __hip_atomic_load((float*)(wsl(c) + WS_CTL + 256), __ATOMIC_RELAXED, __HIP_MEMORY_SCOPE_AGENT); \
        PB_S(11); if (DUP_PH == 11) { ph_ln2(c, l, lds, oscale); __syncthreads(); } if (DUP_PH == 12 && l + 1 < DEPTH) { ph_convert(c, l + 1, lds); __syncthreads(); } ph_ln2(c, l, lds, oscale); \
        if (l + 1 < DEPTH) { __syncthreads(); ph_convert(c, l + 1, lds, CV_ALL, CV_ALL); GBAR(); PB_E(11); } } while (0)
    LAYER(0); LAYER(1); LAYER(2); LAYER(3);
}
#ifdef PHASE_REGS
#define PK(name, body) __global__ void __launch_bounds__(NTHR, 2) name(KArgs a, int l) { LAS unsigned char* lds = (LAS unsigned char*)g_lds; char* ldsg = (char*)g_lds; const Ctx c{}; body; }
PK(t_xprep, ph_xprep(c, lds)) PK(t_convert, ph_convert(c, l, lds)) PK(t_inproj, ph_gemm<0>(c, l, lds)) PK(t_foxprep, ph_foxprep(c, l, lds)) PK(t_hga, hg::pass_a(c, ldsg)) PK(t_hgb, hg::pass_b(c))
PK(t_hgc, hg::pass_c(c, l, ldsg)) PK(t_attn, fa::phase(c, l, ldsg)) PK(t_merge1, ph_gemm<1>(c, l, lds)) PK(t_out, ph_gemm<3>(c, l, lds)) PK(t_ln1, ph_ln1_router(c, l, lds))
PK(t_moeup, ph_gemm<4>(c, l, lds)) PK(t_moedn, ph_gemm<5>(c, l, lds)) PK(t_ln2, ph_ln2(c, l, lds))
#endif
extern "C" void kernel_launch(void* const* d_in, const int* in_sizes, int n_in, void* d_out, int out_size, void* d_ws, size_t ws_size, hipStream_t stream) {
    static int ok = 0;
    if (ok == 0) {
        if (n_in != 21 || in_sizes[0] != T * DM || out_size != T * DM || ws_size < hg::WS_HG_END) { fprintf(stderr, "kernel_launch: unexpected shapes (n_in %d in0 %d out %d ws %zu, need ws >= %zu)\n", n_in, n_in > 0 ? in_sizes[0] : -1, out_size, ws_size, (size_t)hg::WS_HG_END); ok = -1; return; }
        if (hipFuncSetAttribute((const void*)k_mega, hipFuncAttributeMaxDynamicSharedMemorySize, LDS_TOTAL) != hipSuccess) { fprintf(stderr, "kernel_launch: hipFuncSetAttribute failed\n"); ok = -1; return; }
        int dev = 0, cus = 0, per_cu = 0;
        if (hipGetDevice(&dev) != hipSuccess || hipDeviceGetAttribute(&cus, hipDeviceAttributeMultiprocessorCount, dev) != hipSuccess || cus < 256) { fprintf(stderr, "kernel_launch: needs a device with >= 256 CUs (found %d); nothing launched\n", cus); ok = -1; return; }
        if (hipOccupancyMaxActiveBlocksPerMultiprocessor(&per_cu, (const void*)k_mega, NTHR, LDS_TOTAL) != hipSuccess || per_cu < 1) { fprintf(stderr, "kernel_launch: the occupancy query reports %d workgroups per CU (need 1); nothing launched\n", per_cu); (void)hipGetLastError(); ok = -1; return; }
        ok = 1;
    }
    if (ok < 0) return;
    (void)hipMemsetAsync((char*)d_ws + WS_CTL, 0, CTL_BYTES, stream);
    KArgs a{};
    for (int i = 0; i < 21; ++i) a.in[i] = (const float*)d_in[i];
    a.out = (float*)d_out; a.ws = (unsigned char*)d_ws;
    hipLaunchKernelGGL(k_mega, dim3(256), dim3(NTHR), LDS_TOTAL, stream, a);
}
```

```cpp
#include <hip/hip_runtime.h>
#include <stdint.h>
#include <stdio.h>

typedef unsigned short bf16_t;
typedef float f32x4 __attribute__((ext_vector_type(4)));
typedef unsigned u32x4 __attribute__((ext_vector_type(4)));
typedef unsigned u32x2 __attribute__((ext_vector_type(2)));
#define LAS __attribute__((address_space(3)))

constexpr int DM = 1024, NB = 4, SEQ = 8192, T = NB * SEQ, DEPTH = 4;
constexpr int NH = 8, DH = 128;
constexpr int IN_COLS = 9224, INP = 9216, FF_COL = 7168;
constexpr int NG = 4, EPG = 8, NE = 32, DE = 512;
constexpr float ALPHA = 1.6817928305074292f;
constexpr float LN_EPS = 1e-5f, NORM_EPS = 1e-6f;
constexpr float SQRT_DH = 11.313708498984761f;
constexpr float ATT_SCALE = 0.08838834764831845f;
constexpr int NSLOT = 2 * T + NE * 256;

constexpr size_t MiB = 1u << 20;
constexpr size_t WS_CTL = 0, CTL_BYTES = 64 * 1024;
constexpr size_t WS_LB = 1 * MiB;
constexpr size_t WS_RWT = 1 * MiB + 65536;
constexpr size_t WS_FFL = 2 * MiB;
constexpr size_t WS_KBIAS = 3 * MiB;
constexpr size_t WS_TOPE = 4 * MiB;
constexpr size_t WS_TOPW = 4 * MiB + 262144;
constexpr size_t WS_TPOS = 4 * MiB + 524288;
constexpr size_t WS_STE = 5 * MiB;
constexpr size_t WS_WIN = 16 * MiB;
constexpr float WIN_SCALE = 32.f;
constexpr size_t WS_WA = 34 * MiB, WS_WB = 36 * MiB, WS_WO = 38 * MiB;
constexpr float MG_SCALE = 8.f;
constexpr size_t WS_WGU = 40 * MiB;
constexpr size_t WS_WD = 104 * MiB;
constexpr size_t WS_USLO = 136 * MiB;
constexpr size_t WS_X18 = 232 * MiB;
constexpr size_t WS_XB8 = 200 * MiB;
constexpr size_t WS_XBF = 264 * MiB;
constexpr size_t WS_QA = 328 * MiB;
constexpr size_t WS_OA = 456 * MiB;
constexpr size_t WS_OB = 488 * MiB;
constexpr size_t WS_LF = 392 * MiB;
constexpr size_t WS_YX = 392 * MiB;
constexpr size_t WS_VA = 520 * MiB;
constexpr size_t WS_GA = 584 * MiB;
constexpr size_t WS_FQ = 648 * MiB;
constexpr size_t WS_FK = 712 * MiB;
constexpr size_t WS_FV = 776 * MiB;
constexpr size_t WS_SGA = 840 * MiB, WS_SGB = 904 * MiB;
constexpr size_t WS_HB = 520 * MiB;
constexpr size_t WS_YB = 592 * MiB;
constexpr size_t WS_END = 968 * MiB;
static_assert(WS_HB + (size_t)NSLOT * 512 * 2 <= WS_YB && WS_YB + (size_t)NSLOT * 1024 * 2 <= 840 * MiB, "moe overlay");
constexpr int CW_CNT = 1024;

struct KArgs { const float* in[21]; float* out; unsigned char* ws; };
extern __shared__ __attribute__((aligned(16))) unsigned char g_lds[];
constexpr int LDS_STAGE_BYTES = 131072, LDS_TOTAL = 163840, LDS_MISC = LDS_TOTAL - 4096;
typedef __attribute__((address_space(4))) const unsigned long long cu64_t;
__device__ __forceinline__ void* ctx_ptr(int i) {
    const uintptr_t k = (uintptr_t)__builtin_amdgcn_kernarg_segment_ptr();
    unsigned lo = (unsigned)k, hi = (unsigned)(k >> 32); asm volatile("" : "+s"(lo), "+s"(hi));
    cu64_t* t = (cu64_t*)(((uintptr_t)hi << 32) | lo);
    return (void*)(__attribute__((address_space(1))) void*)(uintptr_t)t[i];
}
struct Ctx {
    struct In { __device__ __forceinline__ const float* operator[](int i) const { return (const float*)ctx_ptr(i); } } in;
    __device__ __forceinline__ float* outp() const { return (float*)ctx_ptr(21); }
};
__device__ __forceinline__ unsigned char* wsl(const Ctx&) { return (unsigned char*)ctx_ptr(22); }
enum { I_X = 0, I_WIN, I_BFF, I_GQ, I_GK, I_LBL, I_HGN, I_WA, I_WB, I_WO, I_L1G, I_L1B, I_RGW, I_RGB, I_REW, I_REB, I_WG, I_WU, I_WD, I_L2G, I_L2B };

typedef __bf16 bf16v2_t __attribute__((ext_vector_type(2)));
typedef float f32v2_t __attribute__((ext_vector_type(2)));
typedef _Float16 f16v4_t __attribute__((ext_vector_type(4)));
typedef _Float16 f16v8_t __attribute__((ext_vector_type(8)));
__device__ __forceinline__ unsigned cvt_pk_bf16(float lo, float hi) { f32v2_t v = {lo, hi}; bf16v2_t b = __builtin_convertvector(v, bf16v2_t); return __builtin_bit_cast(unsigned, b); }
__device__ __forceinline__ int bidx() { int b = blockIdx.x; asm volatile("" : "+s"(b)); return b; }
__device__ __forceinline__ int tidx() { int t = threadIdx.x; asm volatile("" : "+v"(t)); return t; }
__device__ __forceinline__ float bf2f(bf16_t b) { return __uint_as_float(((unsigned)b) << 16); }
__device__ __forceinline__ unsigned f2bf(float f) { unsigned u = __float_as_uint(f); return (u + 0x7fffu + ((u >> 16) & 1u)) >> 16; }
__device__ __forceinline__ unsigned pk2(float lo, float hi) { return f2bf(lo) | (f2bf(hi) << 16); }
__device__ __forceinline__ float sigm(float x) { return 1.f / (1.f + __expf(-x)); }
__device__ __forceinline__ float silu(float x) { return x / (1.f + __expf(-x)); }
typedef _Float16 f16v2_t __attribute__((ext_vector_type(2)));
__device__ __forceinline__ unsigned cvt_pk_f16(float lo, float hi) { f32v2_t v = {lo, hi}; f16v2_t h = __builtin_convertvector(v, f16v2_t); return __builtin_bit_cast(unsigned, h); }
__device__ __forceinline__ void unpack_f16x2(unsigned u, float& lo, float& hi) { const f16v2_t h = __builtin_bit_cast(f16v2_t, u); lo = (float)h[0]; hi = (float)h[1]; }
__device__ __forceinline__ f32x4 unpack_f16x4(unsigned a, unsigned b) { const f16v2_t h0 = __builtin_bit_cast(f16v2_t, a), h1 = __builtin_bit_cast(f16v2_t, b); return (f32x4){(float)h0[0], (float)h0[1], (float)h1[0], (float)h1[1]}; }
__device__ __forceinline__ unsigned pack4_fp8(float a, float b, float c, float d) { int v = __builtin_amdgcn_cvt_pk_fp8_f32(a, b, 0, false); v = __builtin_amdgcn_cvt_pk_fp8_f32(c, d, v, true); return (unsigned)v; }
typedef float f32v2u_t __attribute__((ext_vector_type(2)));
__device__ __forceinline__ f32x4 unpack4_fp8(unsigned u) { const f32v2u_t a = __builtin_amdgcn_cvt_pk_f32_fp8((int)u, false), b = __builtin_amdgcn_cvt_pk_f32_fp8((int)u, true); return (f32x4){a[0], a[1], b[0], b[1]}; }
#define DPPF(v, ctrl, rmask, bc) __builtin_bit_cast(float, __builtin_amdgcn_update_dpp(0, __builtin_bit_cast(int, (float)(v)), ctrl, rmask, 0xF, bc))
__device__ __forceinline__ float dpp_xor1(float v) { return DPPF(v, 0xB1, 0xF, false); }
__device__ __forceinline__ float dpp_xor2(float v) { return DPPF(v, 0x4E, 0xF, false); }
__device__ __forceinline__ float row_sum16(float v) { v += DPPF(v, 0xB1, 0xF, false); v += DPPF(v, 0x4E, 0xF, false); v += DPPF(v, 0x141, 0xF, false); v += DPPF(v, 0x140, 0xF, false); return v; }
__device__ __forceinline__ float dpp_sum64(float v) { v = row_sum16(v); v += DPPF(v, 0x142, 0xA, false); v += DPPF(v, 0x143, 0xC, false); return v; }
__device__ __forceinline__ float wave_sum(float v) { return __builtin_bit_cast(float, __builtin_amdgcn_readlane(__builtin_bit_cast(int, dpp_sum64(v)), 63)); }
__device__ __forceinline__ float dpp_shr(float v, int n) {
    return n == 1 ? DPPF(v, 0x111, 0xF, true) : (n == 2 ? DPPF(v, 0x112, 0xF, true) : (n == 4 ? DPPF(v, 0x114, 0xF, true) : DPPF(v, 0x118, 0xF, true)));
}
__device__ __forceinline__ float bperm(float v, int src_lane) { return __builtin_bit_cast(float, __builtin_amdgcn_ds_bpermute(src_lane << 2, __builtin_bit_cast(int, v))); }
struct InProjOut { unsigned char *QA, *VA, *GA, *SGA, *SGB  ; bf16_t *FQ, *FK, *FV; bf16_t* LF  ; const float* lb; };
__device__ __forceinline__ InProjOut make_ipo(const Ctx& c) {
    InProjOut o; unsigned char* ws = wsl(c);
    o.QA = ws + WS_QA; o.VA = ws + WS_VA; o.GA = ws + WS_GA; o.FQ = (bf16_t*)(ws + WS_FQ); o.FK = (bf16_t*)(ws + WS_FK); o.FV = (bf16_t*)(ws + WS_FV);
    o.SGA = ws + WS_SGA; o.SGB = ws + WS_SGB; o.LF = (bf16_t*)(ws + WS_LF); o.lb = (const float*)(ws + WS_LB); return o;
}
__device__ __forceinline__ size_t headmajor(int m, int c) { const int b = m >> 13, s = m & (SEQ - 1), h = c >> 7, d = c & 127; return ((size_t)((b * NH + h) * SEQ + s)) * DH + d; }
constexpr int NTHR = 512, NWAVE = 8;
struct Wv { int tid, lane, wave, gw, ngw; };
__device__ __forceinline__ Wv make_wv() { Wv w; w.tid = tidx(); w.lane = w.tid & 63; w.wave = __builtin_amdgcn_readfirstlane(w.tid >> 6); w.gw = bidx() * NWAVE + w.wave; w.ngw = gridDim.x * NWAVE; return w; }

template <bool F8>
__device__ __forceinline__ void transpose_item(const float* src, int ld, int k0, int c0, void* dst_row0, int K, LAS float* scr, int lane) {
    f32x4 v[16];
#pragma unroll
    for (int i = 0; i < 16; ++i) v[i] = *(const f32x4*)(src + (size_t)(k0 + 4 * i + (lane >> 4)) * ld + c0 + (lane & 15) * 4);
#pragma unroll
    for (int i = 0; i < 16; ++i) { LAS float* p = scr + (4 * i + (lane >> 4)) * 65 + (lane & 15) * 4; p[0] = v[i][0]; p[1] = v[i][1]; p[2] = v[i][2]; p[3] = v[i][3]; }
    asm volatile("s_waitcnt lgkmcnt(0)" ::: "memory");
    const int kc = (lane & 7) * 8;
#pragma unroll
    for (int i = 0; i < 8; ++i) { const int n = 8 * i + (lane >> 3); const LAS float* q = scr + kc * 65 + n;
        if (F8) { u32x2 o; o.x = pack4_fp8(q[0 * 65] * WIN_SCALE, q[1 * 65] * WIN_SCALE, q[2 * 65] * WIN_SCALE, q[3 * 65] * WIN_SCALE); o.y = pack4_fp8(q[4 * 65] * WIN_SCALE, q[5 * 65] * WIN_SCALE, q[6 * 65] * WIN_SCALE, q[7 * 65] * WIN_SCALE);
            *(u32x2*)((unsigned char*)dst_row0 + (size_t)n * K + k0 + kc) = o; }
        else { u32x4 o; o.x = cvt_pk_bf16(q[0 * 65], q[1 * 65]); o.y = cvt_pk_bf16(q[2 * 65], q[3 * 65]); o.z = cvt_pk_bf16(q[4 * 65], q[5 * 65]); o.w = cvt_pk_bf16(q[6 * 65], q[7 * 65]);
            *(u32x4*)((bf16_t*)dst_row0 + (size_t)n * K + k0 + kc) = o; } }
    asm volatile("s_waitcnt lgkmcnt(0)" ::: "memory");
}
constexpr int CV_IN = 16 * 144, CV_SQ = 16 * 16, CV_GU = 16 * 8, CV_DN = 8 * 16;
constexpr int CV_A_END = CV_IN + 3 * CV_SQ, CV_B_END = CV_A_END + (NE / 2) * 2 * CV_GU, CV_ALL = CV_IN + 3 * CV_SQ + NE * 2 * CV_GU + NE * CV_DN;
struct CvItem { const float* src; int ld, k0, c0; unsigned char* dst; int K; };
__device__ __forceinline__ CvItem cv_item(const Ctx& c, int layer, int it) {
    unsigned char* ws = wsl(c); CvItem d; int r = it;
    if (r < CV_IN) { const int kb = r / 144, nb = r % 144, n0 = nb * 64;
        d.src = c.in[I_WIN] + (size_t)layer * DM * IN_COLS; d.ld = IN_COLS; d.k0 = kb * 64; d.c0 = n0 + (n0 >= FF_COL ? 8 : 0); d.dst = (unsigned char*)(ws + WS_WIN) + (size_t)n0 * DM; d.K = DM; return d; }
    r -= CV_IN;
    if (r < 3 * CV_SQ) { const int which = r / CV_SQ, q = r % CV_SQ, kb = q / 16, nb = q % 16;
        d.src = c.in[which == 0 ? I_WA : (which == 1 ? I_WB : I_WO)] + (size_t)layer * DM * DM; d.ld = DM; d.k0 = kb * 64; d.c0 = nb * 64;
        d.dst = ws + (which == 0 ? WS_WA : (which == 1 ? WS_WB : WS_WO)) + (size_t)(nb * 64) * DM; d.K = DM; return d; }
    r -= 3 * CV_SQ;
    if (r < NE * 2 * CV_GU) { const int e = r / (2 * CV_GU), q = r % (2 * CV_GU), up = q / CV_GU, q2 = q % CV_GU, kb = q2 / 8, nb = q2 % 8, j0 = nb * 64;
        d.src = c.in[up ? I_WU : I_WG] + ((size_t)layer * NE + e) * DM * DE; d.ld = DE; d.k0 = kb * 64; d.c0 = j0;
        d.dst = (unsigned char*)(ws + WS_WGU) + ((size_t)e * 1024 + (j0 >> 7) * 256 + (j0 & 127) + up * 128) * DM; d.K = DM; return d; }
    r -= NE * 2 * CV_GU;
    { const int e = r / CV_DN, q = r % CV_DN, kb = q / 16, nb = q % 16;
        d.src = c.in[I_WD] + ((size_t)layer * NE + e) * DE * DM; d.ld = DM; d.k0 = kb * 64; d.c0 = nb * 64; d.dst = (unsigned char*)(ws + WS_WD) + ((size_t)e * 1024 + nb * 64) * DE; d.K = DE; return d; }
}
__device__ __forceinline__ void cv_load(f32x4 (&v)[16], const CvItem& d, int lane) {
#pragma unroll
    for (int i = 0; i < 16; ++i) v[i] = *(const f32x4*)(d.src + (size_t)(d.k0 + 4 * i + (lane >> 4)) * d.ld + d.c0 + (lane & 15) * 4);
}
__device__ __forceinline__ void cv_store(const f32x4 (&v)[16], const CvItem& d, LAS float* scr, int lane) {
#pragma unroll
    for (int i = 0; i < 16; ++i) { LAS float* p = scr + (4 * i + (lane >> 4)) * 65 + (lane & 15) * 4; p[0] = v[i][0]; p[1] = v[i][1]; p[2] = v[i][2]; p[3] = v[i][3]; }
    asm volatile("s_waitcnt lgkmcnt(0)" ::: "memory");
    const int kc = (lane & 7) * 8;
#pragma unroll
    for (int i = 0; i < 8; ++i) { const int n = 8 * i + (lane >> 3); const LAS float* q = scr + kc * 65 + n; u32x2 o;
        o.x = pack4_fp8(q[0 * 65] * WIN_SCALE, q[1 * 65] * WIN_SCALE, q[2 * 65] * WIN_SCALE, q[3 * 65] * WIN_SCALE); o.y = pack4_fp8(q[4 * 65] * WIN_SCALE, q[5 * 65] * WIN_SCALE, q[6 * 65] * WIN_SCALE, q[7 * 65] * WIN_SCALE);
        *(u32x2*)(d.dst + (size_t)n * d.K + d.k0 + kc) = o; }
    asm volatile("s_waitcnt lgkmcnt(0)" ::: "memory");
}
__device__ __forceinline__ void ph_convert(const Ctx& c, int layer, LAS unsigned char* lds, int it_lo = 0, int it_hi = CV_ALL, int gw = -1, int ngw = 1, bool tail = true) {
    const Wv w = make_wv(); LAS float* scr = (LAS float*)(lds + w.wave * 16640);
    unsigned char* ws = wsl(c);
    constexpr int I_IN = CV_IN, I_SQ = CV_SQ, I_GU = CV_GU, I_DN = CV_DN;
    if (gw < 0) { gw = w.gw; ngw = w.ngw; }
    for (int it = it_lo + gw; it < it_hi; it += ngw) {
        int r = it;
        if (r < I_IN) { const int kb = r / 144, nb = r % 144, n0 = nb * 64; const int c0 = n0 + (n0 >= FF_COL ? 8 : 0);
            transpose_item<true>(c.in[I_WIN] + (size_t)layer * DM * IN_COLS, IN_COLS, kb * 64, c0, (unsigned char*)(ws + WS_WIN) + (size_t)n0 * DM, DM, scr, w.lane); continue; }
        r -= I_IN;
        if (r < 3 * I_SQ) { const int which = r / I_SQ, q = r % I_SQ, kb = q / 16, nb = q % 16;
            const float* src = c.in[which == 0 ? I_WA : (which == 1 ? I_WB : I_WO)] + (size_t)layer * DM * DM;
            unsigned char* dst = ws + (which == 0 ? WS_WA : (which == 1 ? WS_WB : WS_WO));
            transpose_item<true>(src, DM, kb * 64, nb * 64, dst + (size_t)(nb * 64) * DM, DM, scr, w.lane); continue; }
        r -= 3 * I_SQ;
        if (r < NE * 2 * I_GU) { const int e = r / (2 * I_GU), q = r % (2 * I_GU), up = q / I_GU, q2 = q % I_GU, kb = q2 / 8, nb = q2 % 8, j0 = nb * 64;
            const float* src = c.in[up ? I_WU : I_WG] + ((size_t)layer * NE + e) * DM * DE;
            const int drow = (j0 >> 7) * 256 + (j0 & 127) + up * 128;
            transpose_item<true>(src, DE, kb * 64, j0, (unsigned char*)(ws + WS_WGU) + ((size_t)e * 1024 + drow) * DM, DM, scr, w.lane); continue; }
        r -= NE * 2 * I_GU;
        { const int e = r / I_DN, q = r % I_DN, kb = q / 16, nb = q % 16;
            const float* src = c.in[I_WD] + ((size_t)layer * NE + e) * DE * DM;
            transpose_item<true>(src, DM, kb * 64, nb * 64, (unsigned char*)(ws + WS_WD) + ((size_t)e * 1024 + nb * 64) * DE, DE, scr, w.lane); }
    }
    if (!tail) return;
    const int gt = bidx() * NTHR + w.tid, ngt = gridDim.x * NTHR;
    float* rwt = (float*)(ws + WS_RWT);
    for (int i = gt; i < 36 * DM; i += ngt) { const int j = i / DM, k = i % DM;
        rwt[i] = j < 4 ? c.in[I_RGW][((size_t)layer * DM + k) * NG + j] : c.in[I_REW][((size_t)layer * DM + k) * NE + (j - 4)]; }
    float* lb = (float*)(ws + WS_LB);
    for (int i = gt; i < DM; i += ngt) { float l[DEPTH], mx = -1e30f;
#pragma unroll
        for (int q = 0; q < DEPTH; ++q) { l[q] = c.in[I_LBL][q * DM + i]; mx = fmaxf(mx, l[q]); }
        float s = 0.f, p[DEPTH];
#pragma unroll
        for (int q = 0; q < DEPTH; ++q) { p[q] = expf(l[q] - mx); s += p[q]; }
        float acc = 0.f;
#pragma unroll
        for (int q = 1; q < DEPTH; ++q) if (q <= layer) acc += p[q] / s;
        lb[i] = acc; }
}

__device__ __forceinline__ void stage_ffw(const Ctx& c, int nl, LAS float* ffw, int tid) {
    const float* wbase = c.in[I_WIN] + (size_t)nl * DM * IN_COLS + FF_COL;
#pragma unroll
    for (int q = 0; q < 2; ++q) { const int k = tid + q * NTHR; const float* wr = wbase + (size_t)k * IN_COLS; const f32x4 w0 = *(const f32x4*)wr, w1 = *(const f32x4*)(wr + 4);
        ffw[0 * DM + k] = w0[0]; ffw[1 * DM + k] = w0[1]; ffw[2 * DM + k] = w0[2]; ffw[3 * DM + k] = w0[3]; ffw[4 * DM + k] = w1[0]; ffw[5 * DM + k] = w1[1]; ffw[6 * DM + k] = w1[2]; ffw[7 * DM + k] = w1[3]; }
    __syncthreads();
}
__device__ __forceinline__ void emit_xb_ffl(const Ctx& c, int nl, int row, const f32x4 (&v)[4], int lane, const LAS float* ffw) {
    unsigned char* wsb = wsl(c); bf16_t* xb = (bf16_t*)(wsb + WS_XBF) + (size_t)row * DM;
#pragma unroll
    for (int j = 0; j < 4; ++j) { u32x2 o; o.x = cvt_pk_f16(v[j][0], v[j][1]); o.y = cvt_pk_f16(v[j][2], v[j][3]); *(u32x2*)(xb + 256 * j + 4 * lane) = o;
        *(unsigned*)(wsb + WS_XB8 + (size_t)row * DM + 256 * j + 4 * lane) = pack4_fp8(v[j][0], v[j][1], v[j][2], v[j][3]); }
    float zz = 0.f;
#pragma unroll
    for (int h = 0; h < 8; ++h) { float z = 0.f;
#pragma unroll
        for (int j = 0; j < 4; ++j) { const f32x4 wv = *(const LAS f32x4*)(ffw + h * DM + 256 * j + 4 * lane); z += (v[j][0] * wv[0] + v[j][1] * wv[1]) + (v[j][2] * wv[2] + v[j][3] * wv[3]); }
        const float s = wave_sum(z); zz = (lane == h) ? s : zz; }
    if (lane < 8) { zz += c.in[I_BFF][nl * NH + lane]; ((float*)(wsb + WS_FFL))[(size_t)row * 8 + lane] = fminf(zz, 0.f) - log1pf(expf(-fabsf(zz))); }
}
__device__ __forceinline__ void ph_xprep(const Ctx& c, LAS unsigned char* lds) {
    const Wv w = make_wv(); LAS float* ffw = (LAS float*)(lds + 1024);
    stage_ffw(c, 0, ffw, w.tid);
    static_assert(T == 16 * NWAVE * 256, "ph_xprep: 16 rows per wave at the 256-workgroup grid");
    const float* X = c.in[I_X];
#define XP_LOAD(V, i) do { const f32x4* xr_ = (const f32x4*)(X + (size_t)(w.gw + (i) * w.ngw) * DM) + w.lane; _Pragma("unroll") for (int j = 0; j < 4; ++j) V[j] = xr_[64 * j]; __builtin_amdgcn_sched_barrier(0); } while (0)
    f32x4 va[4], vb[4];
    XP_LOAD(va, 0);
#pragma unroll 1
    for (int i = 0; i < 16; i += 2) {
        XP_LOAD(vb, i + 1);
        emit_xb_ffl(c, 0, w.gw + i * w.ngw, va, w.lane, ffw); __builtin_amdgcn_sched_barrier(0);
        if (i + 2 < 16) XP_LOAD(va, i + 2);
        emit_xb_ffl(c, 0, w.gw + (i + 1) * w.ngw, vb, w.lane, ffw); __builtin_amdgcn_sched_barrier(0);
    }
#undef XP_LOAD
    __syncthreads();
}

__device__ __forceinline__ void ph_foxprep(const Ctx& c, int layer, LAS unsigned char* lds) {
    const Wv w = make_wv(); unsigned char* ws = wsl(c);
    LAS float* wtot = (LAS float*)lds;
    const float* ffl = (const float*)(ws + WS_FFL); float* kb = (float*)(ws + WS_KBIAS);
    for (int seq = bidx(); seq < NB * NH; seq += gridDim.x) { const int b = seq >> 3, h = seq & 7;
        float loc[16], run = 0.f;
#pragma unroll
        for (int i = 0; i < 16; ++i) { run += ffl[((size_t)(b * SEQ + w.tid * 16 + i)) * 8 + h]; loc[i] = run; }
        float incl = run;
#pragma unroll
        for (int o = 1; o < 16; o <<= 1) incl += dpp_shr(incl, o);
        incl += DPPF(incl, 0x142, 0xA, false); incl += DPPF(incl, 0x143, 0xC, false);
        __syncthreads();
        if (w.lane == 63) wtot[w.wave] = incl;
        __syncthreads();
        float pre = incl - run;
        for (int q = 0; q < w.wave; ++q) pre += wtot[q];
#pragma unroll
        for (int i = 0; i < 16; ++i) kb[(size_t)seq * SEQ + w.tid * 16 + i] = -(pre + loc[i]) * SQRT_DH;
    }
}

constexpr int RW_PITCH = DM + 8;
constexpr int L1_W = 0, L1_WL = 36 * RW_PITCH * 2, L1_C = 2 * L1_WL, L1_CP = L1_C + 384, L1_ST = L1_CP + 4608, L1_CNT = L1_ST + 1024;
static_assert(L1_CNT + 256 <= LDS_MISC, "ln1 LDS map");
__device__ __forceinline__ void ph_ln1_router(const Ctx& c, int layer, LAS unsigned char* lds) {
    const Wv w = make_wv(); unsigned char* ws = wsl(c);
    LAS _Float16* Wh = (LAS _Float16*)(lds + L1_W); LAS _Float16* Wl = (LAS _Float16*)(lds + L1_WL); LAS float* c1 = (LAS float*)(lds + L1_C); LAS float* c2 = c1 + 48; LAS float* cp = (LAS float*)(lds + L1_CP);
    LAS float* st = (LAS float*)(lds + L1_ST); LAS unsigned* lcnt = (LAS unsigned*)(lds + L1_CNT); LAS unsigned* lbase = lcnt + 32;
    const float* g1 = c.in[I_L1G] + layer * DM; const float* b1 = c.in[I_L1B] + layer * DM; const float* rwt = (const float*)(ws + WS_RWT);
    const float* rgb = c.in[I_RGB] + layer * NG; const float* reb = c.in[I_REB] + layer * NE;
    for (int p = w.tid; p < 36 * 16; p += NTHR) { const int n = p >> 4, ch = p & 15; float s1 = 0.f, s2 = 0.f;
#pragma unroll 4
        for (int i = 0; i < 16; ++i) { const int k = ch * 64 + 4 * i; const f32x4 wv = *(const f32x4*)(rwt + n * DM + k), g = *(const f32x4*)(g1 + k), bb = *(const f32x4*)(b1 + k);
            const f32x4 wg = wv * g, wb = wv * bb; s1 += (wg[0] + wg[1]) + (wg[2] + wg[3]); s2 += (wb[0] + wb[1]) + (wb[2] + wb[3]);
            const f16v4_t hi = __builtin_convertvector(wg, f16v4_t); const f32x4 res = (wg - __builtin_convertvector(hi, f32x4)) * 2048.f; const f16v4_t lo = __builtin_convertvector(res, f16v4_t);
            *(LAS f16v4_t*)(Wh + n * RW_PITCH + k) = hi; *(LAS f16v4_t*)(Wl + n * RW_PITCH + k) = lo; }
        cp[(n * 16 + ch) * 2] = s1; cp[(n * 16 + ch) * 2 + 1] = s2; }
    if (w.tid < 64) lcnt[w.tid] = 0u;
    __syncthreads();
    if (w.tid < 36) { float s1 = 0.f, s2 = 0.f;
        for (int ch = 0; ch < 16; ++ch) { s1 += cp[(w.tid * 16 + ch) * 2]; s2 += cp[(w.tid * 16 + ch) * 2 + 1]; }
        c1[w.tid] = s1; c2[w.tid] = s2 + (w.tid < 4 ? rgb[w.tid] : reb[w.tid - 4]); }
    __syncthreads();
    const int x = w.lane & 15, kq = w.lane >> 4, row0 = w.gw * 16;
    bf16_t* Y = (bf16_t*)(ws + WS_YX);
    const bf16_t* yrow = Y + (size_t)(row0 + x) * DM + 8 * kq;
    const int wo0 = x * RW_PITCH + 8 * kq, wo1 = (16 + x) * RW_PITCH + 8 * kq, wo2 = (32 + x < 36 ? 32 + x : 35) * RW_PITCH + 8 * kq;
    f32x4 acc0 = {0.f, 0.f, 0.f, 0.f}, acc1 = acc0, acc2 = acc0, lo0 = acc0, lo1 = acc0, lo2 = acc0; float s1 = 0.f, s2 = 0.f;
    u32x4 ybuf[4];
#pragma unroll
    for (int u = 0; u < 4; ++u) ybuf[u] = *(const u32x4*)(yrow + 32 * u);
    for (int s0 = 0; s0 < 32; s0 += 4) {
#pragma unroll
        for (int u = 0; u < 4; ++u) { const int s = s0 + u; const u32x4 yr = ybuf[u];
            if (s + 4 < 32) ybuf[u] = *(const u32x4*)(yrow + 32 * (s + 4));
            const f32x4 ya = unpack_f16x4(yr.x, yr.y), yb = unpack_f16x4(yr.z, yr.w);
            s1 += ((ya[0] + ya[1]) + (ya[2] + ya[3])) + ((yb[0] + yb[1]) + (yb[2] + yb[3]));
            s2 += ((ya[0] * ya[0] + ya[1] * ya[1]) + (ya[2] * ya[2] + ya[3] * ya[3])) + ((yb[0] * yb[0] + yb[1] * yb[1]) + (yb[2] * yb[2] + yb[3] * yb[3]));
            const f16v8_t ay = __builtin_bit_cast(f16v8_t, yr);
            const f16v8_t h0 = *(const LAS f16v8_t*)(Wh + wo0 + 32 * s), h1 = *(const LAS f16v8_t*)(Wh + wo1 + 32 * s), h2 = *(const LAS f16v8_t*)(Wh + wo2 + 32 * s);
            const f16v8_t l0 = *(const LAS f16v8_t*)(Wl + wo0 + 32 * s), l1 = *(const LAS f16v8_t*)(Wl + wo1 + 32 * s), l2 = *(const LAS f16v8_t*)(Wl + wo2 + 32 * s);
            acc0 = __builtin_amdgcn_mfma_f32_16x16x32_f16(ay, h0, acc0, 0, 0, 0); acc1 = __builtin_amdgcn_mfma_f32_16x16x32_f16(ay, h1, acc1, 0, 0, 0); acc2 = __builtin_amdgcn_mfma_f32_16x16x32_f16(ay, h2, acc2, 0, 0, 0);
            lo0 = __builtin_amdgcn_mfma_f32_16x16x32_f16(ay, l0, lo0, 0, 0, 0); lo1 = __builtin_amdgcn_mfma_f32_16x16x32_f16(ay, l1, lo1, 0, 0, 0); lo2 = __builtin_amdgcn_mfma_f32_16x16x32_f16(ay, l2, lo2, 0, 0, 0); } }
    acc0 += lo0 * (1.f / 2048.f); acc1 += lo1 * (1.f / 2048.f); acc2 += lo2 * (1.f / 2048.f);
    s1 += bperm(s1, w.lane ^ 16); s1 += bperm(s1, w.lane ^ 32); s2 += bperm(s2, w.lane ^ 16); s2 += bperm(s2, w.lane ^ 32);
    { const float mean = s1 * (1.f / DM), var = fmaxf(s2 * (1.f / DM) - mean * mean, 0.f);
      if (kq == 0) { st[(w.wave * 16 + x) * 2] = mean; st[(w.wave * 16 + x) * 2 + 1] = rsqrtf(var + LN_EPS); } }
    __syncthreads();
    LAS float* Lw = (LAS float*)lds + w.wave * 640;
#pragma unroll
    for (int r = 0; r < 4; ++r) { const int row = 4 * kq + r; const float mean = st[(w.wave * 16 + row) * 2], rstd = st[(w.wave * 16 + row) * 2 + 1];
        Lw[row * 40 + x] = rstd * (acc0[r] - mean * c1[x]) + c2[x]; Lw[row * 40 + 16 + x] = rstd * (acc1[r] - mean * c1[16 + x]) + c2[16 + x];
        if (x < 4) Lw[row * 40 + 32 + x] = rstd * (acc2[r] - mean * c1[32 + x]) + c2[32 + x]; }
    asm volatile("s_waitcnt lgkmcnt(0)" ::: "memory");
    int* tope = (int*)(ws + WS_TOPE); float* topw = (float*)(ws + WS_TOPW); int* tpos = (int*)(ws + WS_TPOS); int* ste = (int*)(ws + WS_STE);
    if (w.lane < 16) { const int m = row0 + w.lane; const LAS float* L = Lw + w.lane * 40;
        float gl[4];
#pragma unroll
        for (int q = 0; q < 4; ++q) gl[q] = L[q];
        int grp = 0; float gm = gl[0];
#pragma unroll
        for (int q = 1; q < 4; ++q) if (gl[q] > gm) { gm = gl[q]; grp = q; }
        float gs = 0.f;
#pragma unroll
        for (int q = 0; q < 4; ++q) gs += expf(gl[q] - gm);
        const float pg = 1.f / gs;
        float el[8];
#pragma unroll
        for (int i = 0; i < 8; ++i) el[i] = L[4 + grp * EPG + i];
        int i0 = 0; float v0 = el[0];
#pragma unroll
        for (int i = 1; i < 8; ++i) if (el[i] > v0) { v0 = el[i]; i0 = i; }
        int i1 = -1; float v1 = -3.0e38f;
#pragma unroll
        for (int i = 0; i < 8; ++i) if (i != i0 && el[i] > v1) { v1 = el[i]; i1 = i; }
        const float w0 = 1.f / (1.f + expf(v1 - v0));
        const int e0 = grp * EPG + i0, e1 = grp * EPG + i1;
        tope[2 * m] = e0; tope[2 * m + 1] = e1; topw[2 * m] = w0 * pg; topw[2 * m + 1] = (1.f - w0) * pg;
        tpos[2 * m] = (int)atomicAdd((unsigned*)&lcnt[e0], 1u); tpos[2 * m + 1] = (int)atomicAdd((unsigned*)&lcnt[e1], 1u); }
    f32x4 gg[4], bb[4];
#pragma unroll
    for (int j = 0; j < 4; ++j) { gg[j] = *(const f32x4*)(g1 + 256 * j + 4 * w.lane); bb[j] = *(const f32x4*)(b1 + 256 * j + 4 * w.lane); }
#define L1_LOAD(R, g) do { _Pragma("unroll") for (int r = 0; r < 4; ++r) _Pragma("unroll") for (int j = 0; j < 4; ++j) R[r][j] = *(const u32x2*)(Y + (size_t)(row0 + 4 * (g) + r) * DM + 256 * j + 4 * w.lane); \
        __builtin_amdgcn_sched_barrier(0); } while (0)
#define L1_APPLY(R, g) do { const int m0 = row0 + 4 * (g);                                                                                                       \
        _Pragma("unroll") for (int r = 0; r < 4; ++r) { const float mean = st[(w.wave * 16 + 4 * (g) + r) * 2], rstd = st[(w.wave * 16 + 4 * (g) + r) * 2 + 1];   \
            _Pragma("unroll") for (int j = 0; j < 4; ++j) { const f32x4 v = (unpack_f16x4(R[r][j].x, R[r][j].y) - mean) * rstd * gg[j] + bb[j];                   \
                u32x2 o; o.x = cvt_pk_f16(v[0], v[1]); o.y = cvt_pk_f16(v[2], v[3]); *(u32x2*)(Y + (size_t)(m0 + r) * DM + 256 * j + 4 * w.lane) = o;            \
                *(unsigned*)(ws + WS_X18 + (size_t)(m0 + r) * DM + 256 * j + 4 * w.lane) = pack4_fp8(v[0], v[1], v[2], v[3]); } }                                 \
        __builtin_amdgcn_sched_barrier(0); } while (0)
    { u32x2 ra[4][4], rb[4][4];
      L1_LOAD(ra, 0); L1_LOAD(rb, 1); L1_APPLY(ra, 0); L1_LOAD(ra, 2); L1_APPLY(rb, 1); L1_LOAD(rb, 3); L1_APPLY(ra, 2); L1_APPLY(rb, 3); }
#undef L1_LOAD
#undef L1_APPLY
    __syncthreads();
    if (w.tid < NE) lbase[w.tid] = atomicAdd((unsigned*)(ws + WS_CTL) + CW_CNT + layer * 64 + w.tid, lcnt[w.tid]);
    __syncthreads();
    if (w.lane < 32) { const int m = row0 + (w.lane >> 1), k = w.lane & 1; const int e = tope[2 * m + k]; const int p = tpos[2 * m + k] + (int)lbase[e]; tpos[2 * m + k] = p; ste[(size_t)e * T + p] = m; }
}

__device__ __forceinline__ void moe_starts(const Ctx& c, int layer, LAS int* start  , LAS int* cnt  ) {
    const unsigned* gc = (const unsigned*)(wsl(c) + WS_CTL) + CW_CNT + layer * 64;
    if (threadIdx.x < NE) cnt[threadIdx.x] = (int)__hip_atomic_load(gc + threadIdx.x, __ATOMIC_RELAXED, __HIP_MEMORY_SCOPE_AGENT);
    __syncthreads();
    if (threadIdx.x == 0) { int s = 0;
        for (int e = 0; e < NE; ++e) { const int n = cnt[e]; start[e] = s; s += (n + 255) & ~255; }
        start[NE] = s; }
    __syncthreads();
}

__device__ __forceinline__ void ph_ln2(const Ctx& c, int layer, LAS unsigned char* lds, float oscale = 1.f) {
    const Wv w = make_wv(); unsigned char* ws = wsl(c);
    LAS int* start = (LAS int*)lds; LAS int* cnt = start + 40; LAS float* ffw = (LAS float*)(lds + 1024);
    if (layer + 1 < DEPTH) stage_ffw(c, layer + 1, ffw, w.tid);
    moe_starts(c, layer, start, cnt);
    const bf16_t* X1 = (const bf16_t*)(ws + WS_YX); const bf16_t* YB = (const bf16_t*)(ws + WS_YB);
    const int* tope = (const int*)(ws + WS_TOPE); const float* topw = (const float*)(ws + WS_TOPW); const int* tpos = (const int*)(ws + WS_TPOS);
    const float* g2 = c.in[I_L2G] + layer * DM; const float* b2 = c.in[I_L2B] + layer * DM;
    float* dst = c.outp();
    for (int mA = w.gw; mA < T; mA += 2 * w.ngw) { const int mB = mA + w.ngw;
        int mm[2] = {mA, mB}; size_t s0[2], s1[2]; float w0[2], w1[2];
#pragma unroll
        for (int q = 0; q < 2; ++q) { const int m = mm[q]; const int e0 = tope[2 * m], e1 = tope[2 * m + 1]; w0[q] = topw[2 * m]; w1[q] = topw[2 * m + 1];
            s0[q] = (size_t)(start[e0] + tpos[2 * m]); s1[q] = (size_t)(start[e1] + tpos[2 * m + 1]); }
        u32x2 xr[2][4], ar[2][4], br[2][4];
#pragma unroll
        for (int q = 0; q < 2; ++q)
#pragma unroll
            for (int j = 0; j < 4; ++j) { xr[q][j] = *(const u32x2*)(X1 + (size_t)mm[q] * DM + 256 * j + 4 * w.lane);
                ar[q][j] = *(const u32x2*)(YB + s0[q] * DM + 256 * j + 4 * w.lane); br[q][j] = *(const u32x2*)(YB + s1[q] * DM + 256 * j + 4 * w.lane); }
#pragma unroll
        for (int q = 0; q < 2; ++q) { const int m = mm[q]; f32x4 v[4]; float s = 0.f;
#pragma unroll
            for (int j = 0; j < 4; ++j) { const f32x4 x = unpack_f16x4(xr[q][j].x, xr[q][j].y); const u32x2 a = ar[q][j], b = br[q][j];
                f32x4 ya, yb; ya[0] = __uint_as_float(a.x << 16); ya[1] = __uint_as_float(a.x & 0xffff0000u); ya[2] = __uint_as_float(a.y << 16); ya[3] = __uint_as_float(a.y & 0xffff0000u);
                yb[0] = __uint_as_float(b.x << 16); yb[1] = __uint_as_float(b.x & 0xffff0000u); yb[2] = __uint_as_float(b.y << 16); yb[3] = __uint_as_float(b.y & 0xffff0000u);
                v[j] = x * ALPHA + (ya * w0[q] + yb * w1[q]); s += (v[j][0] + v[j][1]) + (v[j][2] + v[j][3]); }
            const float mean = wave_sum(s) * (1.f / DM); float s2 = 0.f;
#pragma unroll
            for (int j = 0; j < 4; ++j) { v[j] = v[j] - mean; s2 += (v[j][0] * v[j][0] + v[j][1] * v[j][1]) + (v[j][2] * v[j][2] + v[j][3] * v[j][3]); }
            const float rstd = rsqrtf(wave_sum(s2) * (1.f / DM) + LN_EPS);
#pragma unroll
            for (int j = 0; j < 4; ++j) { const f32x4 g = *(const f32x4*)(g2 + 256 * j + 4 * w.lane), bb = *(const f32x4*)(b2 + 256 * j + 4 * w.lane);
                v[j] = v[j] * rstd * g + bb; if (layer == DEPTH - 1) *((f32x4*)(dst + (size_t)m * DM) + w.lane + 64 * j) = v[j] * oscale; }
            if (layer + 1 < DEPTH) emit_xb_ffl(c, layer + 1, m, v, w.lane, ffw); }
    }
}


namespace pg8 {
typedef short bf16x8 __attribute__((ext_vector_type(8)));
typedef int v8i_t __attribute__((ext_vector_type(8)));
typedef int i32x4_t __attribute__((ext_vector_type(4)));
constexpr int BM = 256, BK = 64, HALF = 128, HTB = HALF * BK * 2, STAGE_BYTES = 8 * HTB, NXCD = 8, WGM = 8;
__host__ __device__ __forceinline__ int lds_byte(int r, int c) { const int st = (r >> 4) * 2 + (c >> 5), rr = r & 15, cc = c & 31, ob = rr * 64 + cc * 2; return st * 1024 + (ob ^ (((ob >> 9) & 1) << 5)); }
__host__ __device__ __forceinline__ void stage_rc(int b, int& R, int& C) { const int st = b / 1024, sb = b % 1024, swz = sb ^ (((sb >> 9) & 1) << 5); R = (st >> 1) * 16 + swz / 64; C = (st & 1) * 32 + (swz % 64) / 2; }
__host__ __device__ __forceinline__ int perm32(int rho) { const int n = rho >> 4, i = rho & 15; return 8 * (i >> 2) + 4 * n + (i & 3); }
struct Unit { int pm, pn, e, rt; };
using ::cvt_pk_bf16;

struct StaticOrder {
    static constexpr bool GATHER = false;
    const char* A; const char* Bt; int nM, nN, nwg, G, c; size_t a_tstep, b_tstep;
    __device__ void init(const void* A_, const void* Bt_, int M, int N, int K, int G_, int c_, int elt_bytes = 2) { A = (const char*)A_; Bt = (const char*)Bt_; nM = M / BM; nN = N / BM; nwg = nM * nN; G = G_; c = c_; a_tstep = (size_t)BM * K * elt_bytes; b_tstep = a_tstep; }
    __device__ bool next(int i, Unit& u) const {
        const long L = (long)i * G + c; if (L >= nwg) return false;
        int wgid = (int)L; { const int q = nwg / NXCD, r = nwg % NXCD, xcd = wgid % NXCD, off = wgid / NXCD; wgid = (xcd < r ? xcd * (q + 1) : r * (q + 1) + (xcd - r) * q) + off; }
        const int nig = WGM * nN, gid = wgid / nig, fm = gid * WGM, gsz = (nM - fm) < WGM ? (nM - fm) : WGM;
        u.pm = fm + ((wgid % nig) % gsz); u.pn = (wgid % nig) / gsz; u.e = 0; u.rt = 0; return true;
    }
    __device__ __forceinline__ const char* a_base(const Unit& u) const { return A + (size_t)u.pm * a_tstep; }
    __device__ __forceinline__ const char* b_base(const Unit& u) const { return Bt + (size_t)u.pn * b_tstep; }
    __device__ __forceinline__ int tok(const Unit&, int) const { return 0; }
};
template <bool UP> struct MoeOrder {
    static constexpr bool GATHER = UP;
    const char* A; const char* Bt; const int* ste; LAS const int* tp; LAS const int* start; LAS const int* cnt; int G, c;
    __device__ bool next(int i, Unit& u) const {
        const int L = i * G + c; if (L >= tp[NE] * 4) return false;
        const int rtg = L >> 2; int e = 0;
        for (int q = 1; q < NE; ++q) if (rtg >= tp[q]) e = q;
        u.e = e; u.rt = rtg - tp[e]; u.pm = (start[e] >> 8) + u.rt; u.pn = L & 3; return true;
    }
    __device__ __forceinline__ const char* a_base(const Unit& u) const { return UP ? A : A + (size_t)u.pm * (BM * DE); }
    __device__ __forceinline__ const char* b_base(const Unit& u) const { return Bt + ((size_t)u.e * 1024 + u.pn * 256) * (UP ? DM : DE); }
    __device__ __forceinline__ int tok(const Unit& u, int r) const { const int i = u.rt * 256 + r; return i < cnt[u.e] ? ste[(size_t)u.e * T + i] : 0; }
};

template <int ACT> __device__ __forceinline__ float actf(float x) {
    if (ACT == 1) return x * __builtin_amdgcn_rcpf(1.f + __expf(-x));
    if (ACT == 2) return __builtin_amdgcn_rcpf(1.f + __expf(-x));
    return x;
}
template <int ACT> __device__ __forceinline__ f32x4 act4(const f32x4 x) {
    if (ACT == 0) return x;
    const f32x4 t = x * -1.4426950408889634f;
    const f32x4 e = {__builtin_amdgcn_exp2f(t[0]), __builtin_amdgcn_exp2f(t[1]), __builtin_amdgcn_exp2f(t[2]), __builtin_amdgcn_exp2f(t[3])};
    const f32x4 d = e + 1.f;
    const f32x4 r = {__builtin_amdgcn_rcpf(d[0]), __builtin_amdgcn_rcpf(d[1]), __builtin_amdgcn_rcpf(d[2]), __builtin_amdgcn_rcpf(d[3])};
    return ACT == 1 ? x * r : r;
}
template <int ACT> __device__ __forceinline__ u32x4 pack8_act(const f32x4 a, const f32x4 b) {
    u32x4 w; w.x = cvt_pk_bf16(actf<ACT>(a[0]), actf<ACT>(a[1])); w.y = cvt_pk_bf16(actf<ACT>(a[2]), actf<ACT>(a[3])); w.z = cvt_pk_bf16(actf<ACT>(b[0]), actf<ACT>(b[1])); w.w = cvt_pk_bf16(actf<ACT>(b[2]), actf<ACT>(b[3])); return w;
}
__device__ __forceinline__ void unpack8(const u32x4 r, f32x4& a, f32x4& b) {
    a[0] = __uint_as_float(r.x << 16); a[1] = __uint_as_float(r.x & 0xffff0000u); a[2] = __uint_as_float(r.y << 16); a[3] = __uint_as_float(r.y & 0xffff0000u);
    b[0] = __uint_as_float(r.z << 16); b[1] = __uint_as_float(r.z & 0xffff0000u); b[2] = __uint_as_float(r.w << 16); b[3] = __uint_as_float(r.w & 0xffff0000u);
}
struct EpiInProj {
    static constexpr bool PERM = true;
    InProjOut o; float sc;
    const float* gq; const float* gk; LAS float* xch; int lane;
    template <int ACT, bool HM> __device__ __forceinline__ void st16(bf16_t* base, const f32x4 (&acc)[2][2][4][2], int row0, int ctile, int wc, int fq) const {
#pragma unroll
        for (int ai = 0; ai < 2; ++ai)
#pragma unroll
            for (int m = 0; m < 4; ++m) { const int row = row0 + ai * HALF + m * 16;
                const size_t ro = HM ? ((size_t)((row >> 13) * (NH * SEQ) + (row & (SEQ - 1)))) * DH : (size_t)row * DM;
#pragma unroll
                for (int bj = 0; bj < 2; ++bj) { const int c0 = ctile + 128 * bj + 32 * wc + 8 * fq;
                    const size_t co = HM ? (size_t)(c0 >> 7) * SEQ * DH + (c0 & 127) : (size_t)c0;
                    *(u32x4*)(base + ro + co) = pack8_act<ACT>(acc[ai][bj][m][0] * sc, acc[ai][bj][m][1] * sc); } }
    }
    template <int ACT> __device__ __forceinline__ void st8(unsigned char* base, const f32x4 (&acc)[2][2][4][2], int row0, int ctile, int wc, int fq) const {
#pragma unroll
        for (int ai = 0; ai < 2; ++ai)
#pragma unroll
            for (int m = 0; m < 4; ++m)
#pragma unroll
                for (int bj = 0; bj < 2; ++bj) { const f32x4 a = act4<ACT>(acc[ai][bj][m][0] * sc), b = act4<ACT>(acc[ai][bj][m][1] * sc); u32x2 w;
                    w.x = pack4_fp8(a[0], a[1], a[2], a[3]); w.y = pack4_fp8(b[0], b[1], b[2], b[3]);
                    *(u32x2*)(base + (size_t)(row0 + ai * HALF + m * 16) * DM + ctile + 128 * bj + 32 * wc + 8 * fq) = w; }
    }
    template <bool HM> __device__ __forceinline__ void st_norm(bf16_t* base, const float* gain, const f32x4 (&acc)[2][2][4][2], int row0, int ctile, int wr, int wc, int fr, int fq, int par) const {
        LAS float* tb = xch + par * 2048;
#pragma unroll
        for (int ai = 0; ai < 2; ++ai)
#pragma unroll
            for (int m = 0; m < 4; ++m)
#pragma unroll
                for (int bj = 0; bj < 2; ++bj) { const f32x4 a = acc[ai][bj][m][0], b = acc[ai][bj][m][1];
                    float ss = ((a[0] * a[0] + a[1] * a[1]) + (a[2] * a[2] + a[3] * a[3])) + ((b[0] * b[0] + b[1] * b[1]) + (b[2] * b[2] + b[3] * b[3]));
                    ss += bperm(ss, lane ^ 16); ss += bperm(ss, lane ^ 32);
                    if (fq == 0) tb[((ai * HALF + wr * 64 + m * 16 + fr) * 2 + bj) * 4 + wc] = ss; }
        asm volatile("s_waitcnt lgkmcnt(0)" ::: "memory"); __builtin_amdgcn_s_barrier(); asm volatile("" ::: "memory");
#pragma unroll
        for (int bj = 0; bj < 2; ++bj) { const int c0 = ctile + 128 * bj + 32 * wc + 8 * fq; const f32x4 g0 = *(const f32x4*)(gain + (c0 & 127)), g1 = *(const f32x4*)(gain + (c0 & 127) + 4);
            const size_t co = HM ? (size_t)(c0 >> 7) * SEQ * DH + (c0 & 127) : (size_t)c0;
#pragma unroll
            for (int ai = 0; ai < 2; ++ai)
#pragma unroll
                for (int m = 0; m < 4; ++m) { const int row = row0 + ai * HALF + m * 16;
                    const f32x4 ps = *(const LAS f32x4*)(tb + ((ai * HALF + wr * 64 + m * 16 + fr) * 2 + bj) * 4);
                    const float r = rsqrtf(((ps[0] + ps[1]) + (ps[2] + ps[3])) * (sc * sc * (1.f / DH)) + NORM_EPS) * sc;
                    const size_t ro = HM ? ((size_t)((row >> 13) * (NH * SEQ) + (row & (SEQ - 1)))) * DH : (size_t)row * DM;
                    *(u32x4*)(base + ro + co) = pack8_act<0>(acc[ai][bj][m][0] * r * g0, acc[ai][bj][m][1] * r * g1); } }
    }
    __device__ __forceinline__ bool operator()(const f32x4 (&acc)[2][2][4][2], const Unit& u, int wr, int wc, int fr, int fq) const {
        const int region = u.pn >> 2, ctile = (u.pn & 3) * 256, row0 = u.pm * BM + wr * 64 + fr;
        if (region == 0) st8<1>(o.QA, acc, row0, ctile, wc, fq);
        else if (region == 2) st8<0>(o.VA, acc, row0, ctile, wc, fq);
        else if (region == 3) st8<1>(o.GA, acc, row0, ctile, wc, fq);
        else if (region == 4) st_norm<false>(o.FQ, gq, acc, row0, ctile, wr, wc, fr, fq, 0);
        else if (region == 5) st_norm<true>(o.FK, gk, acc, row0, ctile, wr, wc, fr, fq, 1);
        else if (region == 6) st16<0, true>(o.FV, acc, row0, ctile, wc, fq);
        else if (region == 7) st8<2>(o.SGA, acc, row0, ctile, wc, fq);
        else if (region == 8) st8<2>(o.SGB, acc, row0, ctile, wc, fq);
        else {
#pragma unroll
            for (int bj = 0; bj < 2; ++bj) { const int c0 = ctile + 128 * bj + 32 * wc + 8 * fq;
                const f32x4 l0 = *(const f32x4*)(o.lb + c0), l1 = *(const f32x4*)(o.lb + c0 + 4);
#pragma unroll
                for (int ai = 0; ai < 2; ++ai)
#pragma unroll
                    for (int m = 0; m < 4; ++m) { const int row = row0 + ai * HALF + m * 16; bf16_t* p = o.LF + (size_t)row * DM + c0;
                        f32x4 r0, r1;
#pragma unroll
                        for (int j = 0; j < 4; ++j) { r0[j] = __logf(l0[j] + (1.f - l0[j]) * actf<2>(acc[ai][bj][m][0][j] * sc)); r1[j] = __logf(l1[j] + (1.f - l1[j]) * actf<2>(acc[ai][bj][m][1][j] * sc)); }
                        u32x4 w; w.x = cvt_pk_f16(r0[0], r0[1]); w.y = cvt_pk_f16(r0[2], r0[3]); w.z = cvt_pk_f16(r1[0], r1[1]); w.w = cvt_pk_f16(r1[2], r1[3]); *(u32x4*)p = w; } }
        }
        return false;
    }
};
struct EpiMergeChain {
    static constexpr bool PERM = true;
    const unsigned char* sga; const unsigned char* sgb; unsigned char* MG; float sc;
    __device__ __forceinline__ bool operator()(f32x4 (&acc)[2][2][4][2], const Unit& u, int wr, int wc, int fr, int fq) const {
        const int row0 = u.pm * BM + wr * 64 + fr, cb = u.pn * BM + 32 * wc + 8 * fq;
#pragma unroll
        for (int ai = 0; ai < 2; ++ai) { u32x2 gb[4][2], ga[4][2];
#pragma unroll
            for (int m = 0; m < 4; ++m)
#pragma unroll
                for (int bj = 0; bj < 2; ++bj) { const size_t i = (size_t)(row0 + ai * HALF + m * 16) * DM + cb + 128 * bj; gb[m][bj] = *(const u32x2*)(sgb + i); if (u.e == 0) ga[m][bj] = *(const u32x2*)(sga + i); }
#pragma unroll
            for (int m = 0; m < 4; ++m)
#pragma unroll
                for (int bj = 0; bj < 2; ++bj) { const size_t i = (size_t)(row0 + ai * HALF + m * 16) * DM + cb + 128 * bj; const f32x4 b0 = unpack4_fp8(gb[m][bj].x), b1 = unpack4_fp8(gb[m][bj].y);
                    if (u.e == 0) { const f32x4 a0 = unpack4_fp8(ga[m][bj].x), a1 = unpack4_fp8(ga[m][bj].y);
#pragma unroll
                        for (int j = 0; j < 4; ++j) { acc[ai][bj][m][0][j] *= a0[j] * __builtin_amdgcn_rcpf(fmaxf(b0[j], 1e-30f)); acc[ai][bj][m][1][j] *= a1[j] * __builtin_amdgcn_rcpf(fmaxf(b1[j], 1e-30f)); } }
                    else { const f32x4 y0 = acc[ai][bj][m][0] * b0 * sc, y1 = acc[ai][bj][m][1] * b1 * sc; u32x2 w; w.x = pack4_fp8(y0[0], y0[1], y0[2], y0[3]); w.y = pack4_fp8(y1[0], y1[1], y1[2], y1[3]); *(u32x2*)(MG + i) = w; } }
            asm volatile("" ::: "memory"); }
        return u.e == 0;
    }
};
struct MergeOrder {
    static constexpr bool GATHER = false;
    StaticOrder base; const char* A2; const char* B2;
    __device__ bool next(int i, Unit& u) const { if (!base.next(i >> 1, u)) return false; u.e = i & 1; return true; }
    __device__ __forceinline__ const char* a_base(const Unit& u) const { return (u.e ? A2 : base.A) + (size_t)u.pm * base.a_tstep; }
    __device__ __forceinline__ const char* b_base(const Unit& u) const { return (u.e ? B2 : base.Bt) + (size_t)u.pn * base.b_tstep; }
    __device__ __forceinline__ int tok(const Unit&, int) const { return 0; }
};
struct EpiOut {
    static constexpr bool PERM = true;
    const bf16_t* x; bf16_t* Y; float sc;
    __device__ __forceinline__ bool operator()(const f32x4 (&acc)[2][2][4][2], const Unit& u, int wr, int wc, int fr, int fq) const {
        const int row0 = u.pm * BM + wr * 64 + fr, cb = u.pn * BM + 32 * wc + 8 * fq;
#pragma unroll
        for (int ai = 0; ai < 2; ++ai) { u32x4 xv[4][2];
#pragma unroll
            for (int m = 0; m < 4; ++m)
#pragma unroll
                for (int bj = 0; bj < 2; ++bj) xv[m][bj] = *(const u32x4*)(x + (size_t)(row0 + ai * HALF + m * 16) * DM + cb + 128 * bj);
#pragma unroll
            for (int m = 0; m < 4; ++m)
#pragma unroll
                for (int bj = 0; bj < 2; ++bj) { f32x4 x0, x1; const u32x4 r = xv[m][bj];
                    x0 = unpack_f16x4(r.x, r.y); x1 = unpack_f16x4(r.z, r.w);
                    const f32x4 y0 = x0 * ALPHA + acc[ai][bj][m][0] * sc, y1 = x1 * ALPHA + acc[ai][bj][m][1] * sc;
                    u32x4 w; w.x = cvt_pk_f16(y0[0], y0[1]); w.y = cvt_pk_f16(y0[2], y0[3]); w.z = cvt_pk_f16(y1[0], y1[1]); w.w = cvt_pk_f16(y1[2], y1[3]);
                    *(u32x4*)(Y + (size_t)(row0 + ai * HALF + m * 16) * DM + cb + 128 * bj) = w; }
            asm volatile("" ::: "memory"); }
        return false;
    }
};
struct EpiMoeUp {
    static constexpr bool PERM = true;
    unsigned char* HB; float sc;
    __device__ __forceinline__ bool operator()(const f32x4 (&acc)[2][2][4][2], const Unit& u, int wr, int wc, int fr, int fq) const {
        const int row0 = u.pm * BM + wr * 64 + fr, j0 = u.pn * 128 + 32 * wc + 8 * fq;
#pragma unroll
        for (int ai = 0; ai < 2; ++ai)
#pragma unroll
            for (int m = 0; m < 4; ++m) { f32x4 h0, h1;
                h0 = act4<1>(acc[ai][0][m][0] * sc) * (acc[ai][1][m][0] * sc); h1 = act4<1>(acc[ai][0][m][1] * sc) * (acc[ai][1][m][1] * sc);
                u32x2 w; w.x = pack4_fp8(h0[0], h0[1], h0[2], h0[3]); w.y = pack4_fp8(h1[0], h1[1], h1[2], h1[3]);
                *(u32x2*)(HB + (size_t)(row0 + ai * HALF + m * 16) * DE + j0) = w; }
        return false;
    }
};
struct EpiMoeDn {
    static constexpr bool PERM = true;
    bf16_t* YB; float sc;
    __device__ __forceinline__ bool operator()(const f32x4 (&acc)[2][2][4][2], const Unit& u, int wr, int wc, int fr, int fq) const {
        const int row0 = u.pm * BM + wr * 64 + fr, cb = u.pn * BM + 32 * wc + 8 * fq;
#pragma unroll
        for (int ai = 0; ai < 2; ++ai)
#pragma unroll
            for (int m = 0; m < 4; ++m)
#pragma unroll
                for (int bj = 0; bj < 2; ++bj) *(u32x4*)(YB + (size_t)(row0 + ai * HALF + m * 16) * DM + cb + 128 * bj) = pack8_act<0>(acc[ai][bj][m][0] * sc, acc[ai][bj][m][1] * sc);
        return false;
    }
};

template <int K, class Epi, class Sched, bool F8 = false>
__device__ __forceinline__ void gemm_phase(LAS unsigned char* lds, const Sched& S, const Epi& E) {
    const int tid = tidx(), wid = __builtin_amdgcn_readfirstlane(tid >> 6), lane = tid & 63, wr = wid >> 2, wc = wid & 3, fr = lane & 15, fq = lane >> 4;
    constexpr int RB = F8 ? K : K * 2, nt = RB / 128;
    int RA[2]; unsigned CA2[2], voffB[2], voffA[2][2], voffN[2][2];
#pragma unroll
    for (int i = 0; i < 2; ++i) { int R, C2;
        if (F8) { const int q = tid + 512 * i; R = 16 * (q >> 7) + (q & 15); C2 = (2 * ((q >> 4) & 3) + ((q >> 6) & 1)) * 16; }
        else { int C; stage_rc(tid * 16 + i * 8192, R, C); C2 = 2 * C; }
        const int Rb = Epi::PERM ? ((R & ~31) + perm32(R & 31)) : R;
        RA[i] = R; CA2[i] = (unsigned)C2; voffB[i] = (unsigned)(Rb * RB + C2); }
    const size_t kstep = (size_t)128, hstepB = (size_t)HALF * RB;
    const unsigned ldsw = (unsigned)wid * 1024u;
    const int aoff = F8 ? (4 * wr) * 2048 + lane * 16 : lds_byte(wr * 64 + fr, fq * 8), boff = F8 ? (2 * wc) * 2048 + lane * 16 : lds_byte(wc * 32 + fr, fq * 8);
#define PG8_SA(b, h) (((b) * 2 + (h)) * HTB)
#define PG8_SB(b, h) ((4 + (b) * 2 + (h)) * HTB)
#define PG8_STAGE(bufoff, gbase, voff) do { _Pragma("unroll") for (int _i = 0; _i < 2; ++_i) \
        __builtin_amdgcn_global_load_lds((const unsigned*)((const char*)(gbase) + (voff)[_i]), (LAS unsigned*)(lds + (bufoff) + ldsw + _i * 8192), 16, 0, 0); } while (0)
#define PG8_LDA(dst, b, h) do { if (F8) { unsigned ab_ = (unsigned)aoff; asm volatile("" : "+v"(ab_)); const LAS unsigned char* ap_ = lds + ab_ + PG8_SA(b, h); \
            _Pragma("unroll") for (int m = 0; m < 4; ++m) dst##8[m] = __builtin_shufflevector(*(const LAS i32x4_t*)(ap_ + m * 2048), *(const LAS i32x4_t*)(ap_ + m * 2048 + 1024), 0, 1, 2, 3, 4, 5, 6, 7); } \
        else { _Pragma("unroll") for (int m = 0; m < 4; ++m) _Pragma("unroll") for (int k = 0; k < 2; ++k) dst[m][k] = *(const LAS bf16x8*)(lds + PG8_SA(b, h) + aoff + m * 2048 + k * 1024); } } while (0)
#define PG8_LDB(dst, b, h) do { if (F8) { unsigned bb_ = (unsigned)boff; asm volatile("" : "+v"(bb_)); const LAS unsigned char* bp_ = lds + bb_ + PG8_SB(b, h); \
            _Pragma("unroll") for (int n = 0; n < 2; ++n) dst##8[n] = __builtin_shufflevector(*(const LAS i32x4_t*)(bp_ + n * 2048), *(const LAS i32x4_t*)(bp_ + n * 2048 + 1024), 0, 1, 2, 3, 4, 5, 6, 7); } \
        else { _Pragma("unroll") for (int n = 0; n < 2; ++n) _Pragma("unroll") for (int k = 0; k < 2; ++k) dst[n][k] = *(const LAS bf16x8*)(lds + PG8_SB(b, h) + boff + n * 2048 + k * 1024); } } while (0)
#define PG8_MMA(ai, bj, At, Bt) do { __builtin_amdgcn_s_setprio(1); \
        if (F8) { _Pragma("unroll") for (int m = 0; m < 4; ++m) _Pragma("unroll") for (int n = 0; n < 2; ++n) \
            asm volatile("v_mfma_f32_16x16x128_f8f6f4 %0, %1, %2, %0" : "+v"(acc[ai][bj][m][n]) : "v"(Bt##8[n]), "v"(At##8[m])); } \
        else { _Pragma("unroll") for (int m = 0; m < 4; ++m) _Pragma("unroll") for (int n = 0; n < 2; ++n) _Pragma("unroll") for (int k = 0; k < 2; ++k) \
            acc[ai][bj][m][n] = __builtin_amdgcn_mfma_f32_16x16x32_bf16(Bt[n][k], At[m][k], acc[ai][bj][m][n], 0, 0, 0); } \
        __builtin_amdgcn_s_setprio(0); } while (0)
#define PG8_WAIT_V(n) asm volatile("s_waitcnt vmcnt(" #n ")" ::: "memory")
#define PG8_WAIT_L(n) asm volatile("s_waitcnt lgkmcnt(" #n ")" ::: "memory")
#define PG8_BAR __builtin_amdgcn_s_barrier()
#define PG8_SCHED __builtin_amdgcn_sched_barrier(0)
#define PG8_SETOFF(dst, u) do { _Pragma("unroll") for (int _h = 0; _h < 2; ++_h) _Pragma("unroll") for (int _i = 0; _i < 2; ++_i) \
        dst[_h][_i] = Sched::GATHER ? (unsigned)S.tok(u, RA[_i] + HALF * _h) * (unsigned)RB + CA2[_i] : (unsigned)((RA[_i] + HALF * _h) * RB) + CA2[_i]; } while (0)
    Unit cur, nxt; int ui = 0;
    if (!S.next(0, cur)) return;
    f32x4 acc[2][2][4][2];
#pragma unroll
    for (int a = 0; a < 2; ++a)
#pragma unroll
        for (int b = 0; b < 2; ++b)
#pragma unroll
            for (int m = 0; m < 4; ++m)
#pragma unroll
                for (int n = 0; n < 2; ++n) acc[a][b][m][n] = (f32x4){0.f, 0.f, 0.f, 0.f};
    bf16x8 At[4][2], B0[2][2], B1[2][2]; v8i_t At8[4], B08[2], B18[2];
    PG8_SETOFF(voffA, cur);
    const char* cA = S.a_base(cur); const char* cB = S.b_base(cur);
    PG8_STAGE(PG8_SB(0, 0), cB, voffB); PG8_STAGE(PG8_SA(0, 0), cA, voffA[0]); PG8_STAGE(PG8_SB(0, 1), cB + hstepB, voffB); PG8_STAGE(PG8_SA(0, 1), cA, voffA[1]);
    if (wr == 1) PG8_BAR;
    PG8_WAIT_V(4); PG8_BAR;
    PG8_STAGE(PG8_SB(1, 0), cB + kstep, voffB); PG8_STAGE(PG8_SA(1, 0), cA + kstep, voffA[0]); PG8_STAGE(PG8_SB(1, 1), cB + hstepB + kstep, voffB);
    PG8_WAIT_V(6); PG8_BAR;
    for (;;) {
        const bool has_next = S.next(ui + 1, nxt);
        const char* nA = has_next ? S.a_base(nxt) : cA; const char* nB = has_next ? S.b_base(nxt) : cB;
        if (Sched::GATHER) { if (has_next) { PG8_SETOFF(voffN, nxt); } else {
#pragma unroll
            for (int h = 0; h < 2; ++h)
#pragma unroll
                for (int i = 0; i < 2; ++i) voffN[h][i] = voffA[h][i]; } }
        if (Sched::GATHER) asm volatile("" : "+v"(voffN[0][0]), "+v"(voffN[0][1]), "+v"(voffN[1][0]), "+v"(voffN[1][1]));
#pragma unroll 1
        for (int t = 0; t < nt; t += 2) {
            const bool last = (t == nt - 2);
            const char* a1 = cA + (size_t)(t + 1) * kstep;
            const char* a2 = last ? nA : cA + (size_t)(t + 2) * kstep; const char* b2 = last ? nB : cB + (size_t)(t + 2) * kstep;
            const char* a3 = a2 + kstep; const char* b3 = b2 + kstep;
            unsigned v2[2][2];
#pragma unroll
            for (int h = 0; h < 2; ++h)
#pragma unroll
                for (int i = 0; i < 2; ++i) v2[h][i] = (Sched::GATHER && last) ? voffN[h][i] : voffA[h][i];
            PG8_LDB(B0, 0, 0); PG8_SCHED; PG8_LDA(At, 0, 0); PG8_STAGE(PG8_SA(1, 1), a1, voffA[1]);
            PG8_WAIT_L(8); PG8_BAR; PG8_WAIT_L(0); PG8_MMA(0, 0, At, B0); PG8_BAR; PG8_SCHED;
            PG8_LDB(B1, 0, 1); PG8_STAGE(PG8_SB(0, 0), b2, voffB);
            PG8_BAR; PG8_WAIT_L(0); PG8_MMA(0, 1, At, B1); PG8_BAR;
            PG8_LDA(At, 0, 1); PG8_STAGE(PG8_SA(0, 0), a2, v2[0]);
            PG8_BAR; PG8_WAIT_L(0); PG8_MMA(1, 0, At, B0); PG8_BAR; PG8_SCHED;
            PG8_STAGE(PG8_SB(0, 1), b2 + hstepB, voffB);
            PG8_WAIT_V(6); PG8_BAR; PG8_MMA(1, 1, At, B1); PG8_BAR;
            PG8_LDB(B0, 1, 0); PG8_SCHED; PG8_LDA(At, 1, 0); PG8_STAGE(PG8_SA(0, 1), a2, v2[1]);
            PG8_WAIT_L(8); PG8_BAR; PG8_WAIT_L(0); PG8_MMA(0, 0, At, B0); PG8_BAR; PG8_SCHED;
            PG8_LDB(B1, 1, 1); PG8_STAGE(PG8_SB(1, 0), b3, voffB);
            PG8_BAR; PG8_WAIT_L(0); PG8_MMA(0, 1, At, B1); PG8_BAR;
            PG8_LDA(At, 1, 1); PG8_STAGE(PG8_SA(1, 0), a3, v2[0]);
            PG8_BAR; PG8_WAIT_L(0); PG8_MMA(1, 0, At, B0); PG8_BAR; PG8_SCHED;
            PG8_STAGE(PG8_SB(1, 1), b3 + hstepB, voffB);
            PG8_WAIT_V(6); PG8_BAR; PG8_MMA(1, 1, At, B1); PG8_BAR;
        }
        if (F8) asm volatile("s_nop 15\n\ts_nop 15" ::: "memory");
        const bool keep = E(acc, cur, wr, wc, fr, fq);
        if (!has_next) break;
        if (!keep) {
#pragma unroll
        for (int a = 0; a < 2; ++a)
#pragma unroll
            for (int b = 0; b < 2; ++b)
#pragma unroll
                for (int m = 0; m < 4; ++m)
#pragma unroll
                    for (int n = 0; n < 2; ++n) acc[a][b][m][n] = (f32x4){0.f, 0.f, 0.f, 0.f}; }
        cur = nxt; cA = nA; cB = nB; ++ui;
        if (Sched::GATHER) {
#pragma unroll
        for (int h = 0; h < 2; ++h)
#pragma unroll
            for (int i = 0; i < 2; ++i) voffA[h][i] = voffN[h][i]; }
    }
    PG8_WAIT_V(0);
    if (wr == 0) PG8_BAR;
    PG8_BAR;
#undef PG8_SA
#undef PG8_SB
#undef PG8_STAGE
#undef PG8_LDA
#undef PG8_LDB
#undef PG8_MMA
#undef PG8_WAIT_V
#undef PG8_WAIT_L
#undef PG8_BAR
#undef PG8_SCHED
#undef PG8_SETOFF
}
}


namespace fa {
typedef short bf16x8 __attribute__((ext_vector_type(8)));
typedef short s16x4 __attribute__((ext_vector_type(4)));
typedef float f32x16 __attribute__((ext_vector_type(16)));
constexpr int D = 128, NW = 8, QBLK = 32, KVBLK = 64, QB = NW * QBLK, QS = DM;
constexpr int SHM_V = KVBLK * D * 2, SHM_K = KVBLK * D * 2;
constexpr int OFF_WS = 2 * SHM_V + 2 * SHM_K, OFF_BIAS = OFF_WS + NW * 64 * 4, LDS_BYTES = OFF_BIAS + 2 * 256 + 16;
constexpr float SCALE = ATT_SCALE, THR = 8.f;
#define KSWZ(row, colB) ((row) * 256 + ((colB) ^ (((row) & 7) << 4)))
#define SBAR() __builtin_amdgcn_sched_barrier(0)
__device__ __forceinline__ int v_st(int k, int c) { const int kk = (k & ~0xC) | ((k & 4) << 1) | ((k & 8) >> 1); return ((kk >> 3) * 4 + (c >> 5)) * 512 + ((kk & 7) * 32 + (c & 31)) * 2; }
__device__ __forceinline__ int v_rd_base(int lane) { return ((lane & 3) << 3) | (((lane >> 2) & 3) << 6) | (((lane >> 4) & 1) << 5) | (((lane >> 5) & 1) << 8); }
constexpr int v_rd_off(int d0, int ks, int half) { return d0 * 512 + ks * 4096 + half * 2048; }
__device__ __forceinline__ int crow(int r, int hi) { return (r & 3) + 8 * (r >> 2) + 4 * hi; }
__device__ __forceinline__ bf16x8 load8(const bf16_t* p) { return *reinterpret_cast<const bf16x8*>(p); }
__device__ __forceinline__ void mask_tile(f32x16& p0, f32x16& p1, int dq, unsigned W) {
    const float NEG = -__builtin_inff();
#pragma unroll
    for (int r = 0; r < 16; ++r) { const int c = (r & 3) + 8 * (r >> 2);
        if ((unsigned)(dq - c) >= W) p0[r] = NEG;
        if ((unsigned)(dq - c - 32) >= W) p1[r] = NEG; }
}
__device__ __forceinline__ void partialSM(f32x16& p0, f32x16& p1, float& m_reg, float& mn, float& alpha) {
    float pmax = p0[0];
#pragma unroll
    for (int r = 1; r < 16; ++r) pmax = fmaxf(pmax, p0[r]);
#pragma unroll
    for (int r = 0; r < 16; ++r) pmax = fmaxf(pmax, p1[r]);
    { auto rr = __builtin_amdgcn_permlane32_swap(__float_as_uint(pmax), __float_as_uint(pmax), false, false);
      pmax = fmaxf(__uint_as_float(rr[0]), __uint_as_float(rr[1])); }
    constexpr float C2 = 1.4426950408889634f * SCALE;
    if (__builtin_expect(__all((pmax - m_reg) * SCALE <= THR), 1)) { mn = m_reg; alpha = 1.f; }
    else { mn = fmaxf(m_reg, pmax); alpha = __builtin_amdgcn_exp2f((m_reg - mn) * C2); m_reg = mn; }
    const float mnL = -mn * C2;
#pragma unroll
    for (int r = 0; r < 16; ++r) p0[r] = fmaf(p0[r], C2, mnL);
#pragma unroll
    for (int r = 0; r < 16; ++r) p1[r] = fmaf(p1[r], C2, mnL);
#pragma unroll
    for (int r = 0; r < 16; ++r) p0[r] = __builtin_amdgcn_exp2f(p0[r]);
}
__device__ __forceinline__ void finishSM(f32x16& p0, f32x16& p1, float alpha, float& l_reg, bf16x8& pa0, bf16x8& pa1, bf16x8& pa2, bf16x8& pa3) {
#pragma unroll
    for (int r = 0; r < 16; ++r) p1[r] = __builtin_amdgcn_exp2f(p1[r]);
    float ps = 0;
#pragma unroll
    for (int r = 0; r < 16; ++r) ps += p0[r];
#pragma unroll
    for (int r = 0; r < 16; ++r) ps += p1[r];
    { auto rr = __builtin_amdgcn_permlane32_swap(__float_as_uint(ps), __float_as_uint(ps), false, false);
      ps = __uint_as_float(rr[0]) + __uint_as_float(rr[1]); }
    l_reg = l_reg * alpha + ps;
#define PK4(P, B_, OUT) do { unsigned a0 = cvt_pk_bf16(P[B_+0], P[B_+1]), a1 = cvt_pk_bf16(P[B_+2], P[B_+3]);                          \
        unsigned b0 = cvt_pk_bf16(P[B_+4], P[B_+5]), b1 = cvt_pk_bf16(P[B_+6], P[B_+7]);                                             \
        auto r0 = __builtin_amdgcn_permlane32_swap(a0, b0, false, false); auto r1 = __builtin_amdgcn_permlane32_swap(a1, b1, false, false); \
        u32x4 w = {r0[0], r1[0], r0[1], r1[1]}; OUT = *reinterpret_cast<bf16x8*>(&w); } while (0)
    PK4(p0, 0, pa0); PK4(p0, 8, pa1); PK4(p1, 0, pa2); PK4(p1, 8, pa3);
#undef PK4
}
template <int KB>
__device__ __forceinline__ void qkt(f32x16& p0, f32x16& p1, const char* K_lds, const char* B_lds, int r32, int hi, const bf16x8* qr) {
    { const f32x4* bb = reinterpret_cast<const f32x4*>(B_lds + KB * 256 + hi * 16);
      const f32x4 a0 = bb[0], a1 = bb[2], a2 = bb[4], a3 = bb[6], c0 = bb[8], c1 = bb[10], c2 = bb[12], c3 = bb[14];
      p0 = (f32x16){a0[0], a0[1], a0[2], a0[3], a1[0], a1[1], a1[2], a1[3], a2[0], a2[1], a2[2], a2[3], a3[0], a3[1], a3[2], a3[3]};
      p1 = (f32x16){c0[0], c0[1], c0[2], c0[3], c1[0], c1[1], c1[2], c1[3], c2[0], c2[1], c2[2], c2[3], c3[0], c3[1], c3[2], c3[3]}; }
    const char* kb[4];
#pragma unroll
    for (int dd = 0; dd < 4; ++dd) kb[dd] = K_lds + KB * SHM_K + KSWZ(r32, (dd * 16 + hi * 8) * 2);
#pragma unroll
    for (int d0 = 0; d0 < 8; ++d0) { const char* a = kb[d0 & 3] + (d0 >> 2) * 128;
        bf16x8 b0 = *reinterpret_cast<const bf16x8*>(a);
        bf16x8 b1 = *reinterpret_cast<const bf16x8*>(a + 32 * 256);
        p0 = __builtin_amdgcn_mfma_f32_32x32x16_bf16(b0, qr[d0], p0, 0, 0, 0);
        p1 = __builtin_amdgcn_mfma_f32_32x32x16_bf16(b1, qr[d0], p1, 0, 0, 0); }
}
template <int VB>
__device__ __forceinline__ void pv_tile(f32x16* o, int vb0, bf16x8 pa0, bf16x8 pa1, bf16x8 pa2, bf16x8 pa3) {
#define TRRD(dst, off) asm volatile("ds_read_b64_tr_b16 %0, %1 offset:%2" : "=&v"(dst) : "v"(vb0), "i"(off) : "memory")
#define PV_D0(d0) do { constexpr int b_ = VB * SHM_V + v_rd_off(d0, 0, 0); s16x4 l3, h3; \
        { s16x4 l0, l1, l2, h0, h1, h2; TRRD(l0, b_); TRRD(h0, b_ + 2048); TRRD(l1, b_ + 4096); TRRD(h1, b_ + 6144); TRRD(l2, b_ + 8192); TRRD(h2, b_ + 10240); \
          asm volatile("s_waitcnt lgkmcnt(0)" ::: "memory"); SBAR();   \
          TRRD(l3, b_ + 12288); TRRD(h3, b_ + 14336); SBAR();            \
          o[d0] = __builtin_amdgcn_mfma_f32_32x32x16_bf16(pa0, (bf16x8){l0[0], l0[1], l0[2], l0[3], h0[0], h0[1], h0[2], h0[3]}, o[d0], 0, 0, 0);   \
          o[d0] = __builtin_amdgcn_mfma_f32_32x32x16_bf16(pa1, (bf16x8){l1[0], l1[1], l1[2], l1[3], h1[0], h1[1], h1[2], h1[3]}, o[d0], 0, 0, 0);   \
          o[d0] = __builtin_amdgcn_mfma_f32_32x32x16_bf16(pa2, (bf16x8){l2[0], l2[1], l2[2], l2[3], h2[0], h2[1], h2[2], h2[3]}, o[d0], 0, 0, 0); }   \
        asm volatile("s_waitcnt lgkmcnt(0)" ::: "memory"); SBAR();   \
        o[d0] = __builtin_amdgcn_mfma_f32_32x32x16_bf16(pa3, (bf16x8){l3[0], l3[1], l3[2], l3[3], h3[0], h3[1], h3[2], h3[3]}, o[d0], 0, 0, 0); } while (0)
    PV_D0(0); PV_D0(1); PV_D0(2); PV_D0(3);
#undef PV_D0
#undef TRRD
}
struct BlockRef { const bf16_t* Q; const bf16_t* K; const bf16_t* V; const float* KBp; unsigned char* O  ; int P0, jlo; };
struct Seam { bf16x8 qr[8]; bf16x8 st_v0, st_v1, st_k0, st_k1; float sb; };
#define GLD16(base, boff) (*reinterpret_cast<const bf16x8*>((const char*)(base) + (boff)))
#define VMW() asm volatile("s_waitcnt vmcnt(0)" ::: "memory")
#define VMWN(n) asm volatile("s_waitcnt vmcnt(%0)" :: "i"(n) : "memory")
#define SLOAD_H(Kp, Vp, Bp, k0) do { const char* kq_ = (const char*)(Kp) + (size_t)(k0) * (D * 2); const char* vq_ = (const char*)(Vp) + (size_t)(k0) * (D * 2); \
                         S.st_v0 = GLD16(vq_, kvoff); S.st_v1 = GLD16(vq_ + 32 * D * 2, kvoff); S.st_k0 = GLD16(kq_, kvoff); S.st_k1 = GLD16(kq_ + 32 * D * 2, kvoff); \
                         S.sb = *reinterpret_cast<const float*>((const char*)(Bp) + (size_t)(k0) * 4 + lane4); } while (0)
#define SWRITE_HK(bf) do { *(bf16x8*)(K_lds + (bf) * SHM_K + kws) = S.st_k0; *(bf16x8*)(K_lds + (bf) * SHM_K + kws + 32 * 256) = S.st_k1; \
                           if (wid == 0) *(float*)(B_lds + (bf) * 256 + lane * 4) = S.sb; } while (0)
#define SWRITE_HV(bf) do { *(bf16x8*)(V_lds + (bf) * SHM_V + vst0) = S.st_v0; *(bf16x8*)(V_lds + (bf) * SHM_V + vst1) = S.st_v1; } while (0)
#define SWRITE_H(bf) do { SWRITE_HV(bf); SWRITE_HK(bf); } while (0)
__device__ __forceinline__ void prime(const BlockRef& cur, char* lds, Seam& S) {
    const int tid = tidx(), wid = __builtin_amdgcn_readfirstlane(tid >> 6), lane = tid & 63, r32 = lane & 31, hi = lane >> 5;
    const int sr = tid >> 4, sc = (tid & 15) * 8, kws = KSWZ(sr, sc * 2); char* K_lds = lds + 2 * SHM_V; char* B_lds = lds + OFF_BIAS;
    const unsigned kvoff = (unsigned)(sr * D + sc) * 2u, lane4 = (unsigned)lane * 4u, qoff = (unsigned)((wid * QBLK + r32) * QS + hi * 8) * 2u;
#pragma unroll
    for (int d0 = 0; d0 < 8; ++d0) S.qr[d0] = GLD16(cur.Q, qoff + d0 * 32);
    SLOAD_H(cur.K, cur.V, cur.KBp, cur.jlo * KVBLK); VMW(); SWRITE_HK(0);
    __syncthreads();
}
__device__ __forceinline__ void block(const BlockRef& cur, const BlockRef& nxt, char* lds, Seam& S) {
    const int tid = tidx(), wid = __builtin_amdgcn_readfirstlane(tid >> 6), lane = tid & 63, r32 = lane & 31, hi = lane >> 5;
    const int j_lo = cur.jlo, NT = (cur.P0 + QB - 1) / KVBLK + 1 - j_lo;
    const int tl = NT - 4 + (wid >> 1);
    const int qlo = cur.P0 + wid * QBLK, qm = qlo + r32 - 4 * hi;
    char* V_lds = lds; char* K_lds = lds + 2 * SHM_V; char* B_lds = lds + OFF_BIAS;
    float* ws = (float*)(lds + OFF_WS) + wid * 64; float* li_l = ws; float* al_l = ws + 32;
    float m_reg = -1e30f, l_reg = 0; f32x16 o[4] = {};
    const int sr = tid >> 4, sc = (tid & 15) * 8, vst0 = v_st(sr, sc), vst1 = v_st(32 + sr, sc), kws = KSWZ(sr, sc * 2);
    const unsigned kvoff = (unsigned)(sr * D + sc) * 2u, lane4 = (unsigned)lane * 4u, qoff = (unsigned)((wid * QBLK + r32) * QS + hi * 8) * 2u;
    const int vb0 = (int)(uintptr_t)V_lds + v_rd_base(lane);
    const bf16_t* Kh = cur.K; const bf16_t* Vh = cur.V; const float* Bh = cur.KBp;
#define RESC(a) do { if (__any((a) < 1.f)) { if (hi == 0) al_l[r32] = (a); asm volatile("s_waitcnt lgkmcnt(0)" ::: "memory");              \
                     for (int d_ = 0; d_ < 4; ++d_) for (int r = 0; r < 16; ++r) o[d_][r] *= al_l[crow(r, hi)]; } } while (0)
#define KBASE(t) ((j_lo + (t)) * KVBLK)
#define MASKT(P0_, P1_, t) do { const int kb_ = KBASE(t); if (kb_ + KVBLK - 1 > qlo) mask_tile(P0_, P1_, qm - kb_, 0x7fffffffu); } while (0)
    f32x16 pA0, pA1, pB0, pB1; float mnA, mnB, alA, alB; bf16x8 pa0, pa1, pa2, pa3;
    SWRITE_HV(0); SBAR();
    if (NT > 1) SLOAD_H(Kh, Vh, Bh, KBASE(1));
    SBAR(); qkt<0>(pA0, pA1, K_lds, B_lds, r32, hi, S.qr);
    MASKT(pA0, pA1, 0); partialSM(pA0, pA1, m_reg, mnA, alA);
    if (NT > 1) { VMW(); SWRITE_H(1); SBAR(); if (NT > 2) SLOAD_H(Kh, Vh, Bh, KBASE(2)); }
    __syncthreads();
#define HALF_STEP(PX0, PX1, mnX, alX, PY0, PY1, alY, t, KB, VB, SB) do {                                                      \
        const bool doX_ = (t) <= tl, doY_ = (t) - 1 <= tl;                       \
        SBAR(); if (doX_) qkt<KB>(PX0, PX1, K_lds, B_lds, r32, hi, S.qr);                                                     \
        if (doY_) finishSM(PY0, PY1, alY, l_reg, pa0, pa1, pa2, pa3); SBAR();                                                 \
        if (doY_) pv_tile<VB>(o, vb0, pa0, pa1, pa2, pa3);                                                                    \
        if (doX_) { MASKT(PX0, PX1, (t)); partialSM(PX0, PX1, m_reg, mnX, alX); } else alX = 1.f;                             \
        __syncthreads();                                                                                                      \
        if ((t) + 1 < NT) { VMW(); SWRITE_H(SB); SBAR(); if ((t) + 2 < NT) { SLOAD_H(Kh, Vh, Bh, KBASE((t) + 2)); SBAR(); } }   \
        RESC(alX); __syncthreads(); } while (0)
    for (int t = 1; t + 1 < NT; t += 2) {
        HALF_STEP(pB0, pB1, mnB, alB, pA0, pA1, alA, t, 1, 0, 0);
        HALF_STEP(pA0, pA1, mnA, alA, pB0, pB1, alB, t + 1, 0, 1, 1);
    }
    const bool even = (NT & 1) == 0;
    const bool doA = (even ? NT - 2 : NT - 1) <= tl, doB = even && (NT - 1 <= tl);
    if (doB) { SBAR(); qkt<1>(pB0, pB1, K_lds, B_lds, r32, hi, S.qr); SBAR(); }
    SLOAD_H(nxt.K, nxt.V, nxt.KBp, nxt.jlo * KVBLK); SBAR();
#pragma unroll
    for (int d0 = 0; d0 < 8; ++d0) S.qr[d0] = GLD16(nxt.Q, qoff + d0 * 32);
    SBAR();
    if (doA) { finishSM(pA0, pA1, alA, l_reg, pa0, pa1, pa2, pa3); SBAR();
        pv_tile<0>(o, vb0, pa0, pa1, pa2, pa3); }
    if (even) { if (doB) { MASKT(pB0, pB1, NT - 1); partialSM(pB0, pB1, m_reg, mnB, alB); } else alB = 1.f;
        __syncthreads(); RESC(alB);
        if (doB) { finishSM(pB0, pB1, alB, l_reg, pa0, pa1, pa2, pa3); SBAR(); pv_tile<1>(o, vb0, pa0, pa1, pa2, pa3); } }
    SBAR(); VMWN(8); SWRITE_HK(0); SBAR();
    if (hi == 0) li_l[r32] = l_reg; asm volatile("s_waitcnt lgkmcnt(0)" ::: "memory");
    float rli[16];
#pragma unroll
    for (int r = 0; r < 16; ++r) rli[r] = __builtin_amdgcn_rcpf(li_l[crow(r, hi)]);
    unsigned char* Ow = cur.O; const unsigned ooff = (unsigned)((wid * QBLK + 4 * hi) * QS + r32);
#pragma unroll
    for (int r = 0; r < 16; ++r) { const int orow = (r & 3) + 8 * (r >> 2);
#pragma unroll
        for (int d0 = 0; d0 < 4; ++d0) { const float v = o[d0][r] * rli[r]; const float v1 = dpp_xor1(v), v2 = dpp_xor2(v), v3 = DPPF(v, 0x1B, 0xF, false);
            if ((r32 & 3) == 0) *(unsigned*)(Ow + (size_t)(orow * QS + d0 * 32) + ooff) = pack4_fp8(v, v1, v2, v3); } }
    __syncthreads();
#undef RESC
#undef KBASE
#undef MASKT
#undef HALF_STEP
}
#undef GLD16
#undef VMW
#undef VMWN
#undef SLOAD_H
#undef SWRITE_HK
#undef SWRITE_HV
#undef SWRITE_H
__device__ __forceinline__ BlockRef ref(const Ctx& c, int bh, int qb, float thr, int lane) {
    unsigned char* ws = wsl(c); const int b = bh >> 3, h = bh & 7; BlockRef r;
    const size_t qo = ((size_t)(b * SEQ + qb * QB)) * QS + h * DH;
    r.Q = (const bf16_t*)(ws + WS_FQ) + qo; r.O = ws + WS_OB + qo;
    r.K = (const bf16_t*)(ws + WS_FK) + (size_t)bh * SEQ * DH; r.V = (const bf16_t*)(ws + WS_FV) + (size_t)bh * SEQ * DH;
    r.KBp = (const float*)(ws + WS_KBIAS) + (size_t)bh * SEQ; r.P0 = qb * QB;
    const int nbefore = r.P0 / KVBLK; const float kq = r.KBp[r.P0];
    const bool k0 = (lane >= nbefore) || ((kq - r.KBp[64 * lane + 63]) * (1.f / SQRT_DH) <= thr);
    const bool k1 = (64 + lane >= nbefore) || ((kq - r.KBp[64 * (64 + lane) + 63]) * (1.f / SQRT_DH) <= thr);
    const unsigned long long m0 = __ballot(k0), m1 = __ballot(k1);
    r.jlo = __builtin_amdgcn_readfirstlane(m0 ? (int)__builtin_ctzll(m0) : 64 + (int)__builtin_ctzll(m1));
    return r;
}
constexpr int CW_ATTQ = 2048;
__device__ __forceinline__ void phase(const Ctx& c, int layer, char* lds, int qid = -1) {
    constexpr int NQB = SEQ / QB, TOTAL = NQB * NB * NH;
    const int tid = tidx(), lane = tid & 63;
    unsigned* qhead = (unsigned*)(wsl(c) + WS_CTL) + CW_ATTQ + (qid < 0 ? layer : qid) * 64;
    volatile int* qslot = (volatile int*)(lds + OFF_BIAS + 512);
    float thr;
    { const float* gq = c.in[I_GQ] + layer * DH; const float* gk = c.in[I_GK] + layer * DH;
      float mq = fmaxf(fabsf(gq[lane]), fabsf(gq[lane + 64])), mk = fmaxf(fabsf(gk[lane]), fabsf(gk[lane + 64]));
#pragma unroll
      for (int o = 1; o < 64; o <<= 1) { mq = fmaxf(mq, bperm(mq, lane ^ o)); mk = fmaxf(mk, bperm(mk, lane ^ o)); }
      thr = 2.f * SQRT_DH * mq * mk + 17.f; thr = __builtin_bit_cast(float, __builtin_amdgcn_readfirstlane(__builtin_bit_cast(int, thr))); }
    if (tid == 0) { qslot[0] = (int)__hip_atomic_fetch_add(qhead, 1u, __ATOMIC_RELAXED, __HIP_MEMORY_SCOPE_AGENT); qslot[1] = (int)__hip_atomic_fetch_add(qhead, 1u, __ATOMIC_RELAXED, __HIP_MEMORY_SCOPE_AGENT); }
    __syncthreads();
    int ic = __builtin_amdgcn_readfirstlane(qslot[0]), in_ = __builtin_amdgcn_readfirstlane(qslot[1]), par = 0;
    if (ic >= TOTAL) return;
#define ITEM_REF(i) ref(c, (i) & 31, NQB - 1 - ((i) >> 5), thr, lane)
    BlockRef cur = ITEM_REF(ic);
    Seam S;
    prime(cur, lds, S);
    for (;;) {
        const bool last = in_ >= TOTAL;
        if (tid == 0 && !last) qslot[par] = (int)__hip_atomic_fetch_add(qhead, 1u, __ATOMIC_RELAXED, __HIP_MEMORY_SCOPE_AGENT);
        const BlockRef nxt = last ? cur : ITEM_REF(in_);
        block(cur, nxt, lds, S);
        if (last) break;
        cur = nxt; in_ = __builtin_amdgcn_readfirstlane(qslot[par]); par ^= 1;
    }
#undef ITEM_REF
}
#undef KSWZ
#undef SBAR
}


namespace hg {
typedef short bf16x8 __attribute__((ext_vector_type(8)));
typedef short s16x4 __attribute__((ext_vector_type(4)));
typedef float f32x16 __attribute__((ext_vector_type(16)));
constexpr int C = 64, NCH = SEQ / C, NUNIT = NB * NH * NCH;
constexpr size_t US_BYTES = (size_t)128 * 128 * 2;
constexpr size_t WS_US_LO = WS_USLO, WS_US_HI = 968 * MiB, WS_G = 1032 * MiB, WS_HG_END = 1034 * MiB;
__device__ __forceinline__ bf16_t* us_tile(unsigned char* ws, int unit) { return (bf16_t*)(ws + (unit < NUNIT / 2 ? WS_US_LO + (size_t)unit * US_BYTES : WS_US_HI + (size_t)(unit - NUNIT / 2) * US_BYTES)); }
#define KSWZ(row, colB) ((row) * 256 + ((colB) ^ (((row) & 7) << 4)))
__device__ __forceinline__ int v_st(int k, int c) { const int kk = (k & ~0xC) | ((k & 4) << 1) | ((k & 8) >> 1); return ((kk >> 3) * 4 + (c >> 5)) * 512 + ((kk & 7) * 32 + (c & 31)) * 2; }
__device__ __forceinline__ int v_rd_base(int lane) { return ((lane & 3) << 3) | (((lane >> 2) & 3) << 6) | (((lane >> 4) & 1) << 5) | (((lane >> 5) & 1) << 8); }
__device__ __forceinline__ int crow(int r, int hi) { return (r & 3) + 8 * (r >> 2) + 4 * hi; }
#define LBAR() do { asm volatile("s_waitcnt lgkmcnt(0)" ::: "memory"); __builtin_amdgcn_s_barrier(); asm volatile("" ::: "memory"); } while (0)
#define TRRD(dst, addr, off) asm volatile("ds_read_b64_tr_b16 %0, %1 offset:%2" : "=&v"(dst) : "v"(addr), "i"(off) : "memory")
#define FRAG4(F0, F1, F2, F3, vaddr, d0) do { s16x4 l0, l1, l2, l3, h0, h1, h2, h3; constexpr int b_ = (d0) * 512; \
        TRRD(l0, vaddr, b_); TRRD(h0, vaddr, b_ + 2048); TRRD(l1, vaddr, b_ + 4096); TRRD(h1, vaddr, b_ + 6144); TRRD(l2, vaddr, b_ + 8192); TRRD(h2, vaddr, b_ + 10240); TRRD(l3, vaddr, b_ + 12288); TRRD(h3, vaddr, b_ + 14336); \
        asm volatile("s_waitcnt lgkmcnt(0)" ::: "memory"); __builtin_amdgcn_sched_barrier(0); \
        F0 = (bf16x8){l0[0], l0[1], l0[2], l0[3], h0[0], h0[1], h0[2], h0[3]}; F1 = (bf16x8){l1[0], l1[1], l1[2], l1[3], h1[0], h1[1], h1[2], h1[3]}; \
        F2 = (bf16x8){l2[0], l2[1], l2[2], l2[3], h2[0], h2[1], h2[2], h2[3]}; F3 = (bf16x8){l3[0], l3[1], l3[2], l3[3], h3[0], h3[1], h3[2], h3[3]}; } while (0)
struct Strip { float cum[8][2]; float tot[2]; };
__device__ __forceinline__ void strip_load(const bf16_t* lf_chunk  , int kp, int rg, unsigned (&lr)[8]) {
#pragma unroll
    for (int i = 0; i < 8; ++i) lr[i] = *reinterpret_cast<const unsigned*>(lf_chunk + (size_t)(8 * rg + i) * DM + 2 * kp);
}
__device__ __forceinline__ void strip_unpack(const unsigned (&lr)[8], float (&l)[8][2]) {
#pragma unroll
    for (int i = 0; i < 8; ++i) unpack_f16x2(lr[i], l[i][0], l[i][1]);
}
__device__ __forceinline__ void strip_scan(int lane, const float (&l)[8][2], Strip& st) {
    float run0 = 0.f, run1 = 0.f;
#pragma unroll
    for (int i = 0; i < 8; ++i) { run0 += l[i][0]; run1 += l[i][1]; st.cum[i][0] = run0; st.cum[i][1] = run1; }
    float in0 = run0, in1 = run1;
#pragma unroll
    for (int o = 1; o < 8; o <<= 1) { const float a = dpp_shr(in0, o), b = dpp_shr(in1, o); if ((lane & 7) >= o) { in0 += a; in1 += b; } }
    const float ex0 = in0 - run0, ex1 = in1 - run1;
#pragma unroll
    for (int i = 0; i < 8; ++i) { st.cum[i][0] += ex0; st.cum[i][1] += ex1; }
    st.tot[0] = bperm(in0, (lane & ~7) | 7); st.tot[1] = bperm(in1, (lane & ~7) | 7);
}
constexpr int A_TK = 0, A_TV = 16384, A_LDS = 32768;
__device__ __forceinline__ void pass_a(const Ctx& c, char* lds) {
    const int tid = tidx(), wid = __builtin_amdgcn_readfirstlane(tid >> 6), lane = tid & 63, r32 = lane & 31, hi = lane >> 5;
    const int kp = tid >> 3, rg = tid & 7, sr = tid >> 4, sc = (tid & 15) * 8;
    unsigned char* ws = wsl(c); const bf16_t* LF = (const bf16_t*)(ws + WS_LF); const unsigned char* VA = ws + WS_VA; float* G = (float*)(ws + WS_G);
    const int vaddr_k = (int)(uintptr_t)(lds + A_TK) + v_rd_base(lane), vaddr_v = (int)(uintptr_t)(lds + A_TV) + v_rd_base(lane);
    unsigned lr[8]; u32x2 pv0, pv1;
#define V8_TO_BF16(r) (bf16x8)__builtin_bit_cast(bf16x8, (u32x4){cvt_pk_bf16(unpack4_fp8((r).x)[0], unpack4_fp8((r).x)[1]), cvt_pk_bf16(unpack4_fp8((r).x)[2], unpack4_fp8((r).x)[3]), cvt_pk_bf16(unpack4_fp8((r).y)[0], unpack4_fp8((r).y)[1]), cvt_pk_bf16(unpack4_fp8((r).y)[2], unpack4_fp8((r).y)[3])})
#define A_LOAD(u) do { const int bh_ = (u) >> 7, ch_ = (u) & (NCH - 1); const size_t r0_ = (size_t)((bh_ >> 3) * SEQ + ch_ * C); const int h_ = bh_ & 7; \
        strip_load(LF + r0_ * DM + h_ * DH, kp, rg, lr); const unsigned char* vp_ = VA + (r0_ + sr) * DM + h_ * DH + sc; pv0 = *(const u32x2*)vp_; pv1 = *(const u32x2*)(vp_ + (size_t)32 * DM); } while (0)
    int unit = bidx(); if (unit < NUNIT) A_LOAD(unit);
    for (; unit < NUNIT; unit += gridDim.x) {
        float l[8][2]; strip_unpack(lr, l); Strip st; strip_scan(lane, l, st);
#pragma unroll
        for (int i = 0; i < 8; ++i) { const float k0 = (1.f - __expf(l[i][0])) * __expf(st.tot[0] - st.cum[i][0]), k1 = (1.f - __expf(l[i][1])) * __expf(st.tot[1] - st.cum[i][1]);
            *(unsigned*)(lds + A_TK + v_st(8 * rg + i, 2 * kp)) = cvt_pk_bf16(k0, k1); }
        if (rg == 7) *reinterpret_cast<float2*>(G + (size_t)unit * DH + 2 * kp) = make_float2(__expf(st.tot[0]), __expf(st.tot[1]));
        *(bf16x8*)(lds + A_TV + v_st(sr, sc)) = V8_TO_BF16(pv0); *(bf16x8*)(lds + A_TV + v_st(32 + sr, sc)) = V8_TO_BF16(pv1);
        if (unit + (int)gridDim.x < NUNIT) A_LOAD(unit + (int)gridDim.x);
        LBAR();
        const int kb = wid >> 1; bf16x8 a0, a1, a2, a3;
        if (kb == 0) FRAG4(a0, a1, a2, a3, vaddr_k, 0); else if (kb == 1) FRAG4(a0, a1, a2, a3, vaddr_k, 1); else if (kb == 2) FRAG4(a0, a1, a2, a3, vaddr_k, 2); else FRAG4(a0, a1, a2, a3, vaddr_k, 3);
        bf16_t* U = us_tile(ws, unit);
#pragma unroll
        for (int j = 0; j < 2; ++j) { bf16x8 b0, b1, b2, b3; const int vb = 2 * (wid & 1) + j;
            if (wid & 1) { if (j == 0) FRAG4(b0, b1, b2, b3, vaddr_v, 2); else FRAG4(b0, b1, b2, b3, vaddr_v, 3); } else { if (j == 0) FRAG4(b0, b1, b2, b3, vaddr_v, 0); else FRAG4(b0, b1, b2, b3, vaddr_v, 1); }
            f32x16 acc = {};
            acc = __builtin_amdgcn_mfma_f32_32x32x16_bf16(a0, b0, acc, 0, 0, 0); acc = __builtin_amdgcn_mfma_f32_32x32x16_bf16(a1, b1, acc, 0, 0, 0);
            acc = __builtin_amdgcn_mfma_f32_32x32x16_bf16(a2, b2, acc, 0, 0, 0); acc = __builtin_amdgcn_mfma_f32_32x32x16_bf16(a3, b3, acc, 0, 0, 0);
#pragma unroll
            for (int r = 0; r < 16; ++r) { const float v = acc[r], vn = dpp_xor1(v);
                if ((r32 & 1) == 0) *(unsigned*)(U + (size_t)(32 * kb + crow(r, hi)) * DH + 32 * vb + r32) = cvt_pk_bf16(v, vn); } }
        LBAR();
    }
}
__device__ __forceinline__ void pass_b(const Ctx& c) {
    unsigned char* ws = wsl(c); const float* G = (const float*)(ws + WS_G);
    const int tid = tidx();
    for (int job = bidx(); job < NB * NH * 4; job += gridDim.x) { const int bh = job >> 2, q = job & 3;
        const int e = (q * NTHR + tid) * 8, k = e >> 7, v = e & 127;
        float s[8];
#pragma unroll
        for (int i = 0; i < 8; ++i) s[i] = 0.f;
#define PB_LOAD(U, Gv, c0_) do { _Pragma("unroll") for (int j = 0; j < 8; ++j) { const int unit = bh * NCH + (c0_) + j; U[j] = *(const u32x4*)(us_tile(ws, unit) + k * DH + v); Gv[j] = G[(size_t)unit * DH + k]; } \
        __builtin_amdgcn_sched_barrier(0); } while (0)
#define PB_SCAN(U, Gv, c0_) do { _Pragma("unroll") for (int j = 0; j < 8; ++j) { const int unit = bh * NCH + (c0_) + j;                                              \
            u32x4 o; o.x = cvt_pk_bf16(s[0], s[1]); o.y = cvt_pk_bf16(s[2], s[3]); o.z = cvt_pk_bf16(s[4], s[5]); o.w = cvt_pk_bf16(s[6], s[7]);                 \
            *(u32x4*)(us_tile(ws, unit) + k * DH + v) = o;                                                                                                         \
            s[0] = Gv[j] * s[0] + __uint_as_float(U[j].x << 16); s[1] = Gv[j] * s[1] + __uint_as_float(U[j].x & 0xffff0000u); s[2] = Gv[j] * s[2] + __uint_as_float(U[j].y << 16); s[3] = Gv[j] * s[3] + __uint_as_float(U[j].y & 0xffff0000u); \
            s[4] = Gv[j] * s[4] + __uint_as_float(U[j].z << 16); s[5] = Gv[j] * s[5] + __uint_as_float(U[j].z & 0xffff0000u); s[6] = Gv[j] * s[6] + __uint_as_float(U[j].w << 16); s[7] = Gv[j] * s[7] + __uint_as_float(U[j].w & 0xffff0000u); } \
        __builtin_amdgcn_sched_barrier(0); } while (0)
        static_assert(NCH % 16 == 0, "pass_b: two batches per step");
        u32x4 ua[8], ub[8]; float ga[8], gb[8];
        PB_LOAD(ua, ga, 0);
#pragma unroll 1
        for (int c0 = 0; c0 < NCH; c0 += 16) {
            PB_LOAD(ub, gb, c0 + 8);
            PB_SCAN(ua, ga, c0);
            if (c0 + 16 < NCH) PB_LOAD(ua, ga, c0 + 16);
            PB_SCAN(ub, gb, c0 + 8);
        }
#undef PB_LOAD
#undef PB_SCAN
    }
}
constexpr int C_TQ = 0, C_TKD = 16384, C_TV = 32768, C_TS = 49152, C_ER = 81920, C_PS = 82432, C_LDS = 83456;
__device__ __forceinline__ void pass_c(const Ctx& c, int layer, char* lds, bool dummy = false) {
    const int tid = tidx(), wid = __builtin_amdgcn_readfirstlane(tid >> 6), lane = tid & 63, r32 = lane & 31, hi = lane >> 5;
    const int kp = tid >> 3, rg = tid & 7, sr = tid >> 4, sc = (tid & 15) * 8, rh = wid >> 2, vq = wid & 3;
    unsigned char* ws = wsl(c); const bf16_t* LF = (const bf16_t*)(ws + WS_LF); const unsigned char* VA = ws + WS_VA; const unsigned char* QA = ws + WS_QA; const unsigned char* GA = ws + WS_GA; unsigned char* OA = ws + WS_OA;
    const int vaddr_v = (int)(uintptr_t)(lds + C_TV) + v_rd_base(lane), vaddr_s0 = (int)(uintptr_t)(lds + C_TS) + v_rd_base(lane), vaddr_s1 = vaddr_s0 + 16384;
    float* ER = (float*)(lds + C_ER); float* PS = (float*)(lds + C_PS);
    const float gain = c.in[I_HGN][layer * DH + 32 * vq + r32];
    unsigned lr[8]; unsigned short qraw[8]; u32x2 pv0, pv1; u32x4 sraw[4]; unsigned char garaw[16];
#define C_LOAD(u) do { const int bh_ = (u) >> 7, ch_ = (u) & (NCH - 1); const size_t r0_ = (size_t)((bh_ >> 3) * SEQ + ch_ * C); const int h_ = bh_ & 7; \
        strip_load(LF + r0_ * DM + h_ * DH, kp, rg, lr); \
        _Pragma("unroll") for (int i_ = 0; i_ < 8; ++i_) qraw[i_] = *(const unsigned short*)(QA + (r0_ + 8 * rg + i_) * DM + h_ * DH + 2 * kp); \
        const unsigned char* vp_ = VA + (r0_ + sr) * DM + h_ * DH + sc; pv0 = *(const u32x2*)vp_; pv1 = *(const u32x2*)(vp_ + (size_t)32 * DM); \
        const bf16_t* Sg_ = us_tile(ws, (u)); _Pragma("unroll") for (int j_ = 0; j_ < 4; ++j_) sraw[j_] = *(const u32x4*)(Sg_ + (size_t)(sr + 32 * j_) * DH + sc); } while (0)
    int unit = bidx(); if (unit < NUNIT) C_LOAD(unit);
    for (; unit < NUNIT; unit += gridDim.x) {
        const int bh = unit >> 7, ch = unit & (NCH - 1), b = bh >> 3, h = bh & 7; const size_t row0 = (size_t)(b * SEQ + ch * C);
        float l[8][2]; strip_unpack(lr, l); Strip st; strip_scan(lane, l, st);
        const float ref0 = bperm(st.cum[7][0], (lane & ~7) | 3), ref1 = bperm(st.cum[7][1], (lane & ~7) | 3);
#pragma unroll
        for (int i = 0; i < 8; ++i) { const int row = 8 * rg + i;
            const f32v2u_t qf = __builtin_amdgcn_cvt_pk_f32_fp8((int)qraw[i], false); const float q0 = qf[0], q1 = qf[1];
            const float d0 = st.cum[i][0] - ref0, d1 = st.cum[i][1] - ref1;
            *(unsigned*)(lds + C_TQ + KSWZ(row, 4 * kp)) = cvt_pk_bf16(q0 * __expf(d0), q1 * __expf(d1));
            *(unsigned*)(lds + C_TKD + KSWZ(row, 4 * kp)) = cvt_pk_bf16((1.f - __expf(l[i][0])) * __expf(-d0), (1.f - __expf(l[i][1])) * __expf(-d1)); }
        if (rg == 0) { ER[2 * kp] = __expf(ref0); ER[2 * kp + 1] = __expf(ref1); }
        *(bf16x8*)(lds + C_TV + v_st(sr, sc)) = V8_TO_BF16(pv0); *(bf16x8*)(lds + C_TV + v_st(32 + sr, sc)) = V8_TO_BF16(pv1);
        LBAR();
#pragma unroll
        for (int j = 0; j < 4; ++j) { const int k = sr + 32 * j; const float e = ER[k]; const u32x4 x = sraw[j]; u32x4 o;
            o.x = cvt_pk_bf16(__uint_as_float(x.x << 16) * e, __uint_as_float(x.x & 0xffff0000u) * e); o.y = cvt_pk_bf16(__uint_as_float(x.y << 16) * e, __uint_as_float(x.y & 0xffff0000u) * e);
            o.z = cvt_pk_bf16(__uint_as_float(x.z << 16) * e, __uint_as_float(x.z & 0xffff0000u) * e); o.w = cvt_pk_bf16(__uint_as_float(x.w << 16) * e, __uint_as_float(x.w & 0xffff0000u) * e);
            *(u32x4*)(lds + C_TS + (k >> 6) * 16384 + v_st(k & 63, sc)) = o; }
        if (unit + (int)gridDim.x < NUNIT) C_LOAD(unit + (int)gridDim.x);
        LBAR();
        bf16x8 qr[8];
#pragma unroll
        for (int d0 = 0; d0 < 8; ++d0) qr[d0] = *(const bf16x8*)(lds + C_TQ + KSWZ(32 * rh + r32, (d0 * 16 + hi * 8) * 2));
        f32x16 p0 = {}, p1 = {};
#pragma unroll
        for (int d0 = 0; d0 < 8; ++d0) { const bf16x8 k0 = *(const bf16x8*)(lds + C_TKD + KSWZ(r32, (d0 * 16 + hi * 8) * 2)), k1 = *(const bf16x8*)(lds + C_TKD + KSWZ(32 + r32, (d0 * 16 + hi * 8) * 2));
            p0 = __builtin_amdgcn_mfma_f32_32x32x16_bf16(k0, qr[d0], p0, 0, 0, 0); p1 = __builtin_amdgcn_mfma_f32_32x32x16_bf16(k1, qr[d0], p1, 0, 0, 0); }
        { const int t = 32 * rh + r32;
#pragma unroll
          for (int r = 0; r < 16; ++r) { const int key = crow(r, hi); if (key > t) p0[r] = 0.f; if (key + 32 > t) p1[r] = 0.f; } }
        bf16x8 pa0, pa1, pa2, pa3;
#define PK4(P, B_, OUT) do { unsigned a0 = cvt_pk_bf16(P[B_+0], P[B_+1]), a1 = cvt_pk_bf16(P[B_+2], P[B_+3]);                          \
        unsigned b0 = cvt_pk_bf16(P[B_+4], P[B_+5]), b1 = cvt_pk_bf16(P[B_+6], P[B_+7]);                                             \
        auto r0 = __builtin_amdgcn_permlane32_swap(a0, b0, false, false); auto r1 = __builtin_amdgcn_permlane32_swap(a1, b1, false, false); \
        u32x4 w = {r0[0], r1[0], r0[1], r1[1]}; OUT = *reinterpret_cast<bf16x8*>(&w); } while (0)
        PK4(p0, 0, pa0); PK4(p0, 8, pa1); PK4(p1, 0, pa2); PK4(p1, 8, pa3);
#undef PK4
        f32x16 o = {};
#define ACC_TILE(vaddr, A0, A1, A2, A3) do { bf16x8 b0, b1, b2, b3; \
        if (vq == 0) FRAG4(b0, b1, b2, b3, vaddr, 0); else if (vq == 1) FRAG4(b0, b1, b2, b3, vaddr, 1); else if (vq == 2) FRAG4(b0, b1, b2, b3, vaddr, 2); else FRAG4(b0, b1, b2, b3, vaddr, 3); \
        o = __builtin_amdgcn_mfma_f32_32x32x16_bf16(A0, b0, o, 0, 0, 0); o = __builtin_amdgcn_mfma_f32_32x32x16_bf16(A1, b1, o, 0, 0, 0); \
        o = __builtin_amdgcn_mfma_f32_32x32x16_bf16(A2, b2, o, 0, 0, 0); o = __builtin_amdgcn_mfma_f32_32x32x16_bf16(A3, b3, o, 0, 0, 0); } while (0)
        ACC_TILE(vaddr_v, pa0, pa1, pa2, pa3);
        ACC_TILE(vaddr_s0, qr[0], qr[1], qr[2], qr[3]);
        ACC_TILE(vaddr_s1, qr[4], qr[5], qr[6], qr[7]);
#undef ACC_TILE
#pragma unroll
        for (int r = 0; r < 16; ++r) garaw[r] = GA[(row0 + 32 * rh + crow(r, hi)) * DM + h * DH + 32 * vq + r32];
#pragma unroll
        for (int r = 0; r < 16; ++r) { float ss = o[r] * o[r];
            ss = row_sum16(ss); ss += DPPF(ss, 0x142, 0xA, false);
            if (r32 == 31) PS[(32 * rh + crow(r, hi)) * 4 + vq] = ss; }
        LBAR();
#pragma unroll
        for (int r = 0; r < 16; ++r) { const int t = 32 * rh + crow(r, hi); const f32x4 ps = *(const f32x4*)(PS + t * 4);
            const float rstd = rsqrtf(((ps[0] + ps[1]) + (ps[2] + ps[3])) * (1.f / DH) + NORM_EPS);
            const size_t gi = (row0 + t) * DM + h * DH + 32 * vq + r32;
            const float val = o[r] * rstd * gain * __builtin_amdgcn_cvt_f32_fp8((int)garaw[r], 0); const float v1 = dpp_xor1(val), v2 = dpp_xor2(val), v3 = DPPF(val, 0x1B, 0xF, false);
            if ((r32 & 3) == 0) *(unsigned*)((dummy ? ws + WS_G + 2 * MiB : OA) + (dummy ? (gi & 0xffffff) : gi)) = pack4_fp8(val, v1, v2, v3); }
        LBAR();
    }
}
#undef C_LOAD
#undef A_LOAD
#undef V8_TO_BF16
#undef LBAR
#undef KSWZ
#undef TRRD
#undef FRAG4
}

static_assert(LDS_STAGE_BYTES == pg8::STAGE_BYTES, "stage region");
__device__ __forceinline__ void moe_tables(const Ctx& c, int layer, LAS int* tab) {
    const unsigned* gc = (const unsigned*)(wsl(c) + WS_CTL) + CW_CNT + layer * 64;
    if (threadIdx.x < NE) tab[80 + threadIdx.x] = (int)__hip_atomic_load(gc + threadIdx.x, __ATOMIC_RELAXED, __HIP_MEMORY_SCOPE_AGENT);
    __syncthreads();
    if (threadIdx.x == 0) { int s = 0, t = 0;
        for (int e = 0; e < NE; ++e) { const int n = tab[80 + e]; tab[e] = t; tab[40 + e] = s; s += (n + 255) & ~255; t += (n + 255) >> 8; }
        tab[NE] = t; tab[40 + NE] = s; }
    __syncthreads();
}
__device__ __forceinline__ void moe_tail_convert(const Ctx& c, int next_layer, LAS unsigned char* lds, int it_lo, int it_hi) {
    const LAS int* tab = (const LAS int*)(lds + LDS_MISC + 1024);
    const int rem = (tab[NE] * 4) & 255, cid = bidx();
    if (cid < rem) return;
    const int wave = __builtin_amdgcn_readfirstlane(tidx() >> 6);
    ph_convert(c, next_layer, lds, it_lo, it_hi, (cid - rem) * NWAVE + wave, (256 - rem) * NWAVE, false);
}
constexpr int CW_CVQ = 4096;
__device__ __forceinline__ void attn_tail_convert(const Ctx& c, int layer, LAS unsigned char* lds, int it_lo) {
    unsigned* chead = (unsigned*)(wsl(c) + WS_CTL) + CW_CVQ + layer * 64;
    volatile LAS int* slot = (volatile LAS int*)(lds + LDS_MISC + 2048);
    const int tid = tidx(), wave = __builtin_amdgcn_readfirstlane(tid >> 6), lane = tid & 63;
    LAS float* scr = (LAS float*)(lds + wave * 16640);
    static_assert((CV_ALL - CV_A_END) % (2 * NWAVE) == 0 && (CV_ALL - CV_B_END) % (2 * NWAVE) == 0, "whole batches");
    for (;;) {
        __syncthreads();
        if (tid == 0) slot[0] = (int)__hip_atomic_fetch_add(chead, (unsigned)(2 * NWAVE), __ATOMIC_RELAXED, __HIP_MEMORY_SCOPE_AGENT);
        __syncthreads();
        const int base = __builtin_amdgcn_readfirstlane(slot[0]);
        if (base >= CV_ALL - it_lo) break;
        const CvItem da = cv_item(c, layer, it_lo + base + wave), db = cv_item(c, layer, it_lo + base + NWAVE + wave);
        f32x4 va[16], vb[16];
        cv_load(va, da, lane); cv_load(vb, db, lane);
        __builtin_amdgcn_sched_barrier(0);
        cv_store(va, da, scr, lane); cv_store(vb, db, scr, lane);
    }
}
template <int GP> __device__ __forceinline__ void ph_gemm(const Ctx& c, int layer, LAS unsigned char* lds) {
    unsigned char* ws = wsl(c); const int G = gridDim.x, cid = bidx();
    if (GP == 0) { pg8::StaticOrder S; S.init(ws + WS_XB8, ws + WS_WIN, T, INP, DM, G, cid, 1); pg8::EpiInProj E{make_ipo(c), 1.f / WIN_SCALE, c.in[I_GQ] + layer * DH, c.in[I_GK] + layer * DH, (LAS float*)(lds + LDS_STAGE_BYTES), (int)(tidx() & 63)}; pg8::gemm_phase<DM, pg8::EpiInProj, pg8::StaticOrder, true>(lds, S, E); }
    if (GP == 1) { pg8::MergeOrder S; S.base.init(ws + WS_OA, ws + WS_WA, T, DM, DM, G, cid, 1); S.A2 = (const char*)(ws + WS_OB); S.B2 = (const char*)(ws + WS_WB);
        pg8::EpiMergeChain E{(const unsigned char*)(ws + WS_SGA), (const unsigned char*)(ws + WS_SGB), ws + WS_VA, MG_SCALE / WIN_SCALE}; pg8::gemm_phase<DM, pg8::EpiMergeChain, pg8::MergeOrder, true>(lds, S, E); }
    if (GP == 3) { pg8::StaticOrder S; S.init(ws + WS_VA, ws + WS_WO, T, DM, DM, G, cid, 1); pg8::EpiOut E{(const bf16_t*)(ws + WS_XBF), (bf16_t*)(ws + WS_YX), 1.f / (WIN_SCALE * MG_SCALE)}; pg8::gemm_phase<DM, pg8::EpiOut, pg8::StaticOrder, true>(lds, S, E); }
    if (GP == 4 || GP == 5) { LAS int* tab = (LAS int*)(lds + LDS_MISC + 1024); moe_tables(c, layer, tab);
        if (GP == 4) { pg8::MoeOrder<true> S{(const char*)(ws + WS_X18), (const char*)(ws + WS_WGU), (const int*)(ws + WS_STE), tab, tab + 40, tab + 80, G, cid}; pg8::EpiMoeUp E{(unsigned char*)(ws + WS_HB), 1.f / WIN_SCALE}; pg8::gemm_phase<DM, pg8::EpiMoeUp, pg8::MoeOrder<true>, true>(lds, S, E); }
        else { pg8::MoeOrder<false> S{(const char*)(ws + WS_HB), (const char*)(ws + WS_WD), (const int*)(ws + WS_STE), tab, tab + 40, tab + 80, G, cid}; pg8::EpiMoeDn E{(bf16_t*)(ws + WS_YB), 1.f / WIN_SCALE}; pg8::gemm_phase<DE, pg8::EpiMoeDn, pg8::MoeOrder<false>, true>(lds, S, E); } }
}


#define XB_TMO      128
#define XB_XCNT(j)  (256  + 64 * (j))
#define XB_XSUB(j)  (1280 + 64 * (j))
#define XB_XGEN(j)  (2304 + 64 * (j))
#define XB_TOP      3328
#define XB_TOPGEN   3392
#define XCD_BAR_WORDS 3456
#define XB_SPIN_CAP (1u << 18)
__device__ __forceinline__ unsigned xb_ld(unsigned* p)              { return __hip_atomic_load(p, __ATOMIC_RELAXED, __HIP_MEMORY_SCOPE_AGENT); }
__device__ __forceinline__ unsigned xb_add(unsigned* p, unsigned v) { return __hip_atomic_fetch_add(p, v, __ATOMIC_RELAXED, __HIP_MEMORY_SCOPE_AGENT); }
__device__ __forceinline__ unsigned xb_xcc_id() { return (unsigned)__builtin_amdgcn_s_getreg((3 << 11) | 20) & 0xFu; }
#define XB_SPIN(cond, bar) do { unsigned _sp = 0; while (cond) { __builtin_amdgcn_s_sleep(1); \
    if ((++_sp & 255u) == 0u) { if (xb_ld(&(bar)[XB_TMO])) break; if (_sp > XB_SPIN_CAP) { atomicAdd(&(bar)[XB_TMO], 1u); break; } } } } while (0)
struct XcdBarrier { unsigned* bar; unsigned x; volatile LAS unsigned* st; };
__device__ __forceinline__ XcdBarrier xcd_barrier_post(unsigned* bar, volatile LAS unsigned* st) {
    XcdBarrier b; b.bar = bar; b.x = xb_xcc_id(); b.st = st;
    if (threadIdx.x == 0) (void)xb_add(&bar[XB_XCNT(b.x)], 1u);
    return b;
}
__device__ __forceinline__ void xcd_barrier_complete(unsigned* bar, unsigned x, unsigned& nloc, unsigned& nx) {
    const unsigned G = gridDim.x * gridDim.y * gridDim.z;
    unsigned sum, cnt, mine, sp = 0u;
    for (;;) {
        sum = 0u; cnt = 0u; mine = 0u;
#pragma unroll
        for (unsigned j = 0; j < 16; ++j) { const unsigned c = xb_ld(&bar[XB_XCNT(j)]); sum += c; cnt += (c > 0u) ? 1u : 0u; mine = (j == x) ? c : mine; }
        if (sum == G) break;
        __builtin_amdgcn_s_sleep(1);
        if ((++sp & 255u) == 0u) { if (xb_ld(&bar[XB_TMO])) break; if (sp > XB_SPIN_CAP) { atomicAdd(&bar[XB_TMO], 1u); break; } }
    }
    nloc = mine > 0u ? mine : 1u; nx = cnt > 0u ? cnt : 1u;
}
__device__ __forceinline__ void xcd_barrier(const XcdBarrier& b) {
    asm volatile("s_waitcnt vmcnt(0)" ::: "memory");
    __syncthreads();
    if (threadIdx.x == 0) {
        unsigned* bar = b.bar; asm volatile("" : "+s"(bar));
        const unsigned bx = (unsigned)__builtin_amdgcn_readfirstlane((int)xb_xcc_id());
        __builtin_amdgcn_s_waitcnt(0);
        unsigned nloc = b.st[0], nx = b.st[1];
        if (nloc == 0u) { xcd_barrier_complete(bar, bx, nloc, nx); b.st[0] = nloc; b.st[1] = nx; }
        const unsigned old = xb_add(&bar[XB_XSUB(bx)], 1u);
        const unsigned gen = old / nloc;
        if (old + 1u == (gen + 1u) * nloc) {
            __builtin_amdgcn_fence(__ATOMIC_RELEASE, "agent");
            asm volatile("s_waitcnt vmcnt(0)" ::: "memory");
            const unsigned og = xb_add(&bar[XB_TOP], 1u);
            const unsigned tg = og / nx;
            if (og + 1u == (tg + 1u) * nx) xb_add(&bar[XB_TOPGEN], 1u);
            else XB_SPIN(xb_ld(&bar[XB_TOPGEN]) == tg, bar);
            __builtin_amdgcn_fence(__ATOMIC_ACQUIRE, "agent");
            xb_add(&bar[XB_XGEN(bx)], 1u);
            asm volatile("s_waitcnt vmcnt(0)" ::: "memory");
        } else {
            XB_SPIN(xb_ld(&bar[XB_XGEN(bx)]) == gen, bar);
            __builtin_amdgcn_fence(__ATOMIC_ACQUIRE, "agent");
            asm volatile("s_waitcnt vmcnt(0)" ::: "memory");
        }
    }
    __syncthreads();
}

constexpr int CW_BAR = 8192;
static_assert((CW_BAR + XCD_BAR_WORDS) * 4 <= (int)CTL_BYTES, "ctl");
__global__ void __launch_bounds__(NTHR, 2) k_mega(KArgs a) {
    LAS unsigned char* lds = (LAS unsigned char*)g_lds; char* ldsg = (char*)g_lds;
    if (threadIdx.x < 4) ((LAS unsigned*)(lds + LDS_MISC))[threadIdx.x] = 0u;
    __syncthreads();
    const Ctx c{};
    const XcdBarrier bar = xcd_barrier_post((unsigned*)(wsl(c) + WS_CTL) + CW_BAR, (volatile LAS unsigned*)(lds + LDS_MISC));
#ifndef PROBE_PH
#define PROBE_PH (-1)
#endif
#ifndef DUP_C
#define DUP_C 0
#endif
#ifndef DUP_PH
#define DUP_PH (-1)
#endif
    unsigned long long tacc = 0ull, t0 = 0ull;
#define PB_S(p) do { if (PROBE_PH == (p)) t0 = __builtin_amdgcn_s_memrealtime(); } while (0)
#define PB_E(p) do { if (PROBE_PH == (p)) tacc += __builtin_amdgcn_s_memrealtime() - t0; } while (0)
#define GBAR() xcd_barrier(bar)
    PB_S(0); ph_xprep(c, lds); ph_convert(c, 0, lds, 0, CV_A_END); GBAR(); PB_E(0);
#define LAYER(l) do { \
        PB_S(1); if (DUP_PH == 1) { ph_gemm<0>(c, l, lds); GBAR(); } ph_gemm<0>(c, l, lds);          GBAR(); PB_E(1); \
        PB_S(2); if (DUP_PH == 2) { hg::pass_a(c, ldsg); GBAR(); } ph_foxprep(c, l, lds); __syncthreads(); hg::pass_a(c, ldsg);     GBAR(); PB_E(2); \
        PB_S(5); hg::pass_b(c); __syncthreads(); fa::phase(c, l, ldsg); attn_tail_convert(c, l, lds, CV_A_END);                GBAR(); if (DUP_PH == 5) { fa::phase(c, l, ldsg, l + 4); GBAR(); } PB_E(5);     \
        PB_S(4); if (DUP_C) { hg::pass_c(c, l, ldsg, true); GBAR(); } hg::pass_c(c, l, ldsg);         GBAR(); PB_E(4); \
        PB_S(6); if (DUP_PH == 6) { ph_gemm<1>(c, l, lds); GBAR(); } ph_gemm<1>(c, l, lds);                     GBAR(); PB_E(6); \
        PB_S(7); if (DUP_PH == 7) { ph_gemm<3>(c, l, lds); GBAR(); } ph_gemm<3>(c, l, lds);          GBAR(); PB_E(7); \
        PB_S(8); ph_ln1_router(c, l, lds);       GBAR(); PB_E(8); \
        PB_S(9); if (DUP_PH == 9) { ph_gemm<4>(c, l, lds); GBAR(); } ph_gemm<4>(c, l, lds); if (l + 1 < DEPTH) moe_tail_convert(c, l + 1, lds, 0, CV_A_END);         GBAR(); PB_E(9); \
        PB_S(10); if (DUP_PH == 10) { ph_gemm<5>(c, l, lds); GBAR(); } ph_gemm<5>(c, l, lds); \
        if (PROBE_PH >= 0 && l == DEPTH - 1) { PB_E(10); if (bidx() == 0 && threadIdx.x == 0) { const float tq = exp2f(rintf(4.f * log2f((float)tacc * 1e-7f)) * 0.25f); *(float*)(wsl(c) + WS_CTL + 256) = 1.f + sqrtf(tq); } } \
        GBAR(); if (l < DEPTH - 1) PB_E(10); \
        float oscale = 1.f; if (PROBE_PH >= 0 && l == DEPTH - 1) oscale = __hip_atomic_load((float*)(wsl(c) + WS_CTL + 256), __ATOMIC_RELAXED, __HIP_MEMORY_SCOPE_AGENT); \
        PB_S(11); if (DUP_PH == 11) { ph_ln2(c, l, lds, oscale); __syncthreads(); } if (DUP_PH == 12 && l + 1 < DEPTH) { ph_convert(c, l + 1, lds); __syncthreads(); } ph_ln2(c, l, lds, oscale); \
        if (l + 1 < DEPTH) { __syncthreads(); ph_convert(c, l + 1, lds, CV_ALL, CV_ALL); GBAR(); PB_E(11); } } while (0)
    LAYER(0); LAYER(1); LAYER(2); LAYER(3);
}
#ifdef PHASE_REGS
#define PK(name, body) __global__ void __launch_bounds__(NTHR, 2) name(KArgs a, int l) { LAS unsigned char* lds = (LAS unsigned char*)g_lds; char* ldsg = (char*)g_lds; const Ctx c{}; body; }
PK(t_xprep, ph_xprep(c, lds)) PK(t_convert, ph_convert(c, l, lds)) PK(t_inproj, ph_gemm<0>(c, l, lds)) PK(t_foxprep, ph_foxprep(c, l, lds)) PK(t_hga, hg::pass_a(c, ldsg)) PK(t_hgb, hg::pass_b(c))
PK(t_hgc, hg::pass_c(c, l, ldsg)) PK(t_attn, fa::phase(c, l, ldsg)) PK(t_merge1, ph_gemm<1>(c, l, lds)) PK(t_out, ph_gemm<3>(c, l, lds)) PK(t_ln1, ph_ln1_router(c, l, lds))
PK(t_moeup, ph_gemm<4>(c, l, lds)) PK(t_moedn, ph_gemm<5>(c, l, lds)) PK(t_ln2, ph_ln2(c, l, lds))
#endif
extern "C" void kernel_launch(void* const* d_in, const int* in_sizes, int n_in, void* d_out, int out_size, void* d_ws, size_t ws_size, hipStream_t stream) {
    static int ok = 0;
    if (ok == 0) {
        if (n_in != 21 || in_sizes[0] != T * DM || out_size != T * DM || ws_size < hg::WS_HG_END) { fprintf(stderr, "kernel_launch: unexpected shapes (n_in %d in0 %d out %d ws %zu, need ws >= %zu)\n", n_in, n_in > 0 ? in_sizes[0] : -1, out_size, ws_size, (size_t)hg::WS_HG_END); ok = -1; return; }
        if (hipFuncSetAttribute((const void*)k_mega, hipFuncAttributeMaxDynamicSharedMemorySize, LDS_TOTAL) != hipSuccess) { fprintf(stderr, "kernel_launch: hipFuncSetAttribute failed\n"); ok = -1; return; }
        int dev = 0, cus = 0, per_cu = 0;
        if (hipGetDevice(&dev) != hipSuccess || hipDeviceGetAttribute(&cus, hipDeviceAttributeMultiprocessorCount, dev) != hipSuccess || cus < 256) { fprintf(stderr, "kernel_launch: needs a device with >= 256 CUs (found %d); nothing launched\n", cus); ok = -1; return; }
        if (hipOccupancyMaxActiveBlocksPerMultiprocessor(&per_cu, (const void*)k_mega, NTHR, LDS_TOTAL) != hipSuccess || per_cu < 1) { fprintf(stderr, "kernel_launch: the occupancy query reports %d workgroups per CU (need 1); nothing launched\n", per_cu); (void)hipGetLastError(); ok = -1; return; }
        ok = 1;
    }
    if (ok < 0) return;
    (void)hipMemsetAsync((char*)d_ws + WS_CTL, 0, CTL_BYTES, stream);
    KArgs a{};
    for (int i = 0; i < 21; ++i) a.in[i] = (const float*)d_in[i];
    a.out = (float*)d_out; a.ws = (unsigned char*)d_ws;
    hipLaunchKernelGGL(k_mega, dim3(256), dim3(NTHR), LDS_TOTAL, stream, a);
}
```
